# Optimizing an MI355X kernel written in HIP

```python
import jax, jax.numpy as jnp
from jax import lax
import numpy as np

D_MODEL = 1024
BATCH = 16
SEQ = 2048
DEPTH = 2

CTX_LEN = 256
GRID_W = 64
N_MOD = 6
EPS = 1e-6
D_RNN = 1024
RNN_BLOCKS = 16
RNN_BW = D_RNN // RNN_BLOCKS
CONV_W = 4
CONV_PAD = (2, 1)
LRU_C = 8.0
NA_HEADS = 16
NA_HEAD_DIM = 64
D_ATT = NA_HEADS * NA_HEAD_DIM
WIN_H = 8
WIN_W = 16
Q_COL_BLOCK = WIN_W
K_COL_BLOCK = 2 * WIN_W
IN_SIZES = (D_RNN, D_ATT, D_ATT, D_RNN, D_ATT, D_MODEL, D_MODEL)
IN_COLS = 2 * D_RNN + 3 * D_ATT + 2 * D_MODEL
CTX_STATE_COLS = D_RNN + 2 * D_ATT
D_FF = 2816
N_EXPERTS = 8
TOP_K = 2
D_FF_EXPERT = 3584

kernel_name = 'hybrid_rglru_natten_moe_dit_block'


def rms_norm(x):
    xf = x.astype(jnp.float32)
    return (xf * lax.rsqrt(jnp.mean(xf * xf, axis=-1, keepdims=True) + EPS)).astype(x.dtype)


def head_rms_norm(x, gain):
    return rms_norm(x) * gain


def modulate(x, shift, scale):
    return rms_norm(x) * (1 + scale) + shift


def adaln(cond, w_mod, b_mod):
    return jnp.split(jax.nn.silu(cond) @ w_mod + b_mod, N_MOD, axis=-1)


def split_columns(z):
    parts, off = [], 0
    for size in IN_SIZES:
        if off >= z.shape[-1]:
            break
        parts.append(z[..., off:off + size])
        off += size
    return parts


def heads(t):
    return t.reshape(*t.shape[:-1], NA_HEADS, NA_HEAD_DIM)


def dw_conv(x, w, b):
    y = lax.conv_general_dilated(x, w[:, None, :].astype(x.dtype), window_strides=(1,), padding=(CONV_PAD,),
                                 dimension_numbers=('NWC', 'WIO', 'NWC'), feature_group_count=x.shape[-1])
    return y + b.astype(x.dtype)


def rglru_coeffs(xc, lam, w_gates, b_gates):
    xb = xc.reshape(*xc.shape[:-1], RNN_BLOCKS, RNN_BW)
    g = jnp.einsum('blnc,gncd->gblnd', xb, w_gates).reshape(2, *xc.shape) + b_gates[:, None, None, :]
    r = jax.nn.sigmoid(g[0].astype(jnp.float32))
    i = jax.nn.sigmoid(g[1].astype(jnp.float32))
    log_a = LRU_C * r * jax.nn.log_sigmoid(lam.astype(jnp.float32))
    a = jnp.exp(log_a)
    u = jnp.sqrt(-jnp.expm1(2.0 * log_a)) * (i * xc.astype(jnp.float32))
    return a, u


def linear_scan(a, u, h0, reverse, return_seq):
    def step(h, au):
        h = au[0] * h + au[1]
        return h, (h if return_seq else None)
    h_last, hs = lax.scan(step, h0, (jnp.swapaxes(a, 0, 1), jnp.swapaxes(u, 0, 1)), reverse=reverse)
    return (jnp.swapaxes(hs, 0, 1) if return_seq else None), h_last


def bidirectional_rglru(xc_ctx, xc_lat, rg_lambda, rg_w, rg_b, ctx_out):
    h0 = jnp.zeros((xc_lat.shape[0], D_RNN), jnp.float32)
    ys_ctx, ys_lat = [], []
    for d, reverse in enumerate((False, True)):
        a_c, u_c = rglru_coeffs(xc_ctx, rg_lambda[d], rg_w[d], rg_b[d])
        hs_c, h_c = linear_scan(a_c, u_c, h0, reverse, ctx_out)
        a_l, u_l = rglru_coeffs(xc_lat, rg_lambda[d], rg_w[d], rg_b[d])
        hs_l, _ = linear_scan(a_l, u_l, h_c, reverse, True)
        ys_ctx.append(hs_c)
        ys_lat.append(hs_l)
    y_lat = (ys_lat[0] + ys_lat[1]).astype(xc_lat.dtype)
    y_ctx = (ys_ctx[0] + ys_ctx[1]).astype(xc_ctx.dtype) if ctx_out else None
    return y_ctx, y_lat


def na_tables(rows):
    kr = min(WIN_H, rows)
    n_cb = GRID_W // Q_COL_BLOCK
    qcol = np.arange(GRID_W).reshape(n_cb, Q_COL_BLOCK)
    kstart = np.clip(np.arange(n_cb) * Q_COL_BLOCK - WIN_W // 2, 0, GRID_W - K_COL_BLOCK)
    kcol = kstart[:, None] + np.arange(K_COL_BLOCK)[None, :]
    wstart = np.clip(qcol - WIN_W // 2, 0, GRID_W - WIN_W)[..., None]
    kc = kcol[:, None, :]
    col_valid = (kc >= wstart) & (kc < wstart + WIN_W)
    col_off = np.clip(kc - qcol[..., None] + WIN_W - 1, 0, 2 * WIN_W - 2)
    return kr, kcol, col_valid, col_off


def neighbourhood_attention(q, k, v, k_ctx, v_ctx, rpb):
    b, s, h, dh = q.shape
    rows = s // GRID_W
    kr, kcol, col_valid, col_off = na_tables(rows)
    n_cb = kcol.shape[0]
    n_lat = kr * K_COL_BLOCK
    scale = dh ** -0.5
    qg = q.reshape(b, rows, n_cb, Q_COL_BLOCK, h, dh)
    kg = k.reshape(b, rows, GRID_W, h, dh)
    vg = v.reshape(b, rows, GRID_W, h, dh)
    col_bias = rpb[:, :, col_off].astype(jnp.float32)
    mask = jnp.asarray(col_valid)[:, :, None, :]

    def row_block(r):
        start = jnp.clip(r - kr // 2, 0, rows - kr)
        k_blk = lax.dynamic_slice_in_dim(kg, start, kr, axis=1)[:, :, kcol]
        v_blk = lax.dynamic_slice_in_dim(vg, start, kr, axis=1)[:, :, kcol]
        q_blk = lax.dynamic_index_in_dim(qg, r, axis=1, keepdims=False)
        bias = jnp.take(col_bias, start + jnp.arange(kr) - r + WIN_H - 1, axis=1)
        s_lat = (jnp.einsum('bjqhd,brjkhd->bhjqrk', q_blk, k_blk).astype(jnp.float32) * scale
                 + jnp.transpose(bias, (0, 2, 3, 1, 4)))
        s_lat = jnp.where(mask, s_lat, -jnp.inf).reshape(b, h, n_cb, Q_COL_BLOCK, n_lat)
        s_ctx = jnp.einsum('bjqhd,bchd->bhjqc', q_blk, k_ctx).astype(jnp.float32) * scale
        p = jax.nn.softmax(jnp.concatenate([s_lat, s_ctx], axis=-1), axis=-1).astype(v.dtype)
        p_lat = p[..., :n_lat].reshape(b, h, n_cb, Q_COL_BLOCK, kr, K_COL_BLOCK)
        o = (jnp.einsum('bhjqrk,brjkhd->bjqhd', p_lat, v_blk)
             + jnp.einsum('bhjqc,bchd->bjqhd', p[..., n_lat:], v_ctx))
        return o.reshape(b, GRID_W, h, dh)

    out = lax.map(row_block, jnp.arange(rows))
    return jnp.moveaxis(out, 0, 1).reshape(b, s, h * dh)


def context_attention(q, k, v):
    s = jnp.einsum('bqhd,bkhd->bhqk', q, k).astype(jnp.float32) * q.shape[-1] ** -0.5
    p = jax.nn.softmax(s, axis=-1).astype(v.dtype)
    o = jnp.einsum('bhqk,bkhd->bqhd', p, v)
    return o.reshape(*o.shape[:2], -1)


def merge_branches(y_rnn, y_na, g_rnn, g_na, w_rnn_o, w_na_o, w_out):
    return (jax.nn.sigmoid(g_rnn) * (y_rnn @ w_rnn_o) + jax.nn.sigmoid(g_na) * (y_na @ w_na_o)) @ w_out


def token_mixer(h_ctx, h_lat, w_in, conv_w, conv_b, rg_lambda, rg_w, rg_b, q_gain, k_gain, rpb,
                w_rnn_o, w_na_o, w_out, ctx_out):
    x_l, k_l, v_l, y_l, q_l, gr_l, gn_l = split_columns(h_lat @ w_in)
    z_c = split_columns(h_ctx @ (w_in if ctx_out else w_in[:, :CTX_STATE_COLS]))
    x_c, k_c, v_c = z_c[:3]
    rnn_ctx, rnn_lat = bidirectional_rglru(dw_conv(x_c, conv_w, conv_b), dw_conv(x_l, conv_w, conv_b),
                                           rg_lambda, rg_w, rg_b, ctx_out)
    k_c = head_rms_norm(heads(k_c), k_gain)
    v_c = heads(v_c)
    na_lat = neighbourhood_attention(head_rms_norm(heads(q_l), q_gain), head_rms_norm(heads(k_l), k_gain),
                                     heads(v_l), k_c, v_c, rpb)
    out_lat = merge_branches(rnn_lat * jax.nn.gelu(y_l), na_lat, gr_l, gn_l, w_rnn_o, w_na_o, w_out)
    out_ctx = None
    if ctx_out:
        y_c, q_c, gr_c, gn_c = z_c[3:]
        na_ctx = context_attention(head_rms_norm(heads(q_c), q_gain), k_c, v_c)
        out_ctx = merge_branches(rnn_ctx * jax.nn.gelu(y_c), na_ctx, gr_c, gn_c, w_rnn_o, w_na_o, w_out)
    return out_ctx, out_lat


def swiglu(h, w1, w3, w2):
    return (jax.nn.silu(h @ w1) * (h @ w3)) @ w2


def moe_swiglu(h, router, w1, w3, w2):
    logits = (h @ router).astype(jnp.float32)
    top_val, top_idx = lax.top_k(logits, TOP_K)
    top_w = jax.nn.softmax(top_val, axis=-1)
    gates = jnp.sum(jax.nn.one_hot(top_idx, N_EXPERTS, dtype=jnp.float32) * top_w[..., None], axis=-2).astype(h.dtype)
    out = jnp.zeros_like(h)
    for e in range(N_EXPERTS):
        out = out + gates[..., e:e + 1] * swiglu(h, w1[e], w3[e], w2[e])
    return out


def setup_inputs(seed: int = 0) -> dict:
    key = jax.random.key(seed)
    ks = jax.random.split(key, 25)
    f32 = jnp.float32
    n_dense = (DEPTH + 1) // 2
    n_moe = DEPTH // 2

    def nrm(k, shape, scale):
        return jax.random.normal(k, shape, f32) * scale

    a0 = jax.random.uniform(ks[9], (DEPTH, 2, D_RNN), f32, 0.9, 0.999) ** (1.0 / LRU_C)
    return {
        'x': nrm(ks[0], (BATCH, SEQ, D_MODEL), 1.0),
        'c': nrm(ks[1], (BATCH, D_MODEL), 1.0),
        'ctx': nrm(ks[2], (BATCH, CTX_LEN, D_MODEL), 1.0),
        'c_ctx': nrm(ks[3], (D_MODEL,), 1.0),
        'w_mod': nrm(ks[4], (DEPTH, D_MODEL, N_MOD * D_MODEL), D_MODEL ** -0.5),
        'b_mod': nrm(ks[5], (DEPTH, N_MOD * D_MODEL), 0.02),
        'w_in': nrm(ks[6], (DEPTH, D_MODEL, IN_COLS), D_MODEL ** -0.5),
        'conv_w': nrm(ks[7], (DEPTH, CONV_W, D_RNN), CONV_W ** -0.5),
        'conv_b': nrm(ks[8], (DEPTH, D_RNN), 0.02),
        'rg_lambda': jnp.log(a0) - jnp.log1p(-a0),
        'rg_w': nrm(ks[10], (DEPTH, 2, 2, RNN_BLOCKS, RNN_BW, RNN_BW), RNN_BW ** -0.5),
        'rg_b': nrm(ks[11], (DEPTH, 2, 2, D_RNN), 0.02),
        'q_gain': 1.0 + nrm(ks[12], (DEPTH, NA_HEAD_DIM), 0.02),
        'k_gain': 1.0 + nrm(ks[13], (DEPTH, NA_HEAD_DIM), 0.02),
        'rpb': nrm(ks[14], (DEPTH, NA_HEADS, 2 * WIN_H - 1, 2 * WIN_W - 1), 0.1),
        'w_rnn_o': nrm(ks[15], (DEPTH, D_RNN, D_MODEL), D_RNN ** -0.5),
        'w_na_o': nrm(ks[16], (DEPTH, D_ATT, D_MODEL), D_ATT ** -0.5),
        'w_out': nrm(ks[17], (DEPTH, D_MODEL, D_MODEL), D_MODEL ** -0.5),
        'ffn_w1': nrm(ks[18], (n_dense, D_MODEL, D_FF), D_MODEL ** -0.5),
        'ffn_w3': nrm(ks[19], (n_dense, D_MODEL, D_FF), D_MODEL ** -0.5),
        'ffn_w2': nrm(ks[20], (n_dense, D_FF, D_MODEL), D_FF ** -0.5),
        'router': nrm(ks[21], (n_moe, D_MODEL, N_EXPERTS), D_MODEL ** -0.5),
        'moe_w1': nrm(ks[22], (n_moe, N_EXPERTS, D_MODEL, D_FF_EXPERT), D_MODEL ** -0.5),
        'moe_w3': nrm(ks[23], (n_moe, N_EXPERTS, D_MODEL, D_FF_EXPERT), D_MODEL ** -0.5),
        'moe_w2': nrm(ks[24], (n_moe, N_EXPERTS, D_FF_EXPERT, D_MODEL), D_FF_EXPERT ** -0.5),
    }


def reference(x, c, ctx, c_ctx, w_mod, b_mod, w_in, conv_w, conv_b, rg_lambda, rg_w, rg_b, q_gain, k_gain,
              rpb, w_rnn_o, w_na_o, w_out, ffn_w1, ffn_w3, ffn_w2, router, moe_w1, moe_w3, moe_w2):
    xc = ctx
    for l in range(DEPTH):
        ctx_out = l < DEPTH - 1
        sh1, sc1, g1, sh2, sc2, g2 = [m[:, None, :] for m in adaln(c, w_mod[l], b_mod[l])]
        csh1, csc1, cg1, csh2, csc2, cg2 = adaln(c_ctx, w_mod[l], b_mod[l])
        mix_ctx, mix_lat = token_mixer(modulate(xc, csh1, csc1), modulate(x, sh1, sc1), w_in[l], conv_w[l],
                                       conv_b[l], rg_lambda[l], rg_w[l], rg_b[l], q_gain[l], k_gain[l], rpb[l],
                                       w_rnn_o[l], w_na_o[l], w_out[l], ctx_out)
        x = x + g1 * mix_lat
        if ctx_out:
            xc = xc + cg1 * mix_ctx
        if l % 2 == 0:
            ffn = lambda h, j=l // 2: swiglu(h, ffn_w1[j], ffn_w3[j], ffn_w2[j])
        else:
            ffn = lambda h, j=l // 2: moe_swiglu(h, router[j], moe_w1[j], moe_w3[j], moe_w2[j])
        x = x + g2 * ffn(modulate(x, sh2, sc2))
        if ctx_out:
            xc = xc + cg2 * ffn(modulate(xc, csh2, csc2))
    return x
```

```cpp
#include <hip/hip_runtime.h>
#include <cstdio>
#include <cstdint>
#ifndef MK_ONE_LAUNCH
#define MK_ONE_LAUNCH 0
#endif
#define XB_TMO      128
#define XB_XCNT(j)  (256  + 64 * (j))
#define XB_XSUB(j)  (1280 + 64 * (j))
#define XB_XGEN(j)  (2304 + 64 * (j))
#define XB_TOP      3328
#define XB_TOPGEN   3392
#define XCD_BAR_WORDS 3456
#define XB_SPIN_CAP (1u << 22)
#define LAS __attribute__((address_space(3)))

__device__ __forceinline__ unsigned xb_ld(unsigned* p)              { return __hip_atomic_load(p, __ATOMIC_RELAXED, __HIP_MEMORY_SCOPE_AGENT); }
__device__ __forceinline__ unsigned xb_add(unsigned* p, unsigned v) { return __hip_atomic_fetch_add(p, v, __ATOMIC_RELAXED, __HIP_MEMORY_SCOPE_AGENT); }
__device__ __forceinline__ unsigned xb_xcc_id() { return (unsigned)__builtin_amdgcn_s_getreg((3 << 11) | 20) & 0xFu; }
#define XB_SPIN(cond, bar) do { unsigned _sp = 0; while (cond) { __builtin_amdgcn_s_sleep(1); \
    if ((++_sp & 255u) == 0u) { if (xb_ld(&(bar)[XB_TMO])) break; if (_sp > XB_SPIN_CAP) { atomicAdd(&(bar)[XB_TMO], 1u); break; } } } } while (0)

struct XcdBarrier {
    unsigned* bar; unsigned x;
    volatile LAS unsigned* st;
};

__device__ __forceinline__ XcdBarrier xcd_barrier_post(unsigned* bar, volatile LAS unsigned* st) {
    XcdBarrier b; b.bar = bar; b.x = xb_xcc_id(); b.st = st;
    if (threadIdx.x == 0) (void)xb_add(&bar[XB_XCNT(b.x)], 1u);
    return b;
}
__device__ __forceinline__ void xcd_barrier_complete(unsigned* bar, unsigned x, unsigned& nloc, unsigned& nx) {
    const unsigned G = gridDim.x * gridDim.y * gridDim.z;
    unsigned sum, cnt, mine, sp = 0u;
    for (;;) {
        sum = 0u; cnt = 0u; mine = 0u;
#pragma unroll
        for (unsigned j = 0; j < 16; ++j) { const unsigned c = xb_ld(&bar[XB_XCNT(j)]); sum += c; cnt += (c > 0u) ? 1u : 0u; mine = (j == x) ? c : mine; }
        if (sum == G) break;
        __builtin_amdgcn_s_sleep(1);
        if ((++sp & 255u) == 0u) { if (xb_ld(&bar[XB_TMO])) break; if (sp > XB_SPIN_CAP) { atomicAdd(&bar[XB_TMO], 1u); break; } }
    }
    nloc = mine > 0u ? mine : 1u; nx = cnt > 0u ? cnt : 1u;
}

__device__ __forceinline__ void xcd_barrier(const XcdBarrier& b) {
    asm volatile("s_waitcnt vmcnt(0)" ::: "memory");
    __syncthreads();
    if (threadIdx.x == 0) {
        unsigned* bar = b.bar;
        __builtin_amdgcn_s_waitcnt(0);
        unsigned nloc = b.st[0], nx = b.st[1];
        if (nloc == 0u) { xcd_barrier_complete(bar, b.x, nloc, nx); b.st[0] = nloc; b.st[1] = nx; }
        const unsigned old = xb_add(&bar[XB_XSUB(b.x)], 1u);
        const unsigned gen = old / nloc;
        if (old + 1u == (gen + 1u) * nloc) {
            __builtin_amdgcn_fence(__ATOMIC_RELEASE, "agent");
            asm volatile("s_waitcnt vmcnt(0)" ::: "memory");
            const unsigned og = xb_add(&bar[XB_TOP], 1u);
            const unsigned tg = og / nx;
            if (og + 1u == (tg + 1u) * nx) xb_add(&bar[XB_TOPGEN], 1u);
            else XB_SPIN(xb_ld(&bar[XB_TOPGEN]) == tg, bar);
            __builtin_amdgcn_fence(__ATOMIC_ACQUIRE, "agent");
            xb_add(&bar[XB_XGEN(b.x)], 1u);
            asm volatile("s_waitcnt vmcnt(0)" ::: "memory");
        } else {
            XB_SPIN(xb_ld(&bar[XB_XGEN(b.x)]) == gen, bar);
            __builtin_amdgcn_fence(__ATOMIC_ACQUIRE, "agent");
            asm volatile("s_waitcnt vmcnt(0)" ::: "memory");
        }
    }
    __syncthreads();
}

namespace pg8 {
#define PG8_LAS __attribute__((address_space(3)))
typedef unsigned short bf16_t;
typedef short bf16x8 __attribute__((ext_vector_type(8)));
typedef float f32x4 __attribute__((ext_vector_type(4)));
typedef unsigned u32x4 __attribute__((ext_vector_type(4)));
constexpr int BM = 256, BK = 64, HALF = 128, HTB = HALF * BK * 2  , STAGE_BYTES = 8 * HTB, NXCD = 8, WGM = 8;

__host__ __device__ __forceinline__ int lds_byte(int r, int c) { const int st = (r >> 4) * 2 + (c >> 5), rr = r & 15, cc = c & 31, ob = rr * 64 + cc * 2; return st * 1024 + (ob ^ (((ob >> 9) & 1) << 5)); }
__host__ __device__ __forceinline__ void stage_rc(int b, int& R, int& C) { const int st = b / 1024, sb = b % 1024, swz = sb ^ (((sb >> 9) & 1) << 5); R = (st >> 1) * 16 + swz / 64; C = (st & 1) * 32 + (swz % 64) / 2; }
__host__ __device__ __forceinline__ int perm32(int rho) { const int n = rho >> 4, i = rho & 15; return 8 * (i >> 2) + 4 * n + (i & 3); }

struct Unit { int pm, pn; };
struct Gemm { const bf16_t* A; const bf16_t* Bt; int M, N, K; };
__device__ __forceinline__ unsigned cvt_pk_bf16(float lo, float hi) { unsigned r; asm volatile("v_cvt_pk_bf16_f32 %0, %1, %2" : "=v"(r) : "v"(lo), "v"(hi)); return r; }
typedef float f32x2 __attribute__((ext_vector_type(2)));
template <class Epi, class Sched, bool STAMP = false>
__device__ __forceinline__ void gemm_phase(PG8_LAS unsigned char* lds, const Gemm g, const Sched& S, const Epi& E, unsigned long long* stamps) {
    int tid_l = threadIdx.x; asm volatile("" : "+v"(tid_l));
    const int tid = tid_l, wid = __builtin_amdgcn_readfirstlane(tid >> 6), lane = tid & 63, wr = wid >> 2, wc = wid & 3, fr = lane & 15, fq = lane >> 4;
    const int K = g.K, nt = K / BK;
    int ts_lo = 0, ts_hi = 0, nts = 0; const unsigned long long rt_entry = STAMP ? (unsigned long long)wall_clock64() : 0ull;
#define PG8_STAMP() do { if (STAMP && wid == 0 && nts < 64) { const unsigned long long _c = (unsigned long long)clock64(); \
        ts_lo = (lane == nts) ? (int)(unsigned)_c : ts_lo; ts_hi = (lane == nts) ? (int)(unsigned)(_c >> 32) : ts_hi; ++nts; } } while (0)
    PG8_STAMP();
    unsigned voffA[2], voffB[2];
#pragma unroll
    for (int i = 0; i < 2; ++i) { int R, C; stage_rc(tid * 16 + i * 8192, R, C); const int Rb = Epi::PERM ? ((R & ~31) + perm32(R & 31)) : R;
        voffA[i] = (unsigned)(R * K + C) * 2u; voffB[i] = (unsigned)(Rb * K + C) * 2u; }
    const size_t kstep = (size_t)(BK * 2);
    const size_t hstep = (size_t)HALF * K * 2;
    const size_t tstep = 2 * hstep;
    const unsigned ldsw = (unsigned)wid * 1024u;
    const int aoff = lds_byte(wr * 64 + fr, fq * 8), boff = lds_byte(wc * 32 + fr, fq * 8);
#define PG8_SA(b, h) (((b) * 2 + (h)) * HTB)
#define PG8_SB(b, h) ((4 + (b) * 2 + (h)) * HTB)
#define PG8_STAGE(bufoff, gbase, voff) do { _Pragma("unroll") for (int _i = 0; _i < 2; ++_i) \
        __builtin_amdgcn_global_load_lds((const unsigned*)((const char*)(gbase) + (voff)[_i]), (PG8_LAS unsigned*)(lds + (bufoff) + ldsw + _i * 8192), 16, 0, 0); } while (0)
#define PG8_LDA(dst, b, h) do { _Pragma("unroll") for (int m = 0; m < 4; ++m) _Pragma("unroll") for (int k = 0; k < 2; ++k) dst[m][k] = *(const PG8_LAS bf16x8*)(lds + PG8_SA(b, h) + aoff + m * 2048 + k * 1024); } while (0)
#define PG8_LDB(dst, b, h) do { _Pragma("unroll") for (int n = 0; n < 2; ++n) _Pragma("unroll") for (int k = 0; k < 2; ++k) dst[n][k] = *(const PG8_LAS bf16x8*)(lds + PG8_SB(b, h) + boff + n * 2048 + k * 1024); } while (0)
#define PG8_MMA(ai, bj, At, Bt) do { __builtin_amdgcn_s_setprio(1); _Pragma("unroll") for (int m = 0; m < 4; ++m) _Pragma("unroll") for (int n = 0; n < 2; ++n) _Pragma("unroll") for (int k = 0; k < 2; ++k) \
        acc[ai][bj][m][n] = __builtin_amdgcn_mfma_f32_16x16x32_bf16(Bt[n][k], At[m][k], acc[ai][bj][m][n], 0, 0, 0); __builtin_amdgcn_s_setprio(0); } while (0)
#define PG8_WAIT_V(n) asm volatile("s_waitcnt vmcnt(" #n ")" ::: "memory")
#define PG8_WAIT_L(n) asm volatile("s_waitcnt lgkmcnt(" #n ")" ::: "memory")
#define PG8_BAR __builtin_amdgcn_s_barrier()
#define PG8_SCHED __builtin_amdgcn_sched_barrier(0)
    Unit cur, nxt; int ui = 0;
    if (!S.next(0, cur)) return;
    f32x4 acc[2][2][4][2];
#pragma unroll
    for (int a = 0; a < 2; ++a)
#pragma unroll
        for (int b = 0; b < 2; ++b)
#pragma unroll
            for (int m = 0; m < 4; ++m)
#pragma unroll
                for (int n = 0; n < 2; ++n) acc[a][b][m][n] = (f32x4){0.f, 0.f, 0.f, 0.f};
    bf16x8 At[4][2], B0[2][2], B1[2][2];
    const char* cA = (const char*)g.A + (size_t)cur.pm * tstep; const char* cB = (const char*)g.Bt + (size_t)cur.pn * tstep;
    S.a_ready(cur);
    PG8_STAGE(PG8_SB(0, 0), cB, voffB); PG8_STAGE(PG8_SA(0, 0), cA, voffA); PG8_STAGE(PG8_SB(0, 1), cB + hstep, voffB); PG8_STAGE(PG8_SA(0, 1), cA + hstep, voffA);
    if (wr == 1) PG8_BAR;
    PG8_WAIT_V(4); PG8_BAR;
    PG8_STAGE(PG8_SB(1, 0), cB + kstep, voffB); PG8_STAGE(PG8_SA(1, 0), cA + kstep, voffA); PG8_STAGE(PG8_SB(1, 1), cB + hstep + kstep, voffB);
    PG8_WAIT_V(6); PG8_BAR;
    PG8_STAMP();
    for (;;) {
        const bool has_next = S.next(ui + 1, nxt);
        const char* nA = has_next ? (const char*)g.A + (size_t)nxt.pm * tstep : cA; const char* nB = has_next ? (const char*)g.Bt + (size_t)nxt.pn * tstep : cB;
        for (int t = 0; t < nt; t += 2) {
            const bool last = (t == nt - 2);
            const char* a1 = cA + (size_t)(t + 1) * kstep;
            const char* a2 = last ? nA : cA + (size_t)(t + 2) * kstep; const char* b2 = last ? nB : cB + (size_t)(t + 2) * kstep;
            const char* a3 = a2 + kstep; const char* b3 = b2 + kstep;
            if (last && has_next) S.a_ready(nxt);
            PG8_LDB(B0, 0, 0); PG8_SCHED; PG8_LDA(At, 0, 0); PG8_STAGE(PG8_SA(1, 1), a1 + hstep, voffA);
            PG8_WAIT_L(8); PG8_BAR; PG8_WAIT_L(0); PG8_MMA(0, 0, At, B0); PG8_BAR; PG8_SCHED;
            PG8_LDB(B1, 0, 1); PG8_STAGE(PG8_SB(0, 0), b2, voffB);
            PG8_BAR; PG8_WAIT_L(0); PG8_MMA(0, 1, At, B1); PG8_BAR;
            PG8_LDA(At, 0, 1); PG8_STAGE(PG8_SA(0, 0), a2, voffA);
            PG8_BAR; PG8_WAIT_L(0); PG8_MMA(1, 0, At, B0); PG8_BAR; PG8_SCHED;
            PG8_STAGE(PG8_SB(0, 1), b2 + hstep, voffB);
            PG8_WAIT_V(6); PG8_BAR; PG8_MMA(1, 1, At, B1); PG8_BAR;
            PG8_LDB(B0, 1, 0); PG8_SCHED; PG8_LDA(At, 1, 0); PG8_STAGE(PG8_SA(0, 1), a2 + hstep, voffA);
            PG8_WAIT_L(8); PG8_BAR; PG8_WAIT_L(0); PG8_MMA(0, 0, At, B0); PG8_BAR; PG8_SCHED;
            PG8_LDB(B1, 1, 1); PG8_STAGE(PG8_SB(1, 0), b3, voffB);
            PG8_BAR; PG8_WAIT_L(0); PG8_MMA(0, 1, At, B1); PG8_BAR;
            PG8_LDA(At, 1, 1); PG8_STAGE(PG8_SA(1, 0), a3, voffA);
            PG8_BAR; PG8_WAIT_L(0); PG8_MMA(1, 0, At, B0); PG8_BAR; PG8_SCHED;
            PG8_STAGE(PG8_SB(1, 1), b3 + hstep, voffB);
            PG8_WAIT_V(6); PG8_BAR; PG8_MMA(1, 1, At, B1); PG8_BAR;
        }
        PG8_STAMP();
        if constexpr (!Epi::AFTER_DRAIN) { E(acc, cur, wr, wc, fr, fq); S.done(cur); }
        PG8_STAMP();
        if (!has_next) break;
#pragma unroll
        for (int a = 0; a < 2; ++a)
#pragma unroll
            for (int b = 0; b < 2; ++b)
#pragma unroll
                for (int m = 0; m < 4; ++m)
#pragma unroll
                    for (int n = 0; n < 2; ++n) acc[a][b][m][n] = (f32x4){0.f, 0.f, 0.f, 0.f};
        cur = nxt; cA = nA; cB = nB; ++ui;
    }
    PG8_WAIT_V(0);
    if (wr == 0) PG8_BAR;
    PG8_BAR;
    if constexpr (Epi::AFTER_DRAIN) { E.fused(acc, cur, wr, wc, fr, fq, lds, wid, lane); S.done(cur); }
    PG8_STAMP();
    if (STAMP && wid == 0) { stamps[lane] = lane < nts ? (((unsigned long long)(unsigned)ts_hi << 32) | (unsigned)ts_lo) : 0ull;
        if (lane == 62) stamps[62] = rt_entry; if (lane == 63) stamps[63] = (unsigned long long)wall_clock64(); }
#undef PG8_STAMP
#undef PG8_SA
#undef PG8_SB
#undef PG8_STAGE
#undef PG8_LDA
#undef PG8_LDB
#undef PG8_MMA
#undef PG8_WAIT_V
#undef PG8_WAIT_L
#undef PG8_BAR
#undef PG8_SCHED
}
}
typedef unsigned short bf16;
typedef float f32x4 __attribute__((ext_vector_type(4)));
typedef short bf16x8 __attribute__((ext_vector_type(8)));
typedef short s16x4 __attribute__((ext_vector_type(4)));
typedef unsigned u32x4 __attribute__((ext_vector_type(4)));
typedef unsigned u32x2 __attribute__((ext_vector_type(2)));
constexpr int NB = 16, SEQ = 2048, DM = 1024, CTXL = 256, NLAYER = 2;
constexpr int NGRP = 2, BG = NB / NGRP;
constexpr int LATG = BG * SEQ, CTXG = BG * CTXL, RG = LATG + CTXG;
constexpr int NIN = 7168, DFF = 2816, DFE = 3584, NEXP = 8, NMOD = 6 * DM;
constexpr int NHEAD = 16, HD = 64;
constexpr int MOE_TILES_MAX = 136, MOE_ROWS_MAX = MOE_TILES_MAX * 256;
constexpr float EPS = 1e-6f;
constexpr int NWAVES = 8, NTHR = 512;
constexpr size_t MiB = 1u << 20;
constexpr size_t WS_CTL = 0, CTL_ZERO_BYTES = 64 * 1024;
constexpr size_t WS_MOD = 1 * MiB;
constexpr size_t WS_MISC = 2 * MiB;
constexpr size_t WS_XC = 4 * MiB;
constexpr size_t WS_WIN = 20 * MiB;
constexpr size_t WS_WRO = 48 * MiB, WS_WNO = 52 * MiB, WS_WOUT = 56 * MiB;
constexpr size_t WS_WF13 = 60 * MiB;
constexpr size_t WS_WF2 = 71 * MiB;
constexpr size_t WS_WM13 = 77 * MiB;
constexpr size_t WS_WM2 = 189 * MiB;
constexpr size_t WS_ARENA = 245 * MiB;
constexpr size_t SLAB = (size_t)RG * DM * 2;
static_assert(SLAB == 36 * MiB, "slab");
constexpr size_t A_H = WS_ARENA + 0 * SLAB;
constexpr size_t A_XR = WS_ARENA + 1 * SLAB;
constexpr size_t A_KB = WS_ARENA + 2 * SLAB;
constexpr size_t A_VT = WS_ARENA + 3 * SLAB;
constexpr size_t A_YG = WS_ARENA + 4 * SLAB;
constexpr size_t A_QB = WS_ARENA + 5 * SLAB;
constexpr size_t A_SR = WS_ARENA + 6 * SLAB;
constexpr size_t A_SN = WS_ARENA + 7 * SLAB;
constexpr size_t A_YN = WS_ARENA + 8 * SLAB;
constexpr size_t A_T1 = WS_ARENA + 9 * SLAB;
constexpr size_t A_H2 = WS_ARENA, A_ACT = WS_ARENA + SLAB;
constexpr size_t A_AM = WS_ARENA;
constexpr size_t A_ACTM = WS_ARENA + 68 * MiB;
constexpr size_t A_Y = WS_ARENA + 306 * MiB;
constexpr size_t A_H2M = A_Y;
constexpr size_t WS_END = WS_ARENA + 374 * MiB;
static_assert((size_t)MOE_ROWS_MAX * DM * 2 == 68 * MiB && (size_t)MOE_ROWS_MAX * DFE * 2 == 238 * MiB, "moe map");
static_assert(A_T1 + SLAB <= WS_END, "mixer map");
constexpr size_t MS_TOFF = 0;
constexpr size_t MS_CNT = 4096;
constexpr size_t MS_ROUTE_E = 16384;
constexpr size_t MS_ROUTE_W = 16384 + 65536;
constexpr size_t MS_TOKSLOT = MS_ROUTE_W + 131072;
constexpr size_t MS_SLOTW = MS_TOKSLOT + 131072;
static_assert(MS_SLOTW + MOE_ROWS_MAX * 4 <= 2 * MiB, "misc map");
constexpr int CW_BAR = 1024;
static_assert((CW_BAR + XCD_BAR_WORDS) * 4 <= (int)CTL_ZERO_BYTES, "ctl");
constexpr int RING_BYTES = 131072, MISC_OFF = RING_BYTES, LDS_BYTES = 147456;

__device__ __forceinline__ unsigned f2bf(float f) { unsigned u = __builtin_bit_cast(unsigned, f); return (u + 0x7fffu + ((u >> 16) & 1u)) >> 16; }
__device__ __forceinline__ unsigned pk2(float lo, float hi) { return f2bf(lo) | (f2bf(hi) << 16); }
__device__ __forceinline__ float bf2f(unsigned short b) { return __builtin_bit_cast(float, ((unsigned)b) << 16); }
__device__ __forceinline__ float bflo(unsigned w) { return __builtin_bit_cast(float, w << 16); }
__device__ __forceinline__ float bfhi(unsigned w) { return __builtin_bit_cast(float, w & 0xffff0000u); }
__device__ __forceinline__ float wave_sum(float v) {
#pragma unroll
    for (int o = 1; o < 64; o <<= 1) v += __shfl_xor(v, o);
    return v;
}
__device__ __forceinline__ float sigmoidf_(float x) { return __builtin_amdgcn_rcpf(1.0f + __builtin_amdgcn_exp2f(-1.44269504f * x)); }
__device__ __forceinline__ float siluf_(float x) { return x * sigmoidf_(x); }
__device__ __forceinline__ float gelu_tanh_(float x) { const float u = 0.7978845608f * (x + 0.044715f * x * x * x); return x * sigmoidf_(2.0f * u); }
#define LDS_WAIT() asm volatile("s_waitcnt lgkmcnt(0)" ::: "memory")

struct Args { const float* in[25]; float* out; unsigned char* ws; int ph_lo, ph_hi; };
enum { I_X = 0, I_C, I_CTX, I_CCTX, I_WMOD, I_BMOD, I_WIN, I_CONVW, I_CONVB, I_LAM, I_RGW, I_RGB, I_QG, I_KG, I_RPB, I_WRO, I_WNO, I_WOUT, I_F1, I_F3, I_F2, I_ROUTER, I_M1, I_M3, I_M2 };

__device__ __forceinline__ int map_row(int mode, int n) {
    if (mode == 1) { const int t = n >> 8, cl = n & 255, wc = cl >> 6, bj = (cl >> 5) & 1, j = cl & 31; return (t << 8) + 128 * bj + 32 * wc + j; }
    if (mode == 2) return ((n >> 7) << 8) + (n & 127);
    if (mode == 3) return ((n >> 7) << 8) + 128 + (n & 127);
    return n;
}
__device__ __forceinline__ void transpose_item(const float* __restrict__ W, int K, int N, bf16* __restrict__ WT, int mode, float* scr, int item, int lane) {
    const int nblk = N / 32, kb = item / nblk, nb = item % nblk, k0 = 64 * kb, n0 = 32 * nb;
#pragma unroll 8
    for (int i = 0; i < 32; ++i) { const int kk = 2 * i + (lane >> 5); scr[kk * 33 + (lane & 31)] = W[(size_t)(k0 + kk) * N + n0 + (lane & 31)]; }
    LDS_WAIT(); asm volatile("" ::: "memory");
    const int c = lane & 7;
#pragma unroll
    for (int j = 0; j < 4; ++j) { const int n = (lane >> 3) + 8 * j; const float* s = scr + (8 * c) * 33 + n;
        u32x4 o; o.x = pk2(s[0 * 33], s[1 * 33]); o.y = pk2(s[2 * 33], s[3 * 33]); o.z = pk2(s[4 * 33], s[5 * 33]); o.w = pk2(s[6 * 33], s[7 * 33]);
        *(u32x4*)(WT + (size_t)map_row(mode, n0 + n) * K + k0 + 8 * c) = o; }
    LDS_WAIT(); asm volatile("" ::: "memory");
}
__device__ __forceinline__ void phase_prologue(const Args& a, unsigned char* lds, int blk, int G, int wave, int lane, int tid) {
    unsigned char* ws = a.ws;
    float* scr = (float*)(lds + wave * 16384);
    const int gw = blk * NWAVES + wave, NGW = G * NWAVES;
    constexpr int IT_IN = (DM / 64) * (NIN / 32), IT_SQ = (DM / 64) * (DM / 32), IT_F1 = (DM / 64) * (DFF / 32), IT_F2 = (DFF / 64) * (DM / 32), IT_M1 = (DM / 64) * (DFE / 32), IT_M2 = (DFE / 64) * (DM / 32);
    constexpr int N_IN = 2 * IT_IN, N_SQ = 6 * IT_SQ, N_F = 2 * IT_F1 + IT_F2, N_M13 = 16 * IT_M1, N_M2 = 8 * IT_M2;
    constexpr int NITEMS = N_IN + N_SQ + N_F + N_M13 + N_M2;
    for (int it = gw; it < NITEMS; it += NGW) {
        int r = it;
        if (r < N_IN) { const int l = r / IT_IN; transpose_item(a.in[I_WIN] + (size_t)l * DM * NIN, DM, NIN, (bf16*)(ws + WS_WIN) + (size_t)l * NIN * DM, 1, scr, r % IT_IN, lane); continue; } r -= N_IN;
        if (r < N_SQ) { const int m = r / IT_SQ, which = m >> 1, l = m & 1; const float* src = a.in[which == 0 ? I_WRO : (which == 1 ? I_WNO : I_WOUT)] + (size_t)l * DM * DM;
            bf16* dst = (bf16*)(ws + (which == 0 ? WS_WRO : (which == 1 ? WS_WNO : WS_WOUT))) + (size_t)l * DM * DM; transpose_item(src, DM, DM, dst, 0, scr, r % IT_SQ, lane); continue; } r -= N_SQ;
        if (r < N_F) { if (r < IT_F1) transpose_item(a.in[I_F1], DM, DFF, (bf16*)(ws + WS_WF13), 2, scr, r, lane);
            else if (r < 2 * IT_F1) transpose_item(a.in[I_F3], DM, DFF, (bf16*)(ws + WS_WF13), 3, scr, r - IT_F1, lane);
            else transpose_item(a.in[I_F2], DFF, DM, (bf16*)(ws + WS_WF2), 0, scr, r - 2 * IT_F1, lane); continue; } r -= N_F;
        if (r < N_M13) { const int m = r / IT_M1, e = m >> 1, up = m & 1; transpose_item(a.in[up ? I_M3 : I_M1] + (size_t)e * DM * DFE, DM, DFE, (bf16*)(ws + WS_WM13) + (size_t)e * 2 * DFE * DM, up ? 3 : 2, scr, r % IT_M1, lane); continue; } r -= N_M13;
        { const int e = r / IT_M2; transpose_item(a.in[I_M2] + (size_t)e * DFE * DM, DFE, DM, (bf16*)(ws + WS_WM2) + (size_t)e * DM * DFE, 0, scr, r % IT_M2, lane); }
    }
    __syncthreads();
    float* sc = (float*)lds;
    float* red = (float*)(lds + 17 * 1024 * 4);
    bool have = false;
    for (int u = blk; u < 2 * (NMOD / 64); u += G) {
        if (!have) { for (int i = tid; i < 17 * 1024; i += NTHR) { const float v = (i < 16 * 1024) ? a.in[I_C][i] : a.in[I_CCTX][i - 16 * 1024]; sc[i] = siluf_(v); } have = true; }
        __syncthreads();
        const int l = u / (NMOD / 64), n0 = (u % (NMOD / 64)) * 64;
        const float* wm = a.in[I_WMOD] + (size_t)l * DM * NMOD + n0 + lane;
        float acc[17];
#pragma unroll
        for (int r = 0; r < 17; ++r) acc[r] = 0.f;
        for (int k = wave * 128; k < wave * 128 + 128; ++k) { const float w = wm[(size_t)k * NMOD];
#pragma unroll
            for (int r = 0; r < 17; ++r) acc[r] += sc[r * 1024 + k] * w; }
#pragma unroll
        for (int r = 0; r < 17; ++r) red[(wave * 17 + r) * 64 + lane] = acc[r];
        __syncthreads();
        for (int i = tid; i < 17 * 64; i += NTHR) { const int r = i >> 6, c = i & 63; float s = 0.f;
#pragma unroll
            for (int w = 0; w < 8; ++w) s += red[(w * 17 + r) * 64 + c];
            ((float*)(ws + WS_MOD))[((size_t)l * 17 + r) * NMOD + n0 + c] = s + a.in[I_BMOD][l * NMOD + n0 + c]; }
    }
    __syncthreads();
}

template <bool ROUTE>
__device__ __forceinline__ void modulate_row(const float* __restrict__ xrow, const float* __restrict__ sh, const float* __restrict__ scl, bf16* __restrict__ orow, int lane,
                                             const float* __restrict__ router, int& e0o, int& e1o, float& w0o, float& w1o) {
    const f32x4* xr = (const f32x4*)xrow + lane;
    f32x4 v[4]; float ss = 0.f;
#pragma unroll
    for (int j = 0; j < 4; ++j) { v[j] = xr[64 * j]; ss += (v[j].x * v[j].x + v[j].y * v[j].y) + (v[j].z * v[j].z + v[j].w * v[j].w); }
    ss = wave_sum(ss);
    const float rinv = 1.0f / sqrtf(ss * (1.0f / DM) + EPS);
#pragma unroll
    for (int j = 0; j < 4; ++j) { const f32x4 s4 = ((const f32x4*)scl)[lane + 64 * j], h4 = ((const f32x4*)sh)[lane + 64 * j]; v[j] = v[j] * rinv * (s4 + 1.0f) + h4; }
    unsigned long long* o8 = (unsigned long long*)orow + lane;
#pragma unroll
    for (int j = 0; j < 4; ++j) o8[64 * j] = (unsigned long long)pk2(v[j].x, v[j].y) | ((unsigned long long)pk2(v[j].z, v[j].w) << 32);
    if (ROUTE) {
        float lg[8];
#pragma unroll
        for (int e = 0; e < 8; ++e) lg[e] = 0.f;
#pragma unroll
        for (int j = 0; j < 4; ++j)
#pragma unroll
            for (int i = 0; i < 4; ++i) { const int col = 4 * lane + 256 * j + i; const f32x4 r0 = *(const f32x4*)(router + col * 8), r1 = *(const f32x4*)(router + col * 8 + 4); const float x = v[j][i];
                lg[0] += x * r0.x; lg[1] += x * r0.y; lg[2] += x * r0.z; lg[3] += x * r0.w; lg[4] += x * r1.x; lg[5] += x * r1.y; lg[6] += x * r1.z; lg[7] += x * r1.w; }
#pragma unroll
        for (int e = 0; e < 8; ++e) lg[e] = wave_sum(lg[e]);
        int e0 = 0; float v0 = lg[0];
#pragma unroll
        for (int e = 1; e < 8; ++e) if (lg[e] > v0) { v0 = lg[e]; e0 = e; }
        int e1 = -1; float v1 = -3.0e38f;
#pragma unroll
        for (int e = 0; e < 8; ++e) if (e != e0 && lg[e] > v1) { v1 = lg[e]; e1 = e; }
        const float w0 = 1.0f / (1.0f + __expf(v1 - v0));
        e0o = e0; e1o = e1; w0o = w0; w1o = 1.0f - w0;
    }
}
__device__ __forceinline__ void rect_unit(int L, int nM, int nN, int& pm, int& pn) {
    const int per = 8 * nN, gid = L / per, fm = gid * 8, gs = (nM - fm) < 8 ? (nM - fm) : 8, rem = L - gid * per;
    pm = fm + rem % gs; pn = rem / gs;
}
struct RectOrder {
    int nM0, nN0, nM1, nN1, G, c;
    __device__ __forceinline__ bool next(int i, pg8::Unit& u) const {
        int L = i * G + c; const int n0 = nM0 * nN0;
        if (L < n0) { rect_unit(L, nM0, nN0, u.pm, u.pn); return true; }
        L -= n0; if (L >= nM1 * nN1) return false;
        rect_unit(L, nM1, nN1, u.pm, u.pn); u.pm += nM0; return true;
    }
    __device__ __forceinline__ void a_ready(const pg8::Unit&) const {}
    __device__ __forceinline__ void done(const pg8::Unit&) const {}
};
struct MoeOrder {
    int nT, nN, G, c, t1, t2, t3, t4, t5, t6, t7;
    __device__ __forceinline__ bool next(int i, pg8::Unit& u) const {
        const int L = i * G + c; if (L >= nT * nN) return false;
        int pm, pn; rect_unit(L, nT, nN, pm, pn);
        const int e = (pm >= t1) + (pm >= t2) + (pm >= t3) + (pm >= t4) + (pm >= t5) + (pm >= t6) + (pm >= t7);
        u.pm = pm; u.pn = e * nN + pn; return true;
    }
    __device__ __forceinline__ void a_ready(const pg8::Unit&) const {}
    __device__ __forceinline__ void done(const pg8::Unit&) const {}
};

typedef pg8::f32x4 accv;
__device__ __forceinline__ u32x4 pack8(const accv& a, const accv& b) { u32x4 w; w.x = pg8::cvt_pk_bf16(a[0], a[1]); w.y = pg8::cvt_pk_bf16(a[2], a[3]); w.z = pg8::cvt_pk_bf16(b[0], b[1]); w.w = pg8::cvt_pk_bf16(b[2], b[3]); return w; }

struct EpiIn {
    static constexpr bool PERM = true, AFTER_DRAIN = false;
    unsigned char* ws; const float* qg; const float* kg;
    __device__ __forceinline__ void operator()(const accv (&acc)[2][2][4][2], const pg8::Unit& u, int wr, int wc, int fr_in, int fq) const {
        int fr = fr_in; asm volatile("" : "+v"(fr));
        const int part = u.pn >> 2, ht = (u.pn & 3) * 4 + wc;
        const int row0 = u.pm * 256 + wr * 64 + fr, colb = ht * 64 + 8 * fq;
        if (part == 2) {
            const bool isc = u.pm >= 64; const int bl = isc ? u.pm - 64 : (u.pm >> 3), T = isc ? CTXL : SEQ, t0 = (isc ? 0 : (u.pm & 7) * 256) + wr * 64 + fr;
            bf16* vt = (bf16*)(ws + A_VT) + (isc ? (size_t)LATG * DM : 0) + ((size_t)(bl * 16 + ht) * 64 + 8 * fq) * T + t0;
#pragma unroll
            for (int ai = 0; ai < 2; ++ai)
#pragma unroll
                for (int m = 0; m < 4; ++m)
#pragma unroll
                    for (int bj = 0; bj < 2; ++bj)
#pragma unroll
                        for (int n = 0; n < 2; ++n)
#pragma unroll
                            for (int j = 0; j < 4; ++j) vt[(size_t)(32 * bj + 4 * n + j) * T + ai * 128 + m * 16] = (bf16)f2bf(acc[ai][bj][m][n][j]);
            return;
        }
        bf16* dst = (bf16*)(ws + (part == 0 ? A_XR : part == 1 ? A_KB : part == 3 ? A_YG : part == 4 ? A_QB : part == 5 ? A_SR : A_SN));
        float gn[2][2][4];
        if (part == 1 || part == 4) { const float* gp = (part == 1 ? kg : qg) + 8 * fq; const float sc = (part == 4) ? 0.125f : 1.0f;
#pragma unroll
            for (int bj = 0; bj < 2; ++bj)
#pragma unroll
                for (int n = 0; n < 2; ++n)
#pragma unroll
                    for (int j = 0; j < 4; ++j) gn[bj][n][j] = gp[32 * bj + 4 * n + j] * sc; }
#pragma unroll
        for (int ai = 0; ai < 2; ++ai)
#pragma unroll
            for (int m = 0; m < 4; ++m) {
                accv v[2][2];
#pragma unroll
                for (int bj = 0; bj < 2; ++bj)
#pragma unroll
                    for (int n = 0; n < 2; ++n) v[bj][n] = acc[ai][bj][m][n];
                if (part == 1 || part == 4) {
                    float ss = 0.f;
#pragma unroll
                    for (int bj = 0; bj < 2; ++bj)
#pragma unroll
                        for (int n = 0; n < 2; ++n) ss += (v[bj][n][0] * v[bj][n][0] + v[bj][n][1] * v[bj][n][1]) + (v[bj][n][2] * v[bj][n][2] + v[bj][n][3] * v[bj][n][3]);
                    ss += __shfl_xor(ss, 16); ss += __shfl_xor(ss, 32);
                    const float rinv = 1.0f / sqrtf(ss * (1.0f / 64.0f) + EPS);
#pragma unroll
                    for (int bj = 0; bj < 2; ++bj)
#pragma unroll
                        for (int n = 0; n < 2; ++n)
#pragma unroll
                            for (int j = 0; j < 4; ++j) v[bj][n][j] = v[bj][n][j] * rinv * gn[bj][n][j];
                } else if (part == 3) {
#pragma unroll
                    for (int bj = 0; bj < 2; ++bj)
#pragma unroll
                        for (int n = 0; n < 2; ++n)
#pragma unroll
                            for (int j = 0; j < 4; ++j) v[bj][n][j] = gelu_tanh_(v[bj][n][j]);
                } else if (part >= 5) {
#pragma unroll
                    for (int bj = 0; bj < 2; ++bj)
#pragma unroll
                        for (int n = 0; n < 2; ++n)
#pragma unroll
                            for (int j = 0; j < 4; ++j) v[bj][n][j] = sigmoidf_(v[bj][n][j]);
                }
                bf16* rowp = dst + (size_t)(row0 + ai * 128 + m * 16) * DM + colb;
#pragma unroll
                for (int bj = 0; bj < 2; ++bj) *(u32x4*)(rowp + 32 * bj) = pack8(v[bj][0], v[bj][1]);
            }
    }
};
template <int MODE> struct EpiGate {
    static constexpr bool PERM = true, AFTER_DRAIN = false;
    const bf16* gate; const bf16* add; bf16* out;
    __device__ __forceinline__ void operator()(const accv (&acc)[2][2][4][2], const pg8::Unit& u, int wr, int wc, int fr_in, int fq) const {
        int fr = fr_in; asm volatile("" : "+v"(fr));
        const int row0 = u.pm * 256 + wr * 64 + fr, col0 = u.pn * 256 + wc * 32 + 8 * fq;
#pragma unroll
        for (int ai = 0; ai < 2; ++ai)
#pragma unroll
            for (int m = 0; m < 4; ++m) { const size_t ro = (size_t)(row0 + ai * 128 + m * 16) * DM + col0;
#pragma unroll
                for (int bj = 0; bj < 2; ++bj) {
                    const u32x4 gw = *(const u32x4*)(gate + ro + bj * 128);
                    accv v0 = acc[ai][bj][m][0], v1 = acc[ai][bj][m][1];
                    v0[0] *= bflo(gw.x); v0[1] *= bfhi(gw.x); v0[2] *= bflo(gw.y); v0[3] *= bfhi(gw.y); v1[0] *= bflo(gw.z); v1[1] *= bfhi(gw.z); v1[2] *= bflo(gw.w); v1[3] *= bfhi(gw.w);
                    if (MODE == 1) { const u32x4 aw = *(const u32x4*)(add + ro + bj * 128);
                        v0[0] += bflo(aw.x); v0[1] += bfhi(aw.x); v0[2] += bflo(aw.y); v0[3] += bfhi(aw.y); v1[0] += bflo(aw.z); v1[1] += bfhi(aw.z); v1[2] += bflo(aw.w); v1[3] += bfhi(aw.w); }
                    *(u32x4*)(out + ro + bj * 128) = pack8(v0, v1); } }
    }
};
struct EpiRes {
    static constexpr bool PERM = false, AFTER_DRAIN = false;
    const float* xold_lat; const float* xold_ctx; float* xnew_lat; float* xnew_ctx;
    const float* modl; int gchunk; int g;
    __device__ __forceinline__ void operator()(const accv (&acc)[2][2][4][2], const pg8::Unit& u, int wr, int wc, int fr_in, int fq) const {
        int fr = fr_in; asm volatile("" : "+v"(fr));
        const bool isc = u.pm >= 64; const int mrow = isc ? 16 : (g * BG + (u.pm >> 3));
        const int rbase = (isc ? (u.pm - 64) * 256 : u.pm * 256) + wr * 64 + fr, col0 = u.pn * 256 + wc * 32 + 4 * fq;
        const float* xo = (isc ? xold_ctx : xold_lat) + (size_t)rbase * DM + col0; float* xn = (isc ? xnew_ctx : xnew_lat) + (size_t)rbase * DM + col0;
        const float* gp = modl + (size_t)mrow * NMOD + gchunk * DM + col0;
#pragma unroll
        for (int bj = 0; bj < 2; ++bj)
#pragma unroll
            for (int n = 0; n < 2; ++n) { const accv gv = *(const accv*)(gp + bj * 128 + n * 16);
#pragma unroll
                for (int ai = 0; ai < 2; ++ai) {
#pragma unroll
                    for (int m = 0; m < 4; ++m) { const size_t ro = (size_t)(ai * 128 + m * 16) * DM + bj * 128 + n * 16; const accv xv = *(const accv*)(xo + ro); *(accv*)(xn + ro) = xv + gv * acc[ai][bj][m][n]; }
                    asm volatile("" ::: "memory"); } }
    }
};
template <bool MOE> struct EpiSwi {
    static constexpr bool PERM = true, AFTER_DRAIN = false;
    bf16* out; int ldc; int nN; const float* roww;
    __device__ __forceinline__ void operator()(const accv (&acc)[2][2][4][2], const pg8::Unit& u, int wr, int wc, int fr_in, int fq) const {
        int fr = fr_in; asm volatile("" : "+v"(fr));
        const int pnl = MOE ? (u.pn % nN) : u.pn;
        const int row0 = u.pm * 256 + wr * 64 + fr, col0 = pnl * 128 + wc * 32 + 8 * fq;
#pragma unroll
        for (int ai = 0; ai < 2; ++ai)
#pragma unroll
            for (int m = 0; m < 4; ++m) { const int row = row0 + ai * 128 + m * 16; const float rw = MOE ? roww[row] : 1.0f;
                accv v0, v1;
#pragma unroll
                for (int j = 0; j < 4; ++j) { v0[j] = siluf_(acc[ai][0][m][0][j]) * acc[ai][1][m][0][j] * rw; v1[j] = siluf_(acc[ai][0][m][1][j]) * acc[ai][1][m][1][j] * rw; }
                *(u32x4*)(out + (size_t)row * ldc + col0) = pack8(v0, v1); asm volatile("" ::: "memory"); }
    }
};
struct EpiY {
    static constexpr bool PERM = true, AFTER_DRAIN = false;
    bf16* out; int nN;
    __device__ __forceinline__ void operator()(const accv (&acc)[2][2][4][2], const pg8::Unit& u, int wr, int wc, int fr_in, int fq) const {
        int fr = fr_in; asm volatile("" : "+v"(fr));
        const int pnl = u.pn % nN, row0 = u.pm * 256 + wr * 64 + fr, col0 = pnl * 256 + wc * 32 + 8 * fq;
#pragma unroll
        for (int ai = 0; ai < 2; ++ai)
#pragma unroll
            for (int m = 0; m < 4; ++m)
#pragma unroll
                for (int bj = 0; bj < 2; ++bj) *(u32x4*)(out + (size_t)(row0 + ai * 128 + m * 16) * DM + col0 + bj * 128) = pack8(acc[ai][bj][m][0], acc[ai][bj][m][1]);
    }
};
__device__ __forceinline__ void rglru_unit(const Args& a, unsigned char* lds, int l, int unit, bool ctx_out, int wave, int lane, int tid) {
    unsigned char* ws = a.ws;
    const int bl = unit >> 5, n = (unit >> 1) & 15, hf = unit & 1;
    const bf16* XR = (const bf16*)(ws + A_XR); bf16* YR = (bf16*)(ws + A_H); const bf16* YG = (const bf16*)(ws + A_YG);
    const int col = lane & 15, quad = lane >> 4;
    bf16* xcb = (bf16*)lds;
    float* xcf = (float*)(lds + 18432);
    float* wagg = (float*)(lds + 18432 + 128 * 65 * 4);
    const float* convw = a.in[I_CONVW] + (size_t)l * 4 * DM; const float* convb = a.in[I_CONVB] + (size_t)l * DM;
    for (int d = 0; d < 2; ++d) {
        bf16x8 Bf[2][2][2];
#pragma unroll
        for (int gt = 0; gt < 2; ++gt)
#pragma unroll
            for (int nb = 0; nb < 2; ++nb)
#pragma unroll
                for (int ks = 0; ks < 2; ++ks) { const float* wp = a.in[I_RGW] + ((size_t)((((l * 2 + d) * 2 + gt) * 16 + n) * 64 + 32 * ks + 8 * quad)) * 64 + 32 * hf + 16 * nb + col;
                    u32x4 w; w.x = pk2(wp[0], wp[64]); w.y = pk2(wp[128], wp[192]); w.z = pk2(wp[256], wp[320]); w.w = pk2(wp[384], wp[448]); Bf[gt][nb][ks] = __builtin_bit_cast(bf16x8, w); }
        float b0[2], b1[2], c8[2], hin[2];
#pragma unroll
        for (int nb = 0; nb < 2; ++nb) { const int c = 64 * n + 32 * hf + 16 * nb + col;
            b0[nb] = a.in[I_RGB][((l * 2 + d) * 2 + 0) * DM + c]; b1[nb] = a.in[I_RGB][((l * 2 + d) * 2 + 1) * DM + c];
            const float lam = a.in[I_LAM][(l * 2 + d) * DM + c]; c8[nb] = 8.0f * (fminf(lam, 0.f) - log1pf(__expf(-fabsf(lam)))); hin[nb] = 0.f; }
        for (int seq = 0; seq < 2; ++seq) {
            const int Lseq = seq ? SEQ : CTXL, rowbase = seq ? bl * SEQ : LATG + bl * CTXL; const bool store = (seq == 1) || ctx_out;
            for (int ch = 0; ch < Lseq / 128; ++ch) {
                {
                    const int sl = tid >> 2, cq = tid & 3, s = ch * 128 + sl, t = d ? Lseq - 1 - s : s, c0 = 64 * n + 16 * cq;
                    float xv[16];
#pragma unroll
                    for (int i4 = 0; i4 < 4; ++i4) { const f32x4 bb = *(const f32x4*)(convb + c0 + 4 * i4); xv[4 * i4] = bb.x; xv[4 * i4 + 1] = bb.y; xv[4 * i4 + 2] = bb.z; xv[4 * i4 + 3] = bb.w; }
#pragma unroll
                    for (int j = 0; j < 4; ++j) { const int tt = t - 2 + j;
                        if (tt >= 0 && tt < Lseq) { const u32x4 x0 = *(const u32x4*)(XR + (size_t)(rowbase + tt) * DM + c0), x1 = *(const u32x4*)(XR + (size_t)(rowbase + tt) * DM + c0 + 8);
                            const unsigned xw[8] = {x0.x, x0.y, x0.z, x0.w, x1.x, x1.y, x1.z, x1.w};
#pragma unroll
                            for (int i4 = 0; i4 < 4; ++i4) { const f32x4 w4 = *(const f32x4*)(convw + j * DM + c0 + 4 * i4);
                                xv[4 * i4] += w4.x * bflo(xw[2 * i4]); xv[4 * i4 + 1] += w4.y * bfhi(xw[2 * i4]); xv[4 * i4 + 2] += w4.z * bflo(xw[2 * i4 + 1]); xv[4 * i4 + 3] += w4.w * bfhi(xw[2 * i4 + 1]); } } }
                    u32x4 o0, o1; o0.x = pk2(xv[0], xv[1]); o0.y = pk2(xv[2], xv[3]); o0.z = pk2(xv[4], xv[5]); o0.w = pk2(xv[6], xv[7]); o1.x = pk2(xv[8], xv[9]); o1.y = pk2(xv[10], xv[11]); o1.z = pk2(xv[12], xv[13]); o1.w = pk2(xv[14], xv[15]);
                    *(u32x4*)(xcb + sl * 72 + 16 * cq) = o0; *(u32x4*)(xcb + sl * 72 + 16 * cq + 8) = o1;
#pragma unroll
                    for (int i = 0; i < 16; ++i) xcf[sl * 65 + 16 * cq + i] = xv[i];
                }
                __syncthreads();
                const bf16x8 A0 = *(const bf16x8*)(xcb + (16 * wave + col) * 72 + 8 * quad), A1 = *(const bf16x8*)(xcb + (16 * wave + col) * 72 + 32 + 8 * quad);
                float hl[2][4], PP[2][4], EA[2], EH[2];
#pragma unroll
                for (int nb = 0; nb < 2; ++nb) {
                    accv g0 = {0.f, 0.f, 0.f, 0.f}, g1 = {0.f, 0.f, 0.f, 0.f};
                    g0 = __builtin_amdgcn_mfma_f32_16x16x32_bf16(A0, Bf[0][nb][0], g0, 0, 0, 0); g0 = __builtin_amdgcn_mfma_f32_16x16x32_bf16(A1, Bf[0][nb][1], g0, 0, 0, 0);
                    g1 = __builtin_amdgcn_mfma_f32_16x16x32_bf16(A0, Bf[1][nb][0], g1, 0, 0, 0); g1 = __builtin_amdgcn_mfma_f32_16x16x32_bf16(A1, Bf[1][nb][1], g1, 0, 0, 0);
                    float pa = 1.f, hh = 0.f;
#pragma unroll
                    for (int r = 0; r < 4; ++r) { const int sl = 16 * wave + 4 * quad + r;
                        const float rg = sigmoidf_(g0[r] + b0[nb]), ig = sigmoidf_(g1[r] + b1[nb]), la = c8[nb] * rg, av = __expf(la);
                        const float uu = sqrtf(-expm1f(2.0f * la)) * ig * xcf[sl * 65 + 32 * hf + 16 * nb + col];
                        hh = av * hh + uu; pa *= av; hl[nb][r] = hh; PP[nb][r] = pa; }
                    float IA = pa, IH = hh;
                    { const float pA = __shfl_up(IA, 16), pH = __shfl_up(IH, 16); if (quad >= 1) { IH = IA * pH + IH; IA = IA * pA; } }
                    { const float pA = __shfl_up(IA, 32), pH = __shfl_up(IH, 32); if (quad >= 2) { IH = IA * pH + IH; IA = IA * pA; } }
                    float eA = __shfl_up(IA, 16), eH = __shfl_up(IH, 16); if (quad == 0) { eA = 1.f; eH = 0.f; }
                    EA[nb] = eA; EH[nb] = eH;
                    if (quad == 3) { wagg[((wave * 2 + nb) * 16 + col) * 2] = IA; wagg[((wave * 2 + nb) * 16 + col) * 2 + 1] = IH; }
                }
                __syncthreads();
#pragma unroll
                for (int nb = 0; nb < 2; ++nb) {
                    float h = hin[nb], hw = 0.f;
#pragma unroll
                    for (int w = 0; w < 8; ++w) { if (w == wave) hw = h; const float wa = wagg[((w * 2 + nb) * 16 + col) * 2], wh = wagg[((w * 2 + nb) * 16 + col) * 2 + 1]; h = wa * h + wh; }
                    hin[nb] = h;
                    const float hs = EA[nb] * hw + EH[nb];
                    if (store) {
                        const int c = 64 * n + 32 * hf + 16 * nb + col;
#pragma unroll
                        for (int r = 0; r < 4; ++r) { const int s = ch * 128 + 16 * wave + 4 * quad + r, t = d ? Lseq - 1 - s : s; const size_t off = (size_t)(rowbase + t) * DM + c;
                            const float ht = hl[nb][r] + PP[nb][r] * hs;
                            if (d == 0) YR[off] = (bf16)f2bf(ht);
                            else YR[off] = (bf16)f2bf((bf2f(YR[off]) + ht) * bf2f(YG[off])); }
                    }
                }
                __syncthreads();
            }
        }
    }
}

__device__ __forceinline__ void attn_unit(const Args& a, int l, int wu, bool isc, int lane) {
    unsigned char* ws = a.ws;
    const bf16* QB = (const bf16*)(ws + A_QB); const bf16* KB = (const bf16*)(ws + A_KB); const bf16* VT = (const bf16*)(ws + A_VT); bf16* YN = (bf16*)(ws + A_YN);
    const int q = lane & 15, quad = lane >> 4;
    int bl, h, r = 0, j = 0, qrow0;
    if (!isc) { j = wu & 3; r = (wu >> 2) & 31; h = (wu >> 7) & 15; bl = wu >> 11; qrow0 = bl * SEQ + 64 * r + 16 * j; }
    else { const int qb = wu & 15; h = (wu >> 4) & 15; bl = wu >> 8; qrow0 = LATG + bl * CTXL + 16 * qb; }
    const bf16x8 Bq0 = *(const bf16x8*)(QB + (size_t)(qrow0 + q) * DM + 64 * h + 8 * quad), Bq1 = *(const bf16x8*)(QB + (size_t)(qrow0 + q) * DM + 64 * h + 32 + 8 * quad);
    accv S[32];
    const float NEG = -__builtin_inff();
    const int start = min(max(r - 4, 0), 24), kstart = min(max(16 * j - 8, 0), 32);
    if (!isc) {
        const int qc = 16 * j + q, wst = min(max(qc - 8, 0), 48);
        const float* rp = a.in[I_RPB] + (size_t)(l * 16 + h) * 15 * 31;
#pragma unroll
        for (int kb = 0; kb < 16; ++kb) { const int krow = start + (kb >> 1), hb = kb & 1, tok0 = 64 * krow + kstart + 16 * hb;
            const bf16* kp = KB + (size_t)(bl * SEQ + tok0 + q) * DM + 64 * h + 8 * quad;
            const bf16x8 K0 = *(const bf16x8*)kp, K1 = *(const bf16x8*)(kp + 32);
            accv s = {0.f, 0.f, 0.f, 0.f};
            s = __builtin_amdgcn_mfma_f32_16x16x32_bf16(K0, Bq0, s, 0, 0, 0); s = __builtin_amdgcn_mfma_f32_16x16x32_bf16(K1, Bq1, s, 0, 0, 0);
            const int ro = krow - r + 7;
#pragma unroll
            for (int rr = 0; rr < 4; ++rr) { const int kc = kstart + 16 * hb + 4 * quad + rr; const bool valid = (kc >= wst) && (kc < wst + 16); const int co = min(max(kc - qc + 15, 0), 30);
                s[rr] = valid ? s[rr] + rp[ro * 31 + co] : NEG; }
            S[kb] = s; }
    } else {
#pragma unroll
        for (int kb = 0; kb < 16; ++kb) S[kb] = (accv){NEG, NEG, NEG, NEG};
    }
    {
        const bf16* kc0 = KB + (size_t)(LATG + bl * CTXL + q) * DM + 64 * h + 8 * quad;
#pragma unroll
        for (int kb = 0; kb < 16; ++kb) { const bf16* kp = kc0 + (size_t)(16 * kb) * DM;
            const bf16x8 K0 = *(const bf16x8*)kp, K1 = *(const bf16x8*)(kp + 32);
            accv s = {0.f, 0.f, 0.f, 0.f};
            s = __builtin_amdgcn_mfma_f32_16x16x32_bf16(K0, Bq0, s, 0, 0, 0); s = __builtin_amdgcn_mfma_f32_16x16x32_bf16(K1, Bq1, s, 0, 0, 0);
            S[16 + kb] = s; }
    }
    float mx = NEG;
#pragma unroll
    for (int kb = 0; kb < 32; ++kb) mx = fmaxf(fmaxf(fmaxf(S[kb][0], S[kb][1]), fmaxf(S[kb][2], S[kb][3])), mx);
    mx = fmaxf(mx, __shfl_xor(mx, 16)); mx = fmaxf(mx, __shfl_xor(mx, 32));
    float sum = 0.f;
#pragma unroll
    for (int kb = 0; kb < 32; ++kb)
#pragma unroll
        for (int rr = 0; rr < 4; ++rr) { const float p = __builtin_amdgcn_exp2f((S[kb][rr] - mx) * 1.44269504f); S[kb][rr] = p; sum += p; }
    sum += __shfl_xor(sum, 16); sum += __shfl_xor(sum, 32);
    accv O[4];
#pragma unroll
    for (int db = 0; db < 4; ++db) O[db] = (accv){0.f, 0.f, 0.f, 0.f};
    if (!isc) {
        const bf16* vb = VT + ((size_t)(bl * 16 + h) * 64 + q) * SEQ + kstart + 4 * quad;
#pragma unroll
        for (int pi = 0; pi < 8; ++pi) { const int krow = start + pi;
            u32x4 pw; pw.x = pg8::cvt_pk_bf16(S[2 * pi][0], S[2 * pi][1]); pw.y = pg8::cvt_pk_bf16(S[2 * pi][2], S[2 * pi][3]); pw.z = pg8::cvt_pk_bf16(S[2 * pi + 1][0], S[2 * pi + 1][1]); pw.w = pg8::cvt_pk_bf16(S[2 * pi + 1][2], S[2 * pi + 1][3]);
            const bf16x8 Bp = __builtin_bit_cast(bf16x8, pw);
#pragma unroll
            for (int db = 0; db < 4; ++db) { const bf16* vp = vb + (size_t)(16 * db) * SEQ + 64 * krow;
                const u32x2 va = *(const u32x2*)vp, vbb = *(const u32x2*)(vp + 16); u32x4 vw; vw.x = va.x; vw.y = va.y; vw.z = vbb.x; vw.w = vbb.y;
                O[db] = __builtin_amdgcn_mfma_f32_16x16x32_bf16(__builtin_bit_cast(bf16x8, vw), Bp, O[db], 0, 0, 0); } }
    }
    {
        const bf16* vb = VT + (size_t)LATG * DM + ((size_t)(bl * 16 + h) * 64 + q) * CTXL + 4 * quad;
#pragma unroll
        for (int pi = 0; pi < 8; ++pi) {
            u32x4 pw; pw.x = pg8::cvt_pk_bf16(S[16 + 2 * pi][0], S[16 + 2 * pi][1]); pw.y = pg8::cvt_pk_bf16(S[16 + 2 * pi][2], S[16 + 2 * pi][3]); pw.z = pg8::cvt_pk_bf16(S[17 + 2 * pi][0], S[17 + 2 * pi][1]); pw.w = pg8::cvt_pk_bf16(S[17 + 2 * pi][2], S[17 + 2 * pi][3]);
            const bf16x8 Bp = __builtin_bit_cast(bf16x8, pw);
#pragma unroll
            for (int db = 0; db < 4; ++db) { const bf16* vp = vb + (size_t)(16 * db) * CTXL + 32 * pi;
                const u32x2 va = *(const u32x2*)vp, vbb = *(const u32x2*)(vp + 16); u32x4 vw; vw.x = va.x; vw.y = va.y; vw.z = vbb.x; vw.w = vbb.y;
                O[db] = __builtin_amdgcn_mfma_f32_16x16x32_bf16(__builtin_bit_cast(bf16x8, vw), Bp, O[db], 0, 0, 0); } }
    }
    const float inv = 1.0f / sum;
    bf16* op = YN + (size_t)(qrow0 + q) * DM + 64 * h + 4 * quad;
#pragma unroll
    for (int db = 0; db < 4; ++db) { u32x2 w; w.x = pk2(O[db][0] * inv, O[db][1] * inv); w.y = pk2(O[db][2] * inv, O[db][3] * inv); *(u32x2*)(op + 16 * db) = w; }
}
constexpr int NPH = 1 + NGRP * NLAYER * 12;
__host__ __device__ constexpr bool phase_used(int ph) { if (ph == 0) return true; const int k = (ph - 1) % 12, l = ((ph - 1) / 12) % 2; return l == 0 ? (k <= 8) : (k <= 10); }

__global__ void __launch_bounds__(NTHR, 2) fwd(Args a) {
    extern __shared__ __attribute__((aligned(16))) unsigned char lds[];
    const int tid = threadIdx.x, lane = tid & 63, wave = __builtin_amdgcn_readfirstlane(tid >> 6), G = gridDim.x, blk = blockIdx.x;
    unsigned char* ws = a.ws;
    if (tid < 16) ((unsigned*)(lds + MISC_OFF))[tid] = 0u;
    __syncthreads();
    XcdBarrier bar = xcd_barrier_post((unsigned*)(ws + WS_CTL) + CW_BAR, (volatile LAS unsigned*)(lds + MISC_OFF));
    const int lo = a.ph_lo, hi = a.ph_hi;
#ifndef PHMASK
#define PHMASK 0xFFFF
#endif
#define IN(k) (lo <= (k) && (k) < hi)
#define EN(k) ((PHMASK >> (k)) & 1)
#define SEAM(k) do { if ((k) + 1 < hi) xcd_barrier(bar); } while (0)
    PG8_LAS unsigned char* ring = (PG8_LAS unsigned char*)lds;

    if (EN(0) && IN(0)) { phase_prologue(a, lds, blk, G, wave, lane, tid); SEAM(0); }

    for (int g = 0; g < NGRP; ++g)
        for (int l = 0; l < NLAYER; ++l) {
            const int pb = 1 + (2 * g + l) * 12;
            if (hi <= pb || lo >= pb + 12) continue;
            int tid_l = threadIdx.x; asm volatile("" : "+v"(tid_l));
            const int tid = tid_l, lane = tid & 63, wave = __builtin_amdgcn_readfirstlane(tid >> 6);
            int blk_l = blockIdx.x, G_l = gridDim.x; asm volatile("" : "+s"(blk_l), "+s"(G_l));
            const int blk = blk_l, G = G_l;
            const bool ctx_out = (l == 0);
            const float* modl = (const float*)(ws + WS_MOD) + (size_t)l * 17 * NMOD;
            const float* xin_lat = (l == 0 ? a.in[I_X] : a.out) + (size_t)g * LATG * DM;
            const float* xin_ctx = (l == 0 ? a.in[I_CTX] : (const float*)(ws + WS_XC)) + (size_t)g * CTXG * DM;
            float* xs_lat = a.out + (size_t)g * LATG * DM;
            float* xs_ctx = (float*)(ws + WS_XC) + (size_t)g * CTXG * DM;
            const int gw = blk * NWAVES + wave, NGW = G * NWAVES;
            int dum_i; float dum_f;

            if (EN(1) && IN(pb + 0)) {
                bf16* H = (bf16*)(ws + A_H);
                for (int r = gw; r < RG; r += NGW) { const bool isc = r >= LATG; const int mrow = isc ? 16 : g * BG + r / SEQ;
                    const float* xr = isc ? xin_ctx + (size_t)(r - LATG) * DM : xin_lat + (size_t)r * DM;
                    modulate_row<false>(xr, modl + (size_t)mrow * NMOD + 0 * DM, modl + (size_t)mrow * NMOD + 1 * DM, H + (size_t)r * DM, lane, nullptr, dum_i, dum_i, dum_f, dum_f); }
                SEAM(pb + 0);
            }
            if (EN(2) && IN(pb + 1)) {
                pg8::Gemm gm{(const pg8::bf16_t*)(ws + A_H), (const pg8::bf16_t*)(ws + WS_WIN) + (size_t)l * NIN * DM, RG, NIN, DM};
                RectOrder S{64, 28, 8, ctx_out ? 28 : 12, G, blk};
                EpiIn E{ws, a.in[I_QG] + l * HD, a.in[I_KG] + l * HD};
                pg8::gemm_phase<EpiIn, RectOrder, false>(ring, gm, S, E, nullptr);
                SEAM(pb + 1);
            }
            if (EN(3) && IN(pb + 2)) {
                for (int u = blk; u < 256; u += G) rglru_unit(a, lds, l, u, ctx_out, wave, lane, tid);
                const int nlat = BG * NHEAD * 32 * 4, nctx = ctx_out ? BG * NHEAD * 16 : 0;
                for (int wu = gw; wu < nlat + nctx; wu += NGW) { if (wu < nlat) attn_unit(a, l, wu, false, lane); else attn_unit(a, l, wu - nlat, true, lane); }
                SEAM(pb + 2);
            }
            const int nMmix = ctx_out ? 72 : 64;
            if (EN(4) && IN(pb + 3)) {
                pg8::Gemm gm{(const pg8::bf16_t*)(ws + A_H), (const pg8::bf16_t*)(ws + WS_WRO) + (size_t)l * DM * DM, RG, DM, DM};
                RectOrder S{nMmix, 4, 0, 0, G, blk};
                EpiGate<0> E{(const bf16*)(ws + A_SR), nullptr, (bf16*)(ws + A_T1)};
                pg8::gemm_phase<EpiGate<0>, RectOrder, false>(ring, gm, S, E, nullptr);
                SEAM(pb + 3);
            }
            if (EN(5) && IN(pb + 4)) {
                pg8::Gemm gm{(const pg8::bf16_t*)(ws + A_YN), (const pg8::bf16_t*)(ws + WS_WNO) + (size_t)l * DM * DM, RG, DM, DM};
                RectOrder S{nMmix, 4, 0, 0, G, blk};
                EpiGate<1> E{(const bf16*)(ws + A_SN), (const bf16*)(ws + A_T1), (bf16*)(ws + A_XR)};
                pg8::gemm_phase<EpiGate<1>, RectOrder, false>(ring, gm, S, E, nullptr);
                SEAM(pb + 4);
            }
            if (EN(6) && IN(pb + 5)) {
                pg8::Gemm gm{(const pg8::bf16_t*)(ws + A_XR), (const pg8::bf16_t*)(ws + WS_WOUT) + (size_t)l * DM * DM, RG, DM, DM};
                RectOrder S{nMmix, 4, 0, 0, G, blk};
                EpiRes E{xin_lat, xin_ctx, xs_lat, xs_ctx, modl, 2, g};
                pg8::gemm_phase<EpiRes, RectOrder, false>(ring, gm, S, E, nullptr);
                SEAM(pb + 5);
            }
            if (EN(7) && IN(pb + 6)) {
                if (l == 0) {
                    bf16* H2 = (bf16*)(ws + A_H2);
                    for (int r = gw; r < RG; r += NGW) { const bool isc = r >= LATG; const int mrow = isc ? 16 : g * BG + r / SEQ;
                        const float* xr = isc ? xs_ctx + (size_t)(r - LATG) * DM : xs_lat + (size_t)r * DM;
                        modulate_row<false>(xr, modl + (size_t)mrow * NMOD + 3 * DM, modl + (size_t)mrow * NMOD + 4 * DM, H2 + (size_t)r * DM, lane, nullptr, dum_i, dum_i, dum_f, dum_f); }
                } else {
                    bf16* H2 = (bf16*)(ws + A_H2M); int* cntl = (int*)(lds + 1024);
                    int* re = (int*)(ws + WS_MISC + MS_ROUTE_E); float* rw = (float*)(ws + WS_MISC + MS_ROUTE_W); int* cntg = (int*)(ws + WS_MISC + MS_CNT);
                    for (int c = blk; c < LATG / 64; c += G) {
                        if (tid < 8) cntl[tid] = 0;
                        __syncthreads();
                        for (int i = 0; i < 8; ++i) { const int r = c * 64 + wave * 8 + i, mrow = g * BG + r / SEQ; int e0, e1; float w0, w1;
                            modulate_row<true>(xs_lat + (size_t)r * DM, modl + (size_t)mrow * NMOD + 3 * DM, modl + (size_t)mrow * NMOD + 4 * DM, H2 + (size_t)r * DM, lane, a.in[I_ROUTER], e0, e1, w0, w1);
                            if (lane == 0) { re[r] = e0 | (e1 << 8); rw[2 * r] = w0; rw[2 * r + 1] = w1; atomicAdd(&cntl[e0], 1); atomicAdd(&cntl[e1], 1); } }
                        __syncthreads();
                        if (tid < 8) cntg[c * 8 + tid] = cntl[tid];
                        __syncthreads();
                    }
                }
                SEAM(pb + 6);
            }
            if (EN(8) && IN(pb + 7)) {
                if (l == 0) {
                    pg8::Gemm gm{(const pg8::bf16_t*)(ws + A_H2), (const pg8::bf16_t*)(ws + WS_WF13), RG, 2 * DFF, DM};
                    RectOrder S{72, 22, 0, 0, G, blk};
                    EpiSwi<false> E{(bf16*)(ws + A_ACT), DFF, 22, nullptr};
                    pg8::gemm_phase<EpiSwi<false>, RectOrder, false>(ring, gm, S, E, nullptr);
                } else {
                    int* pre = (int*)lds;
                    int* toff = (int*)(lds + 8192);
                    int* plist = (int*)(lds + 8192 + 128);
                    const int* cntg = (const int*)(ws + WS_MISC + MS_CNT); const int* re = (const int*)(ws + WS_MISC + MS_ROUTE_E); const float* rw = (const float*)(ws + WS_MISC + MS_ROUTE_W);
                    int* tokslot = (int*)(ws + WS_MISC + MS_TOKSLOT); float* slotw = (float*)(ws + WS_MISC + MS_SLOTW);
                    const bf16* H2 = (const bf16*)(ws + A_H2M); bf16* AM = (bf16*)(ws + A_AM);
                    for (int i = tid; i < 2048; i += NTHR) pre[i] = cntg[i];
                    __syncthreads();
                    if (tid < 8) { int run = 0; for (int c = 0; c < 256; ++c) { const int v = pre[c * 8 + tid]; pre[c * 8 + tid] = run; run += v; } toff[10 + tid] = run; }
                    __syncthreads();
                    if (tid == 0) { int t = 0; for (int e = 0; e < 8; ++e) { toff[e] = t; t += (toff[10 + e] + 255) >> 8; } toff[8] = t; toff[9] = t;
                        if (blk == 0) { int* tg = (int*)(ws + WS_MISC + MS_TOFF); for (int e = 0; e < 10; ++e) tg[e] = toff[e]; } }
                    __syncthreads();
                    for (int c = blk; c < LATG / 64; c += G) {
                        if (wave == 0) { const int r = c * 64 + lane, ee = re[r], e0 = ee & 255, e1 = ee >> 8; int s0 = 0, s1 = 0;
                            const unsigned long long lt = (1ull << lane) - 1ull;
#pragma unroll
                            for (int e = 0; e < 8; ++e) { const unsigned long long m0 = __ballot(e0 == e), m1 = __ballot(e1 == e);
                                const int base = toff[e] * 256 + pre[c * 8 + e];
                                if (e0 == e) s0 = base + __popcll(m0 & lt);
                                if (e1 == e) s1 = base + __popcll(m0) + __popcll(m1 & lt); }
                            tokslot[2 * r] = s0; tokslot[2 * r + 1] = s1; slotw[s0] = rw[2 * r]; slotw[s1] = rw[2 * r + 1];
                            plist[4 * lane] = s0; plist[4 * lane + 1] = r; plist[4 * lane + 2] = s1; plist[4 * lane + 3] = r; }
                        __syncthreads();
                        for (int p = wave * 16; p < wave * 16 + 16; ++p) { const int slot = plist[2 * p], r = plist[2 * p + 1];
                            const u32x4* src = (const u32x4*)(H2 + (size_t)r * DM); u32x4* dst = (u32x4*)(AM + (size_t)slot * DM);
                            dst[lane] = src[lane]; dst[64 + lane] = src[64 + lane]; }
                        __syncthreads();
                    }
                }
                SEAM(pb + 7);
            }
            if (EN(9) && IN(pb + 8)) {
                if (l == 0) {
                    pg8::Gemm gm{(const pg8::bf16_t*)(ws + A_ACT), (const pg8::bf16_t*)(ws + WS_WF2), RG, DM, DFF};
                    RectOrder S{72, 4, 0, 0, G, blk};
                    EpiRes E{xs_lat, xs_ctx, xs_lat, xs_ctx, modl, 5, g};
                    pg8::gemm_phase<EpiRes, RectOrder, false>(ring, gm, S, E, nullptr);
                } else {
                    const int* tg = (const int*)(ws + WS_MISC + MS_TOFF);
                    pg8::Gemm gm{(const pg8::bf16_t*)(ws + A_AM), (const pg8::bf16_t*)(ws + WS_WM13), MOE_ROWS_MAX, 2 * DFE, DM};
                    MoeOrder S{tg[8], 28, G, blk, tg[1], tg[2], tg[3], tg[4], tg[5], tg[6], tg[7]};
                    EpiSwi<true> E{(bf16*)(ws + A_ACTM), DFE, 28, (const float*)(ws + WS_MISC + MS_SLOTW)};
                    pg8::gemm_phase<EpiSwi<true>, MoeOrder, false>(ring, gm, S, E, nullptr);
                }
                SEAM(pb + 8);
            }
            if (EN(10) && IN(pb + 9) && l == 1) {
                const int* tg = (const int*)(ws + WS_MISC + MS_TOFF);
                pg8::Gemm gm{(const pg8::bf16_t*)(ws + A_ACTM), (const pg8::bf16_t*)(ws + WS_WM2), MOE_ROWS_MAX, DM, DFE};
                MoeOrder S{tg[8], 4, G, blk, tg[1], tg[2], tg[3], tg[4], tg[5], tg[6], tg[7]};
                EpiY E{(bf16*)(ws + A_Y), 4};
                pg8::gemm_phase<EpiY, MoeOrder, false>(ring, gm, S, E, nullptr);
                SEAM(pb + 9);
            }
            if (EN(11) && IN(pb + 10) && l == 1) {
                const int* tokslot = (const int*)(ws + WS_MISC + MS_TOKSLOT); const bf16* Y = (const bf16*)(ws + A_Y);
                for (int r = gw; r < LATG; r += NGW) { const int s0 = tokslot[2 * r], s1 = tokslot[2 * r + 1], mrow = g * BG + r / SEQ;
                    const float* gp = modl + (size_t)mrow * NMOD + 5 * DM; float* xr = xs_lat + (size_t)r * DM;
#pragma unroll
                    for (int j = 0; j < 4; ++j) { const int col = 4 * lane + 256 * j;
                        const u32x2 y0 = *(const u32x2*)(Y + (size_t)s0 * DM + col), y1 = *(const u32x2*)(Y + (size_t)s1 * DM + col);
                        const f32x4 gv = *(const f32x4*)(gp + col); f32x4 xv = *(const f32x4*)(xr + col);
                        xv.x += gv.x * (bflo(y0.x) + bflo(y1.x)); xv.y += gv.y * (bfhi(y0.x) + bfhi(y1.x)); xv.z += gv.z * (bflo(y0.y) + bflo(y1.y)); xv.w += gv.w * (bfhi(y0.y) + bfhi(y1.y));
                        *(f32x4*)(xr + col) = xv; } }
                SEAM(pb + 10);
            }
        }
#undef IN
#undef SEAM
}

extern "C" void kernel_launch(void* const* d_in, const int* in_sizes, int n_in, void* d_out, int out_size, void* d_ws, size_t ws_size, hipStream_t stream) {
    static int grid = 0;
    if (grid == 0) {
        if (n_in != 25 || out_size != NB * SEQ * DM || ws_size < WS_END) { fprintf(stderr, "kernel_launch: unexpected shapes (n_in %d, out %d, ws %zu < %zu)\n", n_in, out_size, ws_size, (size_t)WS_END); grid = -1; return; }
        int dev = 0, cus = 0, per_cu = 0;
        if (hipGetDevice(&dev) != hipSuccess || hipDeviceGetAttribute(&cus, hipDeviceAttributeMultiprocessorCount, dev) != hipSuccess) { grid = -1; return; }
        if (hipFuncSetAttribute((const void*)fwd, hipFuncAttributeMaxDynamicSharedMemorySize, LDS_BYTES) != hipSuccess) { fprintf(stderr, "kernel_launch: hipFuncSetAttribute failed\n"); grid = -1; return; }
        if (hipOccupancyMaxActiveBlocksPerMultiprocessor(&per_cu, (const void*)fwd, NTHR, LDS_BYTES) != hipSuccess || per_cu < 1) fprintf(stderr, "kernel_launch: occupancy query reports %d\n", per_cu);
        (void)hipGetLastError();
        grid = cus;
    }
    if (grid < 0) return;
    if (hipMemsetAsync((char*)d_ws + WS_CTL, 0, CTL_ZERO_BYTES, stream) != hipSuccess) return;
    Args a{};
    for (int i = 0; i < 25; ++i) a.in[i] = (const float*)d_in[i];
    a.out = (float*)d_out; a.ws = (unsigned char*)d_ws;
#if MK_ONE_LAUNCH
    a.ph_lo = 0; a.ph_hi = NPH;
    hipLaunchKernelGGL(fwd, dim3(grid), dim3(NTHR), LDS_BYTES, stream, a);
#else
    for (int ph = 0; ph < NPH; ++ph) { if (!phase_used(ph)) continue; a.ph_lo = ph; a.ph_hi = ph + 1; hipLaunchKernelGGL(fwd, dim3(grid), dim3(NTHR), LDS_BYTES, stream, a); }
#endif
}
```

```cpp
#include <hip/hip_runtime.h>
#include <cstdio>
#include <cstdint>
#include <type_traits>
#ifndef MK_ONE_LAUNCH
#define MK_ONE_LAUNCH 1
#endif
#define XB_TMO      128
#define XB_XCNT(j)  (256  + 64 * (j))
#define XB_XSUB(j)  (1280 + 64 * (j))
#define XB_XGEN(j)  (2304 + 64 * (j))
#define XB_TOP      3328
#define XB_TOPGEN   3392
#define XCD_BAR_WORDS 3456
#define XB_SPIN_CAP (1u << 22)
#define LAS __attribute__((address_space(3)))

__device__ __forceinline__ unsigned xb_ld(unsigned* p)              { return __hip_atomic_load(p, __ATOMIC_RELAXED, __HIP_MEMORY_SCOPE_AGENT); }
__device__ __forceinline__ unsigned xb_add(unsigned* p, unsigned v) { return __hip_atomic_fetch_add(p, v, __ATOMIC_RELAXED, __HIP_MEMORY_SCOPE_AGENT); }
__device__ __forceinline__ unsigned xb_xcc_id() { return (unsigned)__builtin_amdgcn_s_getreg((3 << 11) | 20) & 0xFu; }
#define XB_SPIN(cond, bar) do { unsigned _sp = 0; while (cond) { __builtin_amdgcn_s_sleep(1); \
    if ((++_sp & 255u) == 0u) { if (xb_ld(&(bar)[XB_TMO])) break; if (_sp > XB_SPIN_CAP) { atomicAdd(&(bar)[XB_TMO], 1u); break; } } } } while (0)

struct XcdBarrier {
    unsigned* bar; unsigned x;
    volatile LAS unsigned* st;
};

__device__ __forceinline__ XcdBarrier xcd_barrier_post(unsigned* bar, volatile LAS unsigned* st) {
    XcdBarrier b; b.bar = bar; b.x = xb_xcc_id(); b.st = st;
    if (threadIdx.x == 0) (void)xb_add(&bar[XB_XCNT(b.x)], 1u);
    return b;
}
__device__ __forceinline__ void xcd_barrier_complete(unsigned* bar, unsigned x, unsigned& nloc, unsigned& nx) {
    const unsigned G = gridDim.x * gridDim.y * gridDim.z;
    unsigned sum, cnt, mine, sp = 0u;
    for (;;) {
        sum = 0u; cnt = 0u; mine = 0u;
#pragma unroll
        for (unsigned j = 0; j < 16; ++j) { const unsigned c = xb_ld(&bar[XB_XCNT(j)]); sum += c; cnt += (c > 0u) ? 1u : 0u; mine = (j == x) ? c : mine; }
        if (sum == G) break;
        __builtin_amdgcn_s_sleep(1);
        if ((++sp & 255u) == 0u) { if (xb_ld(&bar[XB_TMO])) break; if (sp > XB_SPIN_CAP) { atomicAdd(&bar[XB_TMO], 1u); break; } }
    }
    nloc = mine > 0u ? mine : 1u; nx = cnt > 0u ? cnt : 1u;
}

__device__ __forceinline__ void xcd_barrier(const XcdBarrier& b) {
    asm volatile("s_waitcnt vmcnt(0)" ::: "memory");
    __syncthreads();
    if (threadIdx.x == 0) {
        unsigned* bar = b.bar;
        __builtin_amdgcn_s_waitcnt(0);
        unsigned nloc = b.st[0], nx = b.st[1];
        if (nloc == 0u) { xcd_barrier_complete(bar, b.x, nloc, nx); b.st[0] = nloc; b.st[1] = nx; }
        const unsigned old = xb_add(&bar[XB_XSUB(b.x)], 1u);
        const unsigned gen = old / nloc;
        if (old + 1u == (gen + 1u) * nloc) {
            __builtin_amdgcn_fence(__ATOMIC_RELEASE, "agent");
            asm volatile("s_waitcnt vmcnt(0)" ::: "memory");
            const unsigned og = xb_add(&bar[XB_TOP], 1u);
            const unsigned tg = og / nx;
            if (og + 1u == (tg + 1u) * nx) xb_add(&bar[XB_TOPGEN], 1u);
            else XB_SPIN(xb_ld(&bar[XB_TOPGEN]) == tg, bar);
            __builtin_amdgcn_fence(__ATOMIC_ACQUIRE, "agent");
            xb_add(&bar[XB_XGEN(b.x)], 1u);
            asm volatile("s_waitcnt vmcnt(0)" ::: "memory");
        } else {
            XB_SPIN(xb_ld(&bar[XB_XGEN(b.x)]) == gen, bar);
            __builtin_amdgcn_fence(__ATOMIC_ACQUIRE, "agent");
            asm volatile("s_waitcnt vmcnt(0)" ::: "memory");
        }
    }
    __syncthreads();
}

namespace pg8 {
#define PG8_LAS __attribute__((address_space(3)))
typedef unsigned short bf16_t;
typedef short bf16x8 __attribute__((ext_vector_type(8)));
typedef float f32x4 __attribute__((ext_vector_type(4)));
typedef unsigned u32x4 __attribute__((ext_vector_type(4)));
constexpr int BM = 256, BK = 64, HALF = 128, HTB = HALF * BK * 2  , STAGE_BYTES = 8 * HTB, NXCD = 8, WGM = 8;

__host__ __device__ __forceinline__ int lds_byte(int r, int c) { const int st = (r >> 4) * 2 + (c >> 5), rr = r & 15, cc = c & 31, ob = rr * 64 + cc * 2; return st * 1024 + (ob ^ (((ob >> 9) & 1) << 5)); }
__host__ __device__ __forceinline__ void stage_rc(int b, int& R, int& C) { const int st = b / 1024, sb = b % 1024, swz = sb ^ (((sb >> 9) & 1) << 5); R = (st >> 1) * 16 + swz / 64; C = (st & 1) * 32 + (swz % 64) / 2; }
__host__ __device__ __forceinline__ int perm32(int rho) { const int n = rho >> 4, i = rho & 15; return 8 * (i >> 2) + 4 * n + (i & 3); }

struct Unit { int pm, pn, koff, nt; };
struct Gemm { const bf16_t* A; const bf16_t* Bt; int M, N, K, ld; };
__device__ __forceinline__ unsigned cvt_pk_bf16(float lo, float hi) { unsigned r; asm volatile("v_cvt_pk_bf16_f32 %0, %1, %2" : "=v"(r) : "v"(lo), "v"(hi)); return r; }
typedef float f32x2 __attribute__((ext_vector_type(2)));
template <class Epi, class Sched, bool STAMP = false>
__device__ __forceinline__ void gemm_phase(PG8_LAS unsigned char* lds, const Gemm g, const Sched& S, const Epi& E, unsigned long long* stamps, int tid_in) {
    int tid_l = tid_in; asm volatile("" : "+v"(tid_l));
    const int tid = tid_l, wid = __builtin_amdgcn_readfirstlane(tid >> 6), lane = tid & 63, wr = wid >> 2, wc = wid & 3, fr = lane & 15, fq = lane >> 4;
    const int K = g.ld;
    int ts_lo = 0, ts_hi = 0, nts = 0; const unsigned long long rt_entry = STAMP ? (unsigned long long)wall_clock64() : 0ull;
#define PG8_STAMP() do { if (STAMP && wid == 0 && nts < 64) { const unsigned long long _c = (unsigned long long)clock64(); \
        ts_lo = (lane == nts) ? (int)(unsigned)_c : ts_lo; ts_hi = (lane == nts) ? (int)(unsigned)(_c >> 32) : ts_hi; ++nts; } } while (0)
    PG8_STAMP();
    unsigned voffA[2], voffB[2];
#pragma unroll
    for (int i = 0; i < 2; ++i) { int R, C; stage_rc(tid * 16 + i * 8192, R, C); const int Rb = Epi::PERM ? ((R & ~31) + perm32(R & 31)) : R;
        voffA[i] = (unsigned)(R * K + C) * 2u; voffB[i] = (unsigned)(Rb * K + C) * 2u; }
    const size_t kstep = (size_t)(BK * 2);
    const size_t hstep = (size_t)HALF * K * 2;
    const size_t tstep = 2 * hstep;
    const unsigned ldsw = (unsigned)wid * 1024u;
    const int aoff = lds_byte(wr * 64 + fr, fq * 8), boff = lds_byte(wc * 32 + fr, fq * 8);
#define PG8_SA(b, h) (((b) * 2 + (h)) * HTB)
#define PG8_SB(b, h) ((4 + (b) * 2 + (h)) * HTB)
#define PG8_STAGE(bufoff, gbase, voff) do { _Pragma("unroll") for (int _i = 0; _i < 2; ++_i) \
        __builtin_amdgcn_global_load_lds((const unsigned*)((const char*)(gbase) + (voff)[_i]), (PG8_LAS unsigned*)(lds + (bufoff) + ldsw + _i * 8192), 16, 0, 0); } while (0)
#define PG8_LDA(dst, b, h) do { _Pragma("unroll") for (int m = 0; m < 4; ++m) _Pragma("unroll") for (int k = 0; k < 2; ++k) dst[m][k] = *(const PG8_LAS bf16x8*)(lds + PG8_SA(b, h) + aoff + m * 2048 + k * 1024); } while (0)
#define PG8_LDB(dst, b, h) do { _Pragma("unroll") for (int n = 0; n < 2; ++n) _Pragma("unroll") for (int k = 0; k < 2; ++k) dst[n][k] = *(const PG8_LAS bf16x8*)(lds + PG8_SB(b, h) + boff + n * 2048 + k * 1024); } while (0)
#define PG8_MMA(ai, bj, At, Bt) do { __builtin_amdgcn_s_setprio(1); _Pragma("unroll") for (int m = 0; m < 4; ++m) _Pragma("unroll") for (int n = 0; n < 2; ++n) _Pragma("unroll") for (int k = 0; k < 2; ++k) \
        acc[ai][bj][m][n] = __builtin_amdgcn_mfma_f32_16x16x32_bf16(Bt[n][k], At[m][k], acc[ai][bj][m][n], 0, 0, 0); __builtin_amdgcn_s_setprio(0); } while (0)
#define PG8_WAIT_V(n) asm volatile("s_waitcnt vmcnt(" #n ")" ::: "memory")
#define PG8_WAIT_L(n) asm volatile("s_waitcnt lgkmcnt(" #n ")" ::: "memory")
#define PG8_BAR __builtin_amdgcn_s_barrier()
#define PG8_SCHED __builtin_amdgcn_sched_barrier(0)
    Unit cur, nxt; int ui = 0;
    if (!S.next(0, cur)) return;
    f32x4 acc[2][2][4][2];
#pragma unroll
    for (int a = 0; a < 2; ++a)
#pragma unroll
        for (int b = 0; b < 2; ++b)
#pragma unroll
            for (int m = 0; m < 4; ++m)
#pragma unroll
                for (int n = 0; n < 2; ++n) acc[a][b][m][n] = (f32x4){0.f, 0.f, 0.f, 0.f};
    bf16x8 At[4][2], B0[2][2], B1[2][2];
    const char* cA = (const char*)g.A + (size_t)cur.pm * tstep + cur.koff; const char* cB = (const char*)g.Bt + (size_t)cur.pn * tstep + cur.koff;
    if constexpr (Epi::HAS_SWAP) { if (E.swap_ab(cur)) { const char* t_ = cA; cA = cB; cB = t_; } }
    S.a_ready(cur);
    PG8_STAGE(PG8_SB(0, 0), cB, voffB); PG8_STAGE(PG8_SA(0, 0), cA, voffA); PG8_STAGE(PG8_SB(0, 1), cB + hstep, voffB); PG8_STAGE(PG8_SA(0, 1), cA + hstep, voffA);
    if (wr == 1) PG8_BAR;
    PG8_WAIT_V(4); PG8_BAR;
    PG8_STAGE(PG8_SB(1, 0), cB + kstep, voffB); PG8_STAGE(PG8_SA(1, 0), cA + kstep, voffA); PG8_STAGE(PG8_SB(1, 1), cB + hstep + kstep, voffB);
    PG8_WAIT_V(6); PG8_BAR;
    PG8_STAMP();
    for (;;) {
        const bool has_next = S.next(ui + 1, nxt);
        const char* nA_ = has_next ? (const char*)g.A + (size_t)nxt.pm * tstep + nxt.koff : cA; const char* nB_ = has_next ? (const char*)g.Bt + (size_t)nxt.pn * tstep + nxt.koff : cB;
        const char* nA = nA_; const char* nB = nB_;
        if constexpr (Epi::HAS_SWAP) { if (has_next && E.swap_ab(nxt)) { nA = nB_; nB = nA_; } }
        const int nt = cur.nt;
        for (int t = 0; t < nt; t += 2) {
            const bool last = (t == nt - 2);
            const char* a1 = cA + (size_t)(t + 1) * kstep;
            const char* a2 = last ? nA : cA + (size_t)(t + 2) * kstep; const char* b2 = last ? nB : cB + (size_t)(t + 2) * kstep;
            const char* a3 = a2 + kstep; const char* b3 = b2 + kstep;
            if (last && has_next) S.a_ready(nxt);
            PG8_LDB(B0, 0, 0); PG8_SCHED; PG8_LDA(At, 0, 0); PG8_STAGE(PG8_SA(1, 1), a1 + hstep, voffA);
            PG8_WAIT_L(8); PG8_BAR; PG8_WAIT_L(0); PG8_MMA(0, 0, At, B0); PG8_BAR; PG8_SCHED;
            PG8_LDB(B1, 0, 1); PG8_STAGE(PG8_SB(0, 0), b2, voffB);
            PG8_BAR; PG8_WAIT_L(0); PG8_MMA(0, 1, At, B1); PG8_BAR;
            PG8_LDA(At, 0, 1); PG8_STAGE(PG8_SA(0, 0), a2, voffA);
            PG8_BAR; PG8_WAIT_L(0); PG8_MMA(1, 0, At, B0); PG8_BAR; PG8_SCHED;
            PG8_STAGE(PG8_SB(0, 1), b2 + hstep, voffB);
            PG8_WAIT_V(6); PG8_BAR; PG8_MMA(1, 1, At, B1); PG8_BAR;
            PG8_LDB(B0, 1, 0); PG8_SCHED; PG8_LDA(At, 1, 0); PG8_STAGE(PG8_SA(0, 1), a2 + hstep, voffA);
            PG8_WAIT_L(8); PG8_BAR; PG8_WAIT_L(0); PG8_MMA(0, 0, At, B0); PG8_BAR; PG8_SCHED;
            PG8_LDB(B1, 1, 1); PG8_STAGE(PG8_SB(1, 0), b3, voffB);
            PG8_BAR; PG8_WAIT_L(0); PG8_MMA(0, 1, At, B1); PG8_BAR;
            PG8_LDA(At, 1, 1); PG8_STAGE(PG8_SA(1, 0), a3, voffA);
            PG8_BAR; PG8_WAIT_L(0); PG8_MMA(1, 0, At, B0); PG8_BAR; PG8_SCHED;
            PG8_STAGE(PG8_SB(1, 1), b3 + hstep, voffB);
            PG8_WAIT_V(6); PG8_BAR; PG8_MMA(1, 1, At, B1); PG8_BAR;
        }
        PG8_STAMP();
        if constexpr (!Epi::AFTER_DRAIN) { E(acc, cur, wr, wc, fr, fq); S.done(cur); }
        PG8_STAMP();
        if (!has_next) break;
#pragma unroll
        for (int a = 0; a < 2; ++a)
#pragma unroll
            for (int b = 0; b < 2; ++b)
#pragma unroll
                for (int m = 0; m < 4; ++m)
#pragma unroll
                    for (int n = 0; n < 2; ++n) acc[a][b][m][n] = (f32x4){0.f, 0.f, 0.f, 0.f};
        cur = nxt; cA = nA; cB = nB; ++ui;
    }
    PG8_WAIT_V(0);
    if (wr == 0) PG8_BAR;
    PG8_BAR;
    if constexpr (Epi::AFTER_DRAIN) { E.fused(acc, cur, wr, wc, fr, fq, lds, wid, lane); S.done(cur); }
    PG8_STAMP();
    if (STAMP && wid == 0) { stamps[lane] = lane < nts ? (((unsigned long long)(unsigned)ts_hi << 32) | (unsigned)ts_lo) : 0ull;
        if (lane == 62) stamps[62] = rt_entry; if (lane == 63) stamps[63] = (unsigned long long)wall_clock64(); }
#undef PG8_STAMP
#undef PG8_SA
#undef PG8_SB
#undef PG8_STAGE
#undef PG8_LDA
#undef PG8_LDB
#undef PG8_MMA
#undef PG8_WAIT_V
#undef PG8_WAIT_L
#undef PG8_BAR
#undef PG8_SCHED
}
}
typedef unsigned short bf16;
typedef float f32x4 __attribute__((ext_vector_type(4)));
typedef short bf16x8 __attribute__((ext_vector_type(8)));
typedef short s16x4 __attribute__((ext_vector_type(4)));
typedef unsigned u32x4 __attribute__((ext_vector_type(4)));
typedef unsigned u32x2 __attribute__((ext_vector_type(2)));
constexpr int NB = 16, SEQ = 2048, DM = 1024, CTXL = 256, NLAYER = 2;
constexpr int NGRP = 2, BG = NB / NGRP;
constexpr int LATG = BG * SEQ, CTXG = BG * CTXL, RG = LATG + CTXG;
constexpr int NIN = 7168, DFF = 2816, DFE = 3584, NEXP = 8, NMOD = 6 * DM;
constexpr int NHEAD = 16, HD = 64;
constexpr int MOE_TILES_MAX = 136, MOE_ROWS_MAX = MOE_TILES_MAX * 256;
constexpr float EPS = 1e-6f;
constexpr int NWAVES = 8, NTHR = 512;
constexpr size_t MiB = 1u << 20;
constexpr size_t WS_CTL = 0, CTL_ZERO_BYTES = 64 * 1024;
constexpr size_t WS_MOD = 1 * MiB;
constexpr size_t WS_MISC = 2 * MiB;
constexpr size_t WS_XC = 4 * MiB;
constexpr size_t WS_WIN = 20 * MiB;
constexpr size_t WS_WRO = 48 * MiB, WS_WNO = 52 * MiB, WS_WOUT = 56 * MiB;
constexpr size_t WS_WF13 = 60 * MiB;
constexpr size_t WS_WF2 = 71 * MiB;
constexpr size_t WS_WM13 = 77 * MiB;
constexpr size_t WS_WM2 = 189 * MiB;
constexpr size_t WS_ARENA = 245 * MiB;
constexpr size_t SLAB = (size_t)RG * DM * 2;
static_assert(SLAB == 36 * MiB, "slab");
constexpr size_t A_H = WS_ARENA + 0 * SLAB;
constexpr size_t A_XR = WS_ARENA + 1 * SLAB;
constexpr size_t A_KB = WS_ARENA + 2 * SLAB;
constexpr size_t A_VT = WS_ARENA + 3 * SLAB;
constexpr size_t A_YG = WS_ARENA + 4 * SLAB;
constexpr size_t A_QB = WS_ARENA + 5 * SLAB;
constexpr size_t A_SR = WS_ARENA + 6 * SLAB;
constexpr size_t A_SN = WS_ARENA + 7 * SLAB;
constexpr size_t A_YN = WS_ARENA + 8 * SLAB;
constexpr size_t A_T1 = WS_ARENA + 9 * SLAB;
constexpr size_t A_H2 = WS_ARENA, A_ACT = WS_ARENA + 72 * MiB;
constexpr size_t A_AM = WS_ARENA;
constexpr size_t A_ACTM = WS_ARENA + 68 * MiB;
constexpr size_t A_Y = WS_ARENA + 306 * MiB;
constexpr size_t A_YPART = A_AM + 36 * MiB;
static_assert(A_YPART >= WS_ARENA + SLAB && A_YPART + (size_t)7 * 8 * 256 * DM * 2 <= A_ACTM, "partial-output buffer");
constexpr size_t A_H2M = A_Y;
constexpr size_t WS_END = WS_ARENA + 374 * MiB;
static_assert((size_t)MOE_ROWS_MAX * DM * 2 == 68 * MiB && (size_t)MOE_ROWS_MAX * DFE * 2 == 238 * MiB, "moe map");
static_assert(A_T1 + SLAB <= WS_END && A_ACT + (size_t)2 * RG * DFF * 2 <= WS_END, "mixer / ffn map");
constexpr size_t MS_TOFF = 0;
constexpr size_t MS_CNT = 4096;
constexpr size_t MS_ROUTE_E = 16384;
constexpr size_t MS_ROUTE_W = 16384 + 65536;
constexpr size_t MS_TOKSLOT = MS_ROUTE_W + 131072;
constexpr size_t MS_SLOTW = MS_TOKSLOT + 131072;
static_assert(MS_SLOTW + MOE_ROWS_MAX * 4 <= 2 * MiB, "misc map");
constexpr int CW_BAR = 1024;
static_assert((CW_BAR + XCD_BAR_WORDS) * 4 <= (int)CTL_ZERO_BYTES, "ctl");
constexpr int XS_LD = 2 * DM;
constexpr int RING_BYTES = 131072, LDS_BYTES = 147456, MISC_OFF = LDS_BYTES - 64;

__device__ __forceinline__ unsigned pk2(float lo, float hi) { unsigned r; asm("v_cvt_pk_bf16_f32 %0, %1, %2" : "=v"(r) : "v"(lo), "v"(hi)); return r; }
__device__ __forceinline__ unsigned f2bf(float f) { return pk2(f, f) & 0xffffu; }
__device__ __forceinline__ float bf2f(unsigned short b) { return __builtin_bit_cast(float, ((unsigned)b) << 16); }
__device__ __forceinline__ float bflo(unsigned w) { return __builtin_bit_cast(float, w << 16); }
__device__ __forceinline__ float bfhi(unsigned w) { return __builtin_bit_cast(float, w & 0xffff0000u); }
#define SHX(x, m) __builtin_bit_cast(float, __builtin_amdgcn_ds_bpermute(((lane) ^ (m)) << 2, __builtin_bit_cast(int, (float)(x))))
#define SHUP(x, d) __builtin_bit_cast(float, __builtin_amdgcn_ds_bpermute(((lane) >= (d) ? (lane) - (d) : (lane)) << 2, __builtin_bit_cast(int, (float)(x))))
__device__ __forceinline__ int lane_id_fresh() { int l; asm volatile("v_mbcnt_lo_u32_b32 %0, -1, 0\n\tv_mbcnt_hi_u32_b32 %0, -1, %0" : "=v"(l)); return l; }
__device__ __forceinline__ float wave_sum(float v, int lane) {
#pragma unroll
    for (int o = 1; o < 64; o <<= 1) v += SHX(v, o);
    return v;
}
__device__ __forceinline__ float sigmoidf_(float x) { return __builtin_amdgcn_rcpf(1.0f + __builtin_amdgcn_exp2f(-1.44269504f * x)); }
__device__ __forceinline__ float siluf_(float x) { return x * sigmoidf_(x); }
__device__ __forceinline__ float gelu_tanh_(float x) { const float u = 0.7978845608f * (x + 0.044715f * x * x * x); return x * sigmoidf_(2.0f * u); }
#define LDS_WAIT() asm volatile("s_waitcnt lgkmcnt(0)" ::: "memory")

struct Args { const float* in[25]; float* out; unsigned char* ws; int ph_lo, ph_hi; };
enum { I_X = 0, I_C, I_CTX, I_CCTX, I_WMOD, I_BMOD, I_WIN, I_CONVW, I_CONVB, I_LAM, I_RGW, I_RGB, I_QG, I_KG, I_RPB, I_WRO, I_WNO, I_WOUT, I_F1, I_F3, I_F2, I_ROUTER, I_M1, I_M3, I_M2 };

__device__ __forceinline__ int map_row(int mode, int n) {
    if (mode == 1) { const int t = n >> 8, cl = n & 255, wc = cl >> 6, bj = (cl >> 5) & 1, j = cl & 31; return (t << 8) + 128 * bj + 32 * wc + j; }
    if (mode == 2) return ((n >> 7) << 8) + (n & 127);
    if (mode == 3) return ((n >> 7) << 8) + 128 + (n & 127);
    return n;
}
struct TItem { const float* src; bf16* dst; int K, N, mode, k0, n0; };
__device__ __forceinline__ TItem titem(const float* W, int K, int N, bf16* WT, int mode, int tile, int k, int w) { const int n8 = N / 256, kb = 4 * (tile / n8) + k, nb = 8 * (tile % n8) + w; return TItem{W, WT, K, N, mode, 64 * kb, 32 * nb}; }
__device__ __forceinline__ void titem_load(const TItem& d, f32x4 (&t)[8], int lane) {
#pragma unroll
    for (int i = 0; i < 8; ++i) t[i] = *(const f32x4*)(d.src + (size_t)(d.k0 + 8 * i + (lane >> 3)) * d.N + d.n0 + 4 * (lane & 7));
}
__device__ __forceinline__ void titem_finish(const TItem& d, const f32x4 (&t)[8], float* scr, int lane) {
#pragma unroll
    for (int i = 0; i < 8; ++i) { float* p = scr + (8 * i + (lane >> 3)) * 33 + 4 * (lane & 7); p[0] = t[i].x; p[1] = t[i].y; p[2] = t[i].z; p[3] = t[i].w; }
    LDS_WAIT(); asm volatile("" ::: "memory");
    const int c = lane & 7; const float sc = d.mode == 2 ? -1.44269504f : 1.0f;
#pragma unroll
    for (int j = 0; j < 4; ++j) { const int n = (lane >> 3) + 8 * j; const float* s = scr + (8 * c) * 33 + n;
        u32x4 o; o.x = pk2(s[0 * 33] * sc, s[1 * 33] * sc); o.y = pk2(s[2 * 33] * sc, s[3 * 33] * sc); o.z = pk2(s[4 * 33] * sc, s[5 * 33] * sc); o.w = pk2(s[6 * 33] * sc, s[7 * 33] * sc);
        *(u32x4*)(d.dst + (size_t)map_row(d.mode, d.n0 + n) * d.K + d.k0 + 8 * c) = o; }
    LDS_WAIT(); asm volatile("" ::: "memory");
}
constexpr int TL_IN = (DM / 256) * (NIN / 256), TL_SQ = (DM / 256) * (DM / 256), TL_F1 = (DM / 256) * (DFF / 256), TL_F2 = (DFF / 256) * (DM / 256), TL_M1 = (DM / 256) * (DFE / 256), TL_M2 = (DFE / 256) * (DM / 256);
constexpr int NT_IN = 2 * TL_IN, NT_SQ = 6 * TL_SQ, NT_F = 2 * TL_F1 + TL_F2, NT_M13 = 16 * TL_M1, NT_MOE = NT_M13 + 8 * TL_M2, NT_EAGER = NT_IN + NT_SQ + NT_F, NTILES = NT_EAGER + NT_MOE;
static_assert(NIN % 256 == 0 && DFF % 256 == 0 && DFE % 256 == 0 && DM % 256 == 0, "conversion tiles");
__device__ __forceinline__ TItem conv_item(const Args& a, int r, int k, int w) {
    unsigned char* ws = a.ws;
    if (r < NT_IN) { const int l = r / TL_IN; return titem(a.in[I_WIN] + (size_t)l * DM * NIN, DM, NIN, (bf16*)(ws + WS_WIN) + (size_t)l * NIN * DM, 1, r % TL_IN, k, w); } r -= NT_IN;
    if (r < NT_SQ) { const int m = r / TL_SQ, which = m >> 1, l = m & 1; const float* s0 = a.in[I_WRO]; const float* s1 = a.in[I_WNO]; const float* s2 = a.in[I_WOUT];
        const float* src = (which == 0 ? s0 : (which == 1 ? s1 : s2)) + (size_t)l * DM * DM;
        bf16* dst = (bf16*)(ws + (which == 0 ? WS_WRO : (which == 1 ? WS_WNO : WS_WOUT))) + (size_t)l * DM * DM; return titem(src, DM, DM, dst, 0, r % TL_SQ, k, w); } r -= NT_SQ;
    if (r < NT_F) { if (r < TL_F1) return titem(a.in[I_F1], DM, DFF, (bf16*)(ws + WS_WF13), 2, r, k, w);
        if (r < 2 * TL_F1) return titem(a.in[I_F3], DM, DFF, (bf16*)(ws + WS_WF13), 3, r - TL_F1, k, w);
        return titem(a.in[I_F2], DFF, DM, (bf16*)(ws + WS_WF2), 0, r - 2 * TL_F1, k, w); } r -= NT_F;
    if (r < NT_M13) { const int m = r / TL_M1, e = m >> 1, up = m & 1; const float* s1 = a.in[I_M1]; const float* s3 = a.in[I_M3];
        return titem((up ? s3 : s1) + (size_t)e * DM * DFE, DM, DFE, (bf16*)(ws + WS_WM13) + (size_t)e * 2 * DFE * DM, up ? 3 : 2, r % TL_M1, k, w); } r -= NT_M13;
    { const int e = r / TL_M2; return titem(a.in[I_M2] + (size_t)e * DFE * DM, DFE, DM, (bf16*)(ws + WS_WM2) + (size_t)e * DM * DFE, 0, r % TL_M2, k, w); }
}
__device__ __forceinline__ void conv_tile(const Args& a, float* scr, int tile, int wave, int lane) {
    f32x4 t[4][8]; TItem d[4];
#pragma unroll
    for (int k = 0; k < 4; ++k) { d[k] = conv_item(a, tile, k, wave); titem_load(d[k], t[k], lane); }
#pragma unroll
    for (int k = 0; k < 4; ++k) titem_finish(d[k], t[k], scr, lane);
}
static_assert(NT_MOE == 6 * 224, "lazy MoE conversion slices");
__device__ __forceinline__ void moe_convert_slice(const Args& a, unsigned char* lds, int s, int blk, int wave, int lane) {
    if (blk < 32) return;
    conv_tile(a, (float*)(lds + wave * 16384), NT_EAGER + s * 224 + (blk - 32), wave, lane);
}
__device__ __forceinline__ void phase_prologue(const Args& a, unsigned char* lds, int blk, int G, int wave, int lane, int tid, bool lazy_moe) {
    unsigned char* ws = a.ws;
    float* scr = (float*)(lds + wave * 16384);
    const int ntiles = lazy_moe ? NT_EAGER : NTILES;
    for (int t = blk; t < ntiles; t += G) conv_tile(a, scr, t, wave, lane);
    __syncthreads();
    float* sc = (float*)lds;
    float* red = (float*)(lds + 17 * 1024 * 4);
    bool have = false;
    for (int u = blk; u < 2 * (NMOD / 64); u += G) {
        if (!have) { for (int i = tid; i < 17 * 1024; i += NTHR) { const float v = (i < 16 * 1024) ? a.in[I_C][i] : a.in[I_CCTX][i - 16 * 1024]; sc[i] = siluf_(v); } have = true; }
        __syncthreads();
        const int l = u / (NMOD / 64), n0 = (u % (NMOD / 64)) * 64;
        const float* wm = a.in[I_WMOD] + (size_t)l * DM * NMOD + n0 + lane;
        float acc[17];
#pragma unroll
        for (int r = 0; r < 17; ++r) acc[r] = 0.f;
        for (int k0 = wave * 128; k0 < wave * 128 + 128; k0 += 16) { float w[16];
#pragma unroll
            for (int i = 0; i < 16; ++i) w[i] = wm[(size_t)(k0 + i) * NMOD];
#pragma unroll
            for (int i = 0; i < 16; ++i)
#pragma unroll
                for (int r = 0; r < 17; ++r) acc[r] += sc[r * 1024 + k0 + i] * w[i]; }
#pragma unroll
        for (int r = 0; r < 17; ++r) red[(wave * 17 + r) * 64 + lane] = acc[r];
        __syncthreads();
        for (int i = tid; i < 17 * 64; i += NTHR) { const int r = i >> 6, c = i & 63; float s = 0.f;
#pragma unroll
            for (int w = 0; w < 8; ++w) s += red[(w * 17 + r) * 64 + c];
            ((float*)(ws + WS_MOD))[((size_t)l * 17 + r) * NMOD + n0 + c] = s + a.in[I_BMOD][l * NMOD + n0 + c]; }
    }
    __syncthreads();
}

#define DPP_ADD_(v, ctrl, rmask) v += __builtin_bit_cast(float, __builtin_amdgcn_update_dpp(0, __builtin_bit_cast(int, v), ctrl, rmask, 0xf, false))
__device__ __forceinline__ float wave_sum_dpp(float v) {
    DPP_ADD_(v, 0x111, 0xf); DPP_ADD_(v, 0x112, 0xf); DPP_ADD_(v, 0x114, 0xf); DPP_ADD_(v, 0x118, 0xf);
    DPP_ADD_(v, 0x142, 0xa); DPP_ADD_(v, 0x143, 0xc);
    return __builtin_bit_cast(float, __builtin_amdgcn_readlane(__builtin_bit_cast(int, v), 63));
}
template <bool ROUTE, bool XBF, bool CP = false>
__device__ __forceinline__ void modulate_rows(const void* __restrict__ xl_, const void* __restrict__ xc_, int nlat, int mbase, const float* __restrict__ modl, int shoff, bf16* __restrict__ out,
                                              int r0, int n, int lane, const float* __restrict__ router, int* __restrict__ re, float* __restrict__ rw, int* cntl, const bf16* __restrict__ cpart = nullptr) {
    if (n <= 0) return;
    f32x4 rt[ROUTE ? 32 : 1];
    if (ROUTE) {
#pragma unroll
        for (int j = 0; j < 4; ++j)
#pragma unroll
            for (int i = 0; i < 4; ++i) { const int col = 4 * lane + 256 * j + i; rt[2 * (4 * j + i)] = *(const f32x4*)(router + col * 8); rt[2 * (4 * j + i) + 1] = *(const f32x4*)(router + col * 8 + 4); } }
    typedef typename std::conditional<XBF, u32x2, f32x4>::type rowv;
    constexpr size_t XLD = XBF ? (size_t)XS_LD * 2 : (size_t)DM * 4;
    const unsigned char* xl = (const unsigned char*)xl_; const unsigned char* xc = (const unsigned char*)xc_;
    rowv vn[4]; f32x4 s4[4], h4[4];
    { const rowv* p = (const rowv*)(r0 >= nlat ? xc + (size_t)(r0 - nlat) * XLD : xl + (size_t)r0 * XLD);
#pragma unroll
      for (int j = 0; j < 4; ++j) vn[j] = p[lane + 64 * j]; }
    u32x2 pv[CP ? 4 : 1][4];
    if constexpr (CP) { if (r0 >= nlat) {
#pragma unroll
        for (int p = 0; p < 4; ++p) { const u32x2* q = (const u32x2*)(cpart + (size_t)(4 * (r0 - nlat) + p) * XS_LD + DM);
#pragma unroll
            for (int j = 0; j < 4; ++j) pv[p][j] = q[lane + 64 * j]; } } }
    int mprev = -1;
    for (int i = 0; i < n; ++i) {
        const int r = r0 + i;
        f32x4 v[4];
#pragma unroll
        for (int j = 0; j < 4; ++j) { if constexpr (XBF) v[j] = (f32x4){bflo(vn[j].x), bfhi(vn[j].x), bflo(vn[j].y), bfhi(vn[j].y)}; else v[j] = vn[j]; }
        if constexpr (CP) { if (r >= nlat) {
#pragma unroll
            for (int p = 0; p < 4; ++p)
#pragma unroll
                for (int j = 0; j < 4; ++j) { v[j].x += bflo(pv[p][j].x); v[j].y += bfhi(pv[p][j].x); v[j].z += bflo(pv[p][j].y); v[j].w += bfhi(pv[p][j].y); } } }
        if (i + 1 < n) { const int rn = r + 1; const rowv* p = (const rowv*)(rn >= nlat ? xc + (size_t)(rn - nlat) * XLD : xl + (size_t)rn * XLD);
#pragma unroll
            for (int j = 0; j < 4; ++j) vn[j] = p[lane + 64 * j];
            if constexpr (CP) { if (rn >= nlat) {
#pragma unroll
                for (int p = 0; p < 4; ++p) { const u32x2* q = (const u32x2*)(cpart + (size_t)(4 * (rn - nlat) + p) * XS_LD + DM);
#pragma unroll
                    for (int j = 0; j < 4; ++j) pv[p][j] = q[lane + 64 * j]; } } } }
        const int mrow = r >= nlat ? 16 : mbase + r / SEQ;
        if (mrow != mprev) { mprev = mrow; const f32x4* hp = (const f32x4*)(modl + (size_t)mrow * NMOD + (size_t)shoff * DM); const f32x4* sp = hp + DM / 4;
#pragma unroll
            for (int j = 0; j < 4; ++j) { s4[j] = sp[lane + 64 * j] + 1.0f; h4[j] = hp[lane + 64 * j]; } }
        float ss = 0.f;
#pragma unroll
        for (int j = 0; j < 4; ++j) ss += (v[j].x * v[j].x + v[j].y * v[j].y) + (v[j].z * v[j].z + v[j].w * v[j].w);
        ss = wave_sum_dpp(ss);
        const float rinv = __builtin_amdgcn_rsqf(ss * (1.0f / DM) + EPS);
#pragma unroll
        for (int j = 0; j < 4; ++j) v[j] = v[j] * rinv * s4[j] + h4[j];
        unsigned long long* o8 = (unsigned long long*)(out + (size_t)r * DM) + lane;
#pragma unroll
        for (int j = 0; j < 4; ++j) o8[64 * j] = (unsigned long long)pk2(v[j].x, v[j].y) | ((unsigned long long)pk2(v[j].z, v[j].w) << 32);
        if (ROUTE) {
            float lg[8];
#pragma unroll
            for (int e = 0; e < 8; ++e) lg[e] = 0.f;
#pragma unroll
            for (int j = 0; j < 4; ++j)
#pragma unroll
                for (int k = 0; k < 4; ++k) { const f32x4 q0 = rt[2 * (4 * j + k)], q1 = rt[2 * (4 * j + k) + 1]; const float x = v[j][k];
                    lg[0] += x * q0.x; lg[1] += x * q0.y; lg[2] += x * q0.z; lg[3] += x * q0.w; lg[4] += x * q1.x; lg[5] += x * q1.y; lg[6] += x * q1.z; lg[7] += x * q1.w; }
#pragma unroll
            for (int e = 0; e < 8; ++e) lg[e] = wave_sum_dpp(lg[e]);
            int e0 = 0; float v0 = lg[0];
#pragma unroll
            for (int e = 1; e < 8; ++e) if (lg[e] > v0) { v0 = lg[e]; e0 = e; }
            int e1 = -1; float v1 = -3.0e38f;
#pragma unroll
            for (int e = 0; e < 8; ++e) if (e != e0 && lg[e] > v1) { v1 = lg[e]; e1 = e; }
            const float w0 = 1.0f / (1.0f + __expf(v1 - v0));
            if (lane == 0) { re[r] = e0 | (e1 << 8); rw[2 * r] = w0; rw[2 * r + 1] = 1.0f - w0; atomicAdd(&cntl[e0], 1); atomicAdd(&cntl[e1], 1); }
        }
    }
}
#ifndef RECT_GH
#define RECT_GH 4
#endif
__device__ __forceinline__ void rect_unit(int L, int nM, int nN, int& pm, int& pn) {
    const int per = RECT_GH * nN, gid = L / per, fm = gid * RECT_GH, gs = (nM - fm) < RECT_GH ? (nM - fm) : RECT_GH, rem = L - gid * per;
    pm = fm + rem % gs; pn = rem / gs;
}
__device__ __forceinline__ int xcd_remap(int L, int nU) { const int q = nU >> 3, r = nU & 7, xcd = L & 7, off = L >> 3; return (xcd < r ? xcd * (q + 1) : r * (q + 1) + (xcd - r) * q) + off; }
struct RectOrder {
    int nM0, nN0, nM1, nN1, G, c, ntk;
    __device__ __forceinline__ bool next(int i, pg8::Unit& u) const {
        const int n0 = nM0 * nN0, nU = n0 + nM1 * nN1; int L = i * G + c;
        if (L >= nU) return false;
        L = xcd_remap(L, nU); u.koff = 0; u.nt = ntk;
        if (L < n0) { rect_unit(L, nM0, nN0, u.pm, u.pn); return true; }
        rect_unit(L - n0, nM1, nN1, u.pm, u.pn); u.pm += nM0; return true;
    }
    __device__ __forceinline__ void a_ready(const pg8::Unit&) const {}
    __device__ __forceinline__ void done(const pg8::Unit&) const {}
};
struct MoeOrder {
    int nT, nN, G, c, t1, t2, t3, t4, t5, t6, t7, ntk;
    __device__ __forceinline__ bool next(int i, pg8::Unit& u) const {
        const int nU = nT * nN; int L = i * G + c; if (L >= nU) return false;
        L = xcd_remap(L, nU); u.koff = 0; u.nt = ntk;
        int pm, pn; rect_unit(L, nT, nN, pm, pn);
        const int e = (pm >= t1) + (pm >= t2) + (pm >= t3) + (pm >= t4) + (pm >= t5) + (pm >= t6) + (pm >= t7);
        u.pm = pm; u.pn = e * nN + pn; return true;
    }
    __device__ __forceinline__ void a_ready(const pg8::Unit&) const {}
    __device__ __forceinline__ void done(const pg8::Unit&) const {}
};

constexpr int MOE_MAIN_TILES = 128, MOE_KS = 7, MOE_KS_TILES = 8;
struct MoeDownOrder {
    int nT, G, c, t1, t2, t3, t4, t5, t6, t7;
    __device__ __forceinline__ int expert(int pm) const { return (pm >= t1) + (pm >= t2) + (pm >= t3) + (pm >= t4) + (pm >= t5) + (pm >= t6) + (pm >= t7); }
    __device__ __forceinline__ bool next(int i, pg8::Unit& u) const {
        const int Tm = nT < MOE_MAIN_TILES ? nT : MOE_MAIN_TILES, nmain = Tm * 4; int L = i * G + c;
        if (L < nmain) { L = xcd_remap(L, nmain); int pm, pn; rect_unit(L, Tm, 4, pm, pn); u.pm = pm; u.pn = expert(pm) * 4 + pn; u.koff = 0; u.nt = DFE / 64; return true; }
        const int j = L - nmain, novf = (nT - Tm) * 4 * MOE_KS; if (j >= novf) return false;
        const int ks = j % MOE_KS, pn = (j / MOE_KS) & 3, pm = MOE_MAIN_TILES + j / (4 * MOE_KS);
        u.pm = pm; u.pn = expert(pm) * 4 + pn; u.koff = ks * MOE_KS_TILES * 64 * 2; u.nt = MOE_KS_TILES; return true;
    }
    __device__ __forceinline__ void a_ready(const pg8::Unit&) const {}
    __device__ __forceinline__ void done(const pg8::Unit&) const {}
};
static_assert(MOE_KS * MOE_KS_TILES * 64 == DFE, "MoE down K split");
constexpr int FD_MAIN_TILES = 128, FD_KS = 4;
struct FfnDownOrder {
    int G, c;
    __device__ __forceinline__ bool next(int i, pg8::Unit& u) const {
        constexpr int nmain = FD_MAIN_TILES * 4; int L = i * G + c;
        if (L < nmain) { L = xcd_remap(L, nmain); rect_unit(L, FD_MAIN_TILES, 4, u.pm, u.pn); u.koff = 0; u.nt = DFF / 64; return true; }
        const int j = L - nmain; if (j >= 16 * 4 * FD_KS) return false;
        const int ks = j & 3; u.pn = (j >> 2) & 3; u.pm = FD_MAIN_TILES + (j >> 4);
        u.koff = (12 * ks - 2 * (ks >> 1) * (ks & 1)) * 64 * 2; u.nt = 12 - 2 * (ks >> 1); return true;
    }
    __device__ __forceinline__ void a_ready(const pg8::Unit&) const {}
    __device__ __forceinline__ void done(const pg8::Unit&) const {}
};
static_assert(DFF / 64 == 44 && NB * CTXL == 16 * 256 && NB * SEQ == FD_MAIN_TILES * 256, "FFN down K split");

typedef pg8::f32x4 accv;
__device__ __forceinline__ u32x4 pack8(const accv& a, const accv& b) { u32x4 w; w.x = pg8::cvt_pk_bf16(a[0], a[1]); w.y = pg8::cvt_pk_bf16(a[2], a[3]); w.z = pg8::cvt_pk_bf16(b[0], b[1]); w.w = pg8::cvt_pk_bf16(b[2], b[3]); return w; }

struct EpiIn {
    static constexpr bool PERM = true, AFTER_DRAIN = false, HAS_SWAP = true;
    unsigned char* ws; const float* qg; const float* kg;
    __device__ __forceinline__ bool swap_ab(const pg8::Unit& u) const { return (u.pn >> 2) == 2; }
    __device__ __forceinline__ void operator()(const accv (&acc)[2][2][4][2], const pg8::Unit& u, int wr, int wc, int fr_in, int fq) const {
        int fr = fr_in; asm volatile("" : "+v"(fr));
        const int part = u.pn >> 2, ht = (u.pn & 3) * 4 + wc;
        const int row0 = u.pm * 256 + wr * 64 + fr, colb = ht * 64 + 8 * fq;
        if (part == 2) {
            const bool isc = u.pm >= 64; const int bl = isc ? u.pm - 64 : (u.pm >> 3), T = isc ? CTXL : SEQ, t0 = (isc ? 0 : (u.pm & 7) * 256) + wc * 32 + 8 * fq;
            bf16* vt = (bf16*)(ws + A_VT) + (isc ? (size_t)LATG * DM : 0) + ((size_t)(bl * 16 + (u.pn & 3) * 4 + 2 * wr) * 64 + fr) * T + t0;
#pragma unroll
            for (int ai = 0; ai < 2; ++ai)
#pragma unroll
                for (int m = 0; m < 4; ++m)
#pragma unroll
                    for (int bj = 0; bj < 2; ++bj) *(u32x4*)(vt + (size_t)((m >> 1) * 64 + 32 * ai + 16 * (m & 1)) * T + 128 * bj) = pack8(acc[ai][bj][m][0], acc[ai][bj][m][1]);
            return;
        }
        bf16* dst = (bf16*)(ws + (part == 0 ? A_XR : part == 1 ? A_KB : part == 3 ? A_YG : part == 4 ? A_QB : part == 5 ? A_SR : A_SN));
        float gn[2][2][4];
        if (part == 1 || part == 4) { const float* gp = (part == 1 ? kg : qg) + 8 * fq; const float sc = (part == 4) ? 0.125f * 1.44269504f : 1.0f;
#pragma unroll
            for (int bj = 0; bj < 2; ++bj)
#pragma unroll
                for (int n = 0; n < 2; ++n)
#pragma unroll
                    for (int j = 0; j < 4; ++j) gn[bj][n][j] = gp[32 * bj + 4 * n + j] * sc; }
#pragma unroll
        for (int ai = 0; ai < 2; ++ai)
#pragma unroll
            for (int m = 0; m < 4; ++m) {
                accv v[2][2];
#pragma unroll
                for (int bj = 0; bj < 2; ++bj)
#pragma unroll
                    for (int n = 0; n < 2; ++n) v[bj][n] = acc[ai][bj][m][n];
                if (part == 1 || part == 4) {
                    float ss = 0.f;
#pragma unroll
                    for (int bj = 0; bj < 2; ++bj)
#pragma unroll
                        for (int n = 0; n < 2; ++n) ss += (v[bj][n][0] * v[bj][n][0] + v[bj][n][1] * v[bj][n][1]) + (v[bj][n][2] * v[bj][n][2] + v[bj][n][3] * v[bj][n][3]);
                    { const int lane = fq * 16 + fr; ss += SHX(ss, 16); ss += SHX(ss, 32); }
                    const float rinv = __builtin_amdgcn_rsqf(ss * (1.0f / 64.0f) + EPS);
#pragma unroll
                    for (int bj = 0; bj < 2; ++bj)
#pragma unroll
                        for (int n = 0; n < 2; ++n)
#pragma unroll
                            for (int j = 0; j < 4; ++j) v[bj][n][j] = v[bj][n][j] * rinv * gn[bj][n][j];
                } else if (part == 3) {
#pragma unroll
                    for (int bj = 0; bj < 2; ++bj)
#pragma unroll
                        for (int n = 0; n < 2; ++n)
#pragma unroll
                            for (int j = 0; j < 4; ++j) v[bj][n][j] = gelu_tanh_(v[bj][n][j]);
                } else if (part >= 5) {
#pragma unroll
                    for (int bj = 0; bj < 2; ++bj)
#pragma unroll
                        for (int n = 0; n < 2; ++n)
#pragma unroll
                            for (int j = 0; j < 4; ++j) v[bj][n][j] = sigmoidf_(v[bj][n][j]);
                }
                bf16* rowp = dst + (size_t)(row0 + ai * 128 + m * 16) * DM + colb;
#pragma unroll
                for (int bj = 0; bj < 2; ++bj) *(u32x4*)(rowp + 32 * bj) = pack8(v[bj][0], v[bj][1]);
            }
    }
};
template <int MODE> struct EpiGate {
    static constexpr bool PERM = true, AFTER_DRAIN = false, HAS_SWAP = false;
    const bf16* gate; const bf16* add; bf16* out;
    __device__ __forceinline__ void operator()(const accv (&acc)[2][2][4][2], const pg8::Unit& u, int wr, int wc, int fr_in, int fq) const {
        int fr = fr_in; asm volatile("" : "+v"(fr));
        const int row0 = u.pm * 256 + wr * 64 + fr, col0 = u.pn * 256 + wc * 32 + 8 * fq;
#pragma unroll
        for (int ai = 0; ai < 2; ++ai) {
            u32x4 gw[4][2], aw[4][2];
#pragma unroll
            for (int m = 0; m < 4; ++m)
#pragma unroll
                for (int bj = 0; bj < 2; ++bj) { const size_t ro = (size_t)(row0 + ai * 128 + m * 16) * DM + col0 + bj * 128;
                    gw[m][bj] = *(const u32x4*)(gate + ro); if (MODE == 1) aw[m][bj] = *(const u32x4*)(add + ro); }
#pragma unroll
            for (int m = 0; m < 4; ++m)
#pragma unroll
                for (int bj = 0; bj < 2; ++bj) { const size_t ro = (size_t)(row0 + ai * 128 + m * 16) * DM + col0 + bj * 128;
                    const u32x4 g = gw[m][bj];
                    accv v0 = acc[ai][bj][m][0], v1 = acc[ai][bj][m][1];
                    v0[0] *= bflo(g.x); v0[1] *= bfhi(g.x); v0[2] *= bflo(g.y); v0[3] *= bfhi(g.y); v1[0] *= bflo(g.z); v1[1] *= bfhi(g.z); v1[2] *= bflo(g.w); v1[3] *= bfhi(g.w);
                    if (MODE == 1) { const u32x4 a4 = aw[m][bj];
                        v0[0] += bflo(a4.x); v0[1] += bfhi(a4.x); v0[2] += bflo(a4.y); v0[3] += bfhi(a4.y); v1[0] += bflo(a4.z); v1[1] += bfhi(a4.z); v1[2] += bflo(a4.w); v1[3] += bfhi(a4.w); }
                    *(u32x4*)(out + ro) = pack8(v0, v1); }
            asm volatile("" ::: "memory");
        }
    }
};
template <bool INF32, bool SPLITCTX = false> struct EpiRes {
    static constexpr bool PERM = true, AFTER_DRAIN = false, HAS_SWAP = false;
    const void* xold_lat; const void* xold_ctx; bf16* xnew_lat; bf16* xnew_ctx;
    const float* modl; int gchunk; int sbase; int nlat;
    __device__ __forceinline__ void operator()(const accv (&acc)[2][2][4][2], const pg8::Unit& u, int wr, int wc, int fr_in, int fq) const {
        int fr = fr_in; asm volatile("" : "+v"(fr));
        const bool isc = u.pm >= nlat; const int mrow = isc ? 16 : (sbase + (u.pm >> 3));
        const int rbase = (isc ? (u.pm - nlat) * 256 : u.pm * 256) + wr * 64 + fr, col0 = u.pn * 256 + wc * 32 + 8 * fq;
        const bool iscp = SPLITCTX ? false : isc;
        const float* xof = (const float*)(iscp ? xold_ctx : xold_lat) + (size_t)rbase * DM + col0; const bf16* xob = (const bf16*)(iscp ? xold_ctx : xold_lat) + (size_t)rbase * XS_LD + col0;
        bf16* xn = (iscp ? xnew_ctx : xnew_lat) + (size_t)rbase * XS_LD + col0;
        const float* gp = modl + (size_t)mrow * NMOD + gchunk * DM + col0;
        accv gv[2][2];
#pragma unroll
        for (int bj = 0; bj < 2; ++bj)
#pragma unroll
            for (int n = 0; n < 2; ++n) gv[bj][n] = *(const accv*)(gp + bj * 128 + n * 4);
        if constexpr (SPLITCTX) {
            if (isc) { const int kt = u.koff >> 7, ks = (kt >= 12) + (kt >= 24) + (kt >= 34);
#pragma unroll
                for (int ai = 0; ai < 2; ++ai)
#pragma unroll
                    for (int m = 0; m < 4; ++m) { const int cr = rbase + ai * 128 + m * 16, gg = cr >> 11, cl = cr & 2047;
                        bf16* pp = xnew_lat + (size_t)(gg * LATG + 4 * cl + ks) * XS_LD + DM + col0;
#pragma unroll
                        for (int bj = 0; bj < 2; ++bj) *(u32x4*)(pp + bj * 128) = pack8(gv[bj][0] * acc[ai][bj][m][0], gv[bj][1] * acc[ai][bj][m][1]); }
                return; }
        }
#pragma unroll
        for (int ai = 0; ai < 2; ++ai) {
            accv xv[4][2][2];
            if constexpr (INF32) {
#pragma unroll
                for (int m = 0; m < 4; ++m)
#pragma unroll
                    for (int bj = 0; bj < 2; ++bj)
#pragma unroll
                        for (int n = 0; n < 2; ++n) xv[m][bj][n] = *(const accv*)(xof + (size_t)(ai * 128 + m * 16) * DM + bj * 128 + n * 4);
            } else {
                u32x4 xw[4][2];
#pragma unroll
                for (int m = 0; m < 4; ++m)
#pragma unroll
                    for (int bj = 0; bj < 2; ++bj) xw[m][bj] = *(const u32x4*)(xob + (size_t)(ai * 128 + m * 16) * XS_LD + bj * 128);
#pragma unroll
                for (int m = 0; m < 4; ++m)
#pragma unroll
                    for (int bj = 0; bj < 2; ++bj) { xv[m][bj][0] = (accv){bflo(xw[m][bj].x), bfhi(xw[m][bj].x), bflo(xw[m][bj].y), bfhi(xw[m][bj].y)}; xv[m][bj][1] = (accv){bflo(xw[m][bj].z), bfhi(xw[m][bj].z), bflo(xw[m][bj].w), bfhi(xw[m][bj].w)}; }
            }
#pragma unroll
            for (int m = 0; m < 4; ++m)
#pragma unroll
                for (int bj = 0; bj < 2; ++bj) *(u32x4*)(xn + (size_t)(ai * 128 + m * 16) * XS_LD + bj * 128) = pack8(xv[m][bj][0] + gv[bj][0] * acc[ai][bj][m][0], xv[m][bj][1] + gv[bj][1] * acc[ai][bj][m][1]);
            asm volatile("" ::: "memory");
        }
    }
};
template <bool MOE> struct EpiSwi {
    static constexpr bool PERM = true, AFTER_DRAIN = false, HAS_SWAP = false;
    bf16* out; int ldc; int nN; const float* roww;
    __device__ __forceinline__ void operator()(const accv (&acc)[2][2][4][2], const pg8::Unit& u, int wr, int wc, int fr_in, int fq) const {
        int fr = fr_in; asm volatile("" : "+v"(fr));
        const int pnl = MOE ? (u.pn % nN) : u.pn;
        const int row0 = u.pm * 256 + wr * 64 + fr, col0 = pnl * 128 + wc * 32 + 8 * fq;
        float rwv[2][4];
#pragma unroll
        for (int ai = 0; ai < 2; ++ai)
#pragma unroll
            for (int m = 0; m < 4; ++m) rwv[ai][m] = MOE ? roww[row0 + ai * 128 + m * 16] : 1.0f;
#pragma unroll
        for (int ai = 0; ai < 2; ++ai)
#pragma unroll
            for (int m = 0; m < 4; ++m) { const int row = row0 + ai * 128 + m * 16; const float rw = rwv[ai][m] * -0.69314718f;
                const pg8::f32x2 rw2 = {rw, rw}; accv v[2];
#pragma unroll
                for (int n = 0; n < 2; ++n)
#pragma unroll
                    for (int jp = 0; jp < 2; ++jp) { const pg8::f32x2 gq = {acc[ai][0][m][n][2 * jp], acc[ai][0][m][n][2 * jp + 1]}, uq = {acc[ai][1][m][n][2 * jp], acc[ai][1][m][n][2 * jp + 1]};
                        pg8::f32x2 dq = (pg8::f32x2){__builtin_amdgcn_exp2f(gq.x), __builtin_amdgcn_exp2f(gq.y)} + 1.0f;
                        const pg8::f32x2 rq = {__builtin_amdgcn_rcpf(dq.x), __builtin_amdgcn_rcpf(dq.y)}, oq = (gq * uq) * (rq * rw2);
                        v[n][2 * jp] = oq.x; v[n][2 * jp + 1] = oq.y; }
                *(u32x4*)(out + (size_t)row * ldc + col0) = pack8(v[0], v[1]); }
    }
};
struct EpiY {
    static constexpr bool PERM = true, AFTER_DRAIN = false, HAS_SWAP = false;
    bf16* out; int nN; bf16* part;
    __device__ __forceinline__ void operator()(const accv (&acc)[2][2][4][2], const pg8::Unit& u, int wr, int wc, int fr_in, int fq) const {
        int fr = fr_in; asm volatile("" : "+v"(fr));
        const int pnl = u.pn % nN, col0 = pnl * 256 + wc * 32 + 8 * fq;
        bf16* base = u.pm < MOE_MAIN_TILES ? out + (size_t)(u.pm * 256) * DM : part + ((size_t)((u.koff / (MOE_KS_TILES * 128)) * 8 + (u.pm - MOE_MAIN_TILES)) * 256) * DM;
        const int row0 = wr * 64 + fr;
#pragma unroll
        for (int ai = 0; ai < 2; ++ai)
#pragma unroll
            for (int m = 0; m < 4; ++m)
#pragma unroll
                for (int bj = 0; bj < 2; ++bj) *(u32x4*)(base + (size_t)(row0 + ai * 128 + m * 16) * DM + col0 + bj * 128) = pack8(acc[ai][bj][m][0], acc[ai][bj][m][1]);
    }
};
constexpr int RL_XRAW = 0, RL_XCB = 33792, RL_XCF = 70656, RL_WAGG = 104448, RL_HB = RL_WAGG + 2048, RL_HB_LD = 36, RL_END = RL_HB + 2 * 128 * RL_HB_LD * 4;
static_assert(RL_END <= MISC_OFF, "RG-LRU LDS map");
struct RlStep { int L, rowbase, tlo; bool store, comb; };
__device__ __forceinline__ RlStep rl_step(int st, int dirw, int bl, bool ctx_out) {
    RlStep s; const int seq = st >= 2, ch = seq ? st - 2 : st, nst = seq ? 16 : 2;
    s.L = seq ? SEQ : CTXL; s.rowbase = seq ? bl * SEQ : LATG + bl * CTXL;
    s.tlo = dirw ? s.L - 128 * (ch + 1) : 128 * ch;
    s.store = seq || ctx_out; s.comb = ch >= nst / 2; return s;
}
#define LDS_BARRIER() asm volatile("s_waitcnt lgkmcnt(0)\n\ts_barrier" ::: "memory")
__device__ __forceinline__ void rglru_unit(const Args& a, unsigned char* lds, int l, int unit, bool ctx_out, int wave, int lane_in, int tid_in) {
    int lane = lane_in, tid = tid_in; asm volatile("" : "+v"(lane), "+v"(tid));
    unsigned char* ws = a.ws;
    const int bl = unit >> 5, n = (unit >> 1) & 15, hf = unit & 1;
    const bf16* XR = (const bf16*)(ws + A_XR); bf16* YR = (bf16*)(ws + A_H); const bf16* YG = (const bf16*)(ws + A_YG);
    const int col = lane & 15, quad = lane >> 4, dirw = wave >> 2, wd = wave & 3, td = tid & 255;
    bf16* xraw = (bf16*)(lds + RL_XRAW) + dirw * 132 * 64;
    bf16* xcb = (bf16*)(lds + RL_XCB) + dirw * 128 * 72;
    float* wagg = (float*)(lds + RL_WAGG) + dirw * 256;
    float* hb = (float*)(lds + RL_HB) + dirw * 128 * RL_HB_LD;
    __syncthreads();
    const int cp = td & 31, tg = td >> 5;
    pg8::f32x2 cwv[4], cbv;
    { const float* cbp = a.in[I_CONVB] + (size_t)l * DM + 64 * n + 2 * cp; cbv = (pg8::f32x2){cbp[0], cbp[1]};
#pragma unroll
      for (int j = 0; j < 4; ++j) { const float* cwp = a.in[I_CONVW] + (size_t)l * 4 * DM + j * DM + 64 * n + 2 * cp; cwv[j] = (pg8::f32x2){cwp[0], cwp[1]}; } }
    bf16x8 Bf[2][2][2];
#pragma unroll
    for (int gt = 0; gt < 2; ++gt)
#pragma unroll
        for (int nb = 0; nb < 2; ++nb)
#pragma unroll
            for (int ks = 0; ks < 2; ++ks) { const float* wp = a.in[I_RGW] + ((size_t)((((l * 2 + dirw) * 2 + gt) * 16 + n) * 64 + 32 * ks + 8 * quad)) * 64 + 32 * hf + 16 * nb + col;
                const float sg = -1.44269504f;
                u32x4 w; w.x = pk2(wp[0] * sg, wp[64] * sg); w.y = pk2(wp[128] * sg, wp[192] * sg); w.z = pk2(wp[256] * sg, wp[320] * sg); w.w = pk2(wp[384] * sg, wp[448] * sg); Bf[gt][nb][ks] = __builtin_bit_cast(bf16x8, w); }
    float b0[2], b1[2], c8[2], hin[2];
#pragma unroll
    for (int nb = 0; nb < 2; ++nb) { const int c = 64 * n + 32 * hf + 16 * nb + col;
        b0[nb] = -1.44269504f * a.in[I_RGB][((l * 2 + dirw) * 2 + 0) * DM + c]; b1[nb] = -1.44269504f * a.in[I_RGB][((l * 2 + dirw) * 2 + 1) * DM + c];
        const float lam = a.in[I_LAM][(l * 2 + dirw) * DM + c]; c8[nb] = 8.0f * (fminf(lam, 0.f) - log1pf(__expf(-fabsf(lam)))); hin[nb] = 0.f; }
    u32x4 xr[5];
#define RL_FETCH(S_) do { _Pragma("unroll") for (int i = 0; i < 5; ++i) { const int c = td + 256 * i, row = c >> 3, part = c & 7, t = (S_).tlo - 2 + row; \
        xr[i] = (u32x4){0u, 0u, 0u, 0u}; if (row < 131 && t >= 0 && t < (S_).L) xr[i] = *(const u32x4*)(XR + (unsigned)(((S_).rowbase + t) * DM + 64 * n + 8 * part)); } } while (0)
#define RL_PUT() do { _Pragma("unroll") for (int i = 0; i < 5; ++i) { const int c = td + 256 * i; if (c < 131 * 8) *(u32x4*)(xraw + c * 8) = xr[i]; } } while (0)
#define RL_CONV() do { const int rlo = dirw ? 112 - 16 * tg : 16 * tg; pg8::f32x2 xv[19]; \
        _Pragma("unroll") for (int i = 0; i < 19; ++i) { const unsigned w_ = *(const unsigned*)(xraw + (rlo + i) * 64 + 2 * cp); xv[i] = (pg8::f32x2){bflo(w_), bfhi(w_)}; } \
        unsigned pk_[16]; \
        _Pragma("unroll") for (int i = 0; i < 16; ++i) { pg8::f32x2 v_ = cbv; \
            _Pragma("unroll") for (int j = 0; j < 4; ++j) v_ += cwv[j] * xv[i + j]; \
            pk_[i] = pk2(v_.x, v_.y); } \
          \
        if (dirw) { bf16* pb_ = xcb + (16 * tg + 15) * 72 + 2 * cp; _Pragma("unroll") for (int i = 0; i < 16; ++i) *(unsigned*)(pb_ - i * 72) = pk_[i]; } \
        else { bf16* pf_ = xcb + (16 * tg) * 72 + 2 * cp; _Pragma("unroll") for (int i = 0; i < 16; ++i) *(unsigned*)(pf_ + i * 72) = pk_[i]; } } while (0)
    u32x4 oy[2], og[2];
#define RL_OUT_LOAD(SO_) do { if ((SO_).store && (SO_).comb) { const int sl_ = td >> 1, t_ = (SO_).tlo + (dirw ? 127 - sl_ : sl_); const unsigned go_ = (unsigned)(((SO_).rowbase + t_) * DM + 64 * n + 32 * hf + 16 * (td & 1)); \
        oy[0] = *(const u32x4*)(YR + go_); oy[1] = *(const u32x4*)(YR + go_ + 8); og[0] = *(const u32x4*)(YG + go_); og[1] = *(const u32x4*)(YG + go_ + 8); } } while (0)
#define RL_OUT_FINISH(SO_) do { if ((SO_).store) { const int sl_ = td >> 1, t_ = (SO_).tlo + (dirw ? 127 - sl_ : sl_); const unsigned go_ = (unsigned)(((SO_).rowbase + t_) * DM + 64 * n + 32 * hf + 16 * (td & 1)); \
        const f32x4* hp_ = (const f32x4*)(hb + sl_ * RL_HB_LD + 16 * (td & 1)); f32x4 hv_[4]; _Pragma("unroll") for (int i_ = 0; i_ < 4; ++i_) hv_[i_] = hp_[i_]; \
        if ((SO_).comb) { _Pragma("unroll") for (int k_ = 0; k_ < 2; ++k_) { const unsigned yw_[4] = {oy[k_].x, oy[k_].y, oy[k_].z, oy[k_].w}, gw_[4] = {og[k_].x, og[k_].y, og[k_].z, og[k_].w}; \
            _Pragma("unroll") for (int e_ = 0; e_ < 4; ++e_) { const int v_ = 2 * k_ + (e_ >> 1), c_ = 2 * (e_ & 1); \
                hv_[v_][c_] = (bflo(yw_[e_]) + hv_[v_][c_]) * bflo(gw_[e_]); hv_[v_][c_ + 1] = (bfhi(yw_[e_]) + hv_[v_][c_ + 1]) * bfhi(gw_[e_]); } } } \
        u32x4 o0_, o1_; o0_.x = pk2(hv_[0][0], hv_[0][1]); o0_.y = pk2(hv_[0][2], hv_[0][3]); o0_.z = pk2(hv_[1][0], hv_[1][1]); o0_.w = pk2(hv_[1][2], hv_[1][3]); \
        o1_.x = pk2(hv_[2][0], hv_[2][1]); o1_.y = pk2(hv_[2][2], hv_[2][3]); o1_.z = pk2(hv_[3][0], hv_[3][1]); o1_.w = pk2(hv_[3][2], hv_[3][3]); \
        *(u32x4*)(YR + go_) = o0_; *(u32x4*)(YR + go_ + 8) = o1_; } } while (0)
    { const RlStep s0 = rl_step(0, dirw, bl, ctx_out); RL_FETCH(s0); RL_PUT(); }
    __syncthreads();
    RL_CONV();
    { const RlStep s1 = rl_step(1, dirw, bl, ctx_out); RL_FETCH(s1); }
    __syncthreads();
    for (int st = 0; st < 18; ++st) {
        const RlStep S = rl_step(st, dirw, bl, ctx_out);
        if (st > 0) { const RlStep Sp = rl_step(st - 1, dirw, bl, ctx_out); RL_OUT_FINISH(Sp); }
        if (st + 1 < 18) RL_PUT();
        if (st + 2 < 18) { const RlStep Sn = rl_step(st + 2, dirw, bl, ctx_out); RL_FETCH(Sn); }
        float hl[2][2][4], PP[2][2][4], EA[2][2], EH[2][2];
#pragma unroll
        for (int mb = 0; mb < 2; ++mb) {
            const bf16* ap = xcb + (32 * wd + 16 * mb + col) * 72 + 8 * quad;
            const bf16x8 A0 = *(const bf16x8*)ap, A1 = *(const bf16x8*)(ap + 32);
#pragma unroll
            for (int nb = 0; nb < 2; ++nb) {
                accv g0 = {0.f, 0.f, 0.f, 0.f}, g1 = {0.f, 0.f, 0.f, 0.f};
                g0 = __builtin_amdgcn_mfma_f32_16x16x32_bf16(A0, Bf[0][nb][0], g0, 0, 0, 0); g0 = __builtin_amdgcn_mfma_f32_16x16x32_bf16(A1, Bf[0][nb][1], g0, 0, 0, 0);
                g1 = __builtin_amdgcn_mfma_f32_16x16x32_bf16(A0, Bf[1][nb][0], g1, 0, 0, 0); g1 = __builtin_amdgcn_mfma_f32_16x16x32_bf16(A1, Bf[1][nb][1], g1, 0, 0, 0);
                float pa = 1.f, hh = 0.f;
#pragma unroll
                for (int r = 0; r < 4; ++r) { const int sl = 32 * wd + 16 * mb + 4 * quad + r;
                    const float rg = __builtin_amdgcn_rcpf(1.0f + __builtin_amdgcn_exp2f(g0[r] + b0[nb])), ig = __builtin_amdgcn_rcpf(1.0f + __builtin_amdgcn_exp2f(g1[r] + b1[nb])), la = c8[nb] * rg, av = __builtin_amdgcn_exp2f(1.44269504f * la);
                    const float om = fmaxf(1.0f - av * av, 0.0f);
                    const float uu = __builtin_amdgcn_sqrtf(om) * ig * bf2f(xcb[sl * 72 + 32 * hf + 16 * nb + col]);
                    hh = av * hh + uu; pa *= av; hl[mb][nb][r] = hh; PP[mb][nb][r] = pa; }
                float IA = pa, IH = hh;
                { const float pA = SHUP(IA, 16), pH = SHUP(IH, 16); if (quad >= 1) { IH = IA * pH + IH; IA = IA * pA; } }
                { const float pA = SHUP(IA, 32), pH = SHUP(IH, 32); if (quad >= 2) { IH = IA * pH + IH; IA = IA * pA; } }
                float eA = SHUP(IA, 16), eH = SHUP(IH, 16); if (quad == 0) { eA = 1.f; eH = 0.f; }
                const float gA = __builtin_bit_cast(float, __builtin_amdgcn_ds_bpermute((48 + col) << 2, __builtin_bit_cast(int, IA)));
                const float gH = __builtin_bit_cast(float, __builtin_amdgcn_ds_bpermute((48 + col) << 2, __builtin_bit_cast(int, IH)));
                if (mb == 0) { EA[0][nb] = eA; EH[0][nb] = eH; EA[1][nb] = gA; EH[1][nb] = gH; }
                else { const float a0 = EA[1][nb], h0 = EH[1][nb];
                    EA[1][nb] = eA * a0; EH[1][nb] = eA * h0 + eH;
                    if (quad == 3) { wagg[((wd * 2 + nb) * 16 + col) * 2] = gA * a0; wagg[((wd * 2 + nb) * 16 + col) * 2 + 1] = gA * h0 + gH; } }
            }
            __builtin_amdgcn_sched_barrier(0);
        }
        __syncthreads();
        RL_OUT_LOAD(S);
#pragma unroll
        for (int nb = 0; nb < 2; ++nb) {
            float h = hin[nb], hw = 0.f;
#pragma unroll
            for (int w = 0; w < 4; ++w) { if (w == wd) hw = h; const float wa = wagg[((w * 2 + nb) * 16 + col) * 2], wh = wagg[((w * 2 + nb) * 16 + col) * 2 + 1]; h = wa * h + wh; }
            hin[nb] = h;
            if (S.store) {
#pragma unroll
                for (int mb = 0; mb < 2; ++mb) { const float hs = EA[mb][nb] * hw + EH[mb][nb];
#pragma unroll
                    for (int r = 0; r < 4; ++r) { const int sl = 32 * wd + 16 * mb + 4 * quad + r; hb[sl * RL_HB_LD + 16 * nb + col] = hl[mb][nb][r] + PP[mb][nb][r] * hs; } }
            }
        }
        if (st + 1 < 18) RL_CONV();
        LDS_BARRIER();
    }
    { const RlStep Sl = rl_step(17, dirw, bl, ctx_out); RL_OUT_FINISH(Sl); }
    __syncthreads();
#undef RL_OUT_LOAD
#undef RL_OUT_FINISH
#undef RL_FETCH
#undef RL_PUT
#undef RL_CONV
}

constexpr int AT_KC = 0, AT_KC_LD = 72, AT_VC = 256 * 72 * 2, AT_VC_LD = 264, AT_RP = AT_VC + 64 * 264 * 2, AT_WIN = AT_RP + 2048, AT_END = AT_WIN + 9 * 64 * 128;
static_assert(AT_END <= MISC_OFF, "attention LDS map");
#define SCHED_FENCE() __builtin_amdgcn_sched_barrier(0)
__device__ __forceinline__ void attn_stage(const Args& a, unsigned char* lds, int l, int bl, int h, int tid) {
    unsigned char* ws = a.ws;
    const bf16* KB = (const bf16*)(ws + A_KB); const bf16* VT = (const bf16*)(ws + A_VT);
    bf16* KC = (bf16*)(lds + AT_KC); bf16* VC = (bf16*)(lds + AT_VC); float* RP = (float*)(lds + AT_RP);
    u32x4 tk[4], tv[4];
    const bf16* vsrc = VT + (size_t)LATG * DM + (size_t)(bl * 16 + h) * 64 * CTXL;
#pragma unroll
    for (int i = 0; i < 4; ++i) { const int c = tid + 512 * i; tk[i] = *(const u32x4*)(KB + (size_t)(LATG + bl * CTXL + (c >> 3)) * DM + 64 * h + 8 * (c & 7)); tv[i] = *(const u32x4*)(vsrc + (size_t)(c >> 5) * CTXL + 8 * (c & 31)); }
#pragma unroll
    for (int i = 0; i < 4; ++i) { const int c = tid + 512 * i; *(u32x4*)(KC + (c >> 3) * AT_KC_LD + 8 * (c & 7)) = tk[i]; *(u32x4*)(VC + (c >> 5) * AT_VC_LD + 8 * (c & 31)) = tv[i]; }
    const float* rp = a.in[I_RPB] + (size_t)(l * 16 + h) * 465;
    if (tid < 466) RP[tid] = tid < 465 ? rp[tid] * 1.44269504f : -__builtin_inff();
}
__device__ __forceinline__ int win_fk(int kcol) { return ((kcol >> 1) & 1) | (((kcol >> 3) & 3) << 1); }
__device__ __forceinline__ void win_fetch_k(u32x4 (&wr)[9], const bf16* KB, int bl, int h, int ws0, int tid) {
#pragma unroll
    for (int i = 0; i < 9; ++i) { const int c = tid + 512 * i, kidx = c >> 3, chunk = c & 7, wi = kidx >> 6, kcol = kidx & 63, grow = min(ws0 + wi, 31);
        wr[i] = *(const u32x4*)(KB + (unsigned)((bl * SEQ + 64 * grow + kcol) * DM + 64 * h + 8 * chunk)); }
}
__device__ __forceinline__ void win_put_k(const u32x4 (&wr)[9], unsigned char* win, int tid) {
#pragma unroll
    for (int i = 0; i < 9; ++i) { const int c = tid + 512 * i, kidx = c >> 3, chunk = c & 7, kcol = kidx & 63; *(u32x4*)(win + kidx * 128 + ((chunk ^ win_fk(kcol)) << 4)) = wr[i]; }
}
__device__ __forceinline__ void win_fetch_v(u32x4 (&wr)[9], const bf16* VT, int bl, int h, int ws0, int tid) {
#pragma unroll
    for (int i = 0; i < 9; ++i) { const int c = tid + 512 * i, line = c >> 3, chunk = c & 7, wi = line >> 6, dd = line & 63, grow = min(ws0 + wi, 31);
        wr[i] = *(const u32x4*)(VT + (unsigned)(((bl * 16 + h) * 64 + dd) * SEQ + 64 * grow + 8 * chunk)); }
}
__device__ __forceinline__ void win_put_v(const u32x4 (&wr)[9], unsigned char* win, int tid) {
#pragma unroll
    for (int i = 0; i < 9; ++i) { const int c = tid + 512 * i, line = c >> 3, chunk = c & 7, dd = line & 63; *(u32x4*)(win + line * 128 + ((chunk ^ ((dd >> 1) & 7)) << 4)) = wr[i]; }
}
__device__ __forceinline__ void attn_ctx_seg(const unsigned char* lds, const bf16x8 Bq0, const bf16x8 Bq1, int q, int quad, int kq, int one, accv (&O2)[4], float& m2, float& l2) {
    const bf16* KC = (const bf16*)(lds + AT_KC); const bf16* VC = (const bf16*)(lds + AT_VC);
    const float NEG = -__builtin_inff();
    accv S[16];
    const bf16* kc0 = KC + kq * AT_KC_LD + 8 * quad;
#pragma unroll
    for (int g4 = 0; g4 < 4; ++g4) {
        if (one) { asm volatile("");
            bf16x8 Kc[4][2];
#pragma unroll
            for (int i = 0; i < 4; ++i) { const int kb = 4 * g4 + i; const bf16* kp = kc0 + (32 * (kb >> 1) + 4 * (kb & 1)) * AT_KC_LD; Kc[i][0] = *(const bf16x8*)kp; Kc[i][1] = *(const bf16x8*)(kp + 32); }
            SCHED_FENCE();
#pragma unroll
            for (int i = 0; i < 4; ++i) { accv s = {0.f, 0.f, 0.f, 0.f};
                s = __builtin_amdgcn_mfma_f32_16x16x32_bf16(Kc[i][0], Bq0, s, 0, 0, 0); s = __builtin_amdgcn_mfma_f32_16x16x32_bf16(Kc[i][1], Bq1, s, 0, 0, 0); S[4 * g4 + i] = s; } }
    }
    float mx = NEG;
#pragma unroll
    for (int kb = 0; kb < 16; ++kb) mx = fmaxf(fmaxf(fmaxf(S[kb][0], S[kb][1]), fmaxf(S[kb][2], S[kb][3])), mx);
    { const int lane = quad * 16 + q; mx = fmaxf(mx, SHX(mx, 16)); mx = fmaxf(mx, SHX(mx, 32)); }
    float sum = 0.f; u32x2 Pc[16];
#pragma unroll
    for (int kb = 0; kb < 16; ++kb) { float p[4];
#pragma unroll
        for (int rr = 0; rr < 4; ++rr) { p[rr] = __builtin_amdgcn_exp2f(S[kb][rr] - mx); sum += p[rr]; }
        Pc[kb].x = pg8::cvt_pk_bf16(p[0], p[1]); Pc[kb].y = pg8::cvt_pk_bf16(p[2], p[3]); }
    { const int lane = quad * 16 + q; sum += SHX(sum, 16); sum += SHX(sum, 32); }
    m2 = mx; l2 = sum;
#pragma unroll
    for (int db = 0; db < 4; ++db) O2[db] = (accv){0.f, 0.f, 0.f, 0.f};
    const bf16* vb = VC + q * AT_VC_LD + 8 * quad;
#pragma unroll
    for (int g2 = 0; g2 < 4; ++g2) {
        if (one) { asm volatile("");
            u32x4 Vc[2][4];
#pragma unroll
            for (int p2 = 0; p2 < 2; ++p2)
#pragma unroll
                for (int db = 0; db < 4; ++db) Vc[p2][db] = *(const u32x4*)(vb + 16 * db * AT_VC_LD + 32 * (2 * g2 + p2));
            SCHED_FENCE();
#pragma unroll
            for (int p2 = 0; p2 < 2; ++p2) { const int pi = 2 * g2 + p2;
                u32x4 pw; pw.x = Pc[2 * pi].x; pw.y = Pc[2 * pi].y; pw.z = Pc[2 * pi + 1].x; pw.w = Pc[2 * pi + 1].y;
                const bf16x8 Bp = __builtin_bit_cast(bf16x8, pw);
#pragma unroll
                for (int db = 0; db < 4; ++db) O2[db] = __builtin_amdgcn_mfma_f32_16x16x32_bf16(__builtin_bit_cast(bf16x8, Vc[p2][db]), Bp, O2[db], 0, 0, 0); } }
    }
}
__device__ __forceinline__ void attn_store(bf16* op, const accv (&O1)[4], const accv (&O2)[4], float m1, float l1, float m2, float l2) {
    const float m = fmaxf(m1, m2), f1 = __builtin_amdgcn_exp2f(m1 - m), f2 = __builtin_amdgcn_exp2f(m2 - m);
    const float inv = 1.0f / (l1 * f1 + l2 * f2), g1 = f1 * inv, g2 = f2 * inv;
#pragma unroll
    for (int db = 0; db < 4; ++db) { u32x2 w; w.x = pk2(O1[db][0] * g1 + O2[db][0] * g2, O1[db][1] * g1 + O2[db][1] * g2); w.y = pk2(O1[db][2] * g1 + O2[db][2] * g2, O1[db][3] * g1 + O2[db][3] * g2); *(u32x2*)(op + 16 * db) = w; }
}
__device__ __forceinline__ void attn_iter(const Args& a, unsigned char* lds, int bl, int h, int r0, int wave, bf16x8 (&qf)[2], int nq) {
    unsigned char* ws = a.ws;
    const bf16* QB = (const bf16*)(ws + A_QB); const bf16* KB = (const bf16*)(ws + A_KB); const bf16* VT = (const bf16*)(ws + A_VT); bf16* YN = (bf16*)(ws + A_YN);
    const float* RP = (const float*)(lds + AT_RP); unsigned char* win = lds + AT_WIN;
    const int r = r0 + (wave >> 2), j = wave & 3;
    const int ws0 = min(max(r0 - 4, 0), 24), start = min(max(r - 4, 0), 24), kstart = min(max(16 * j - 8, 0), 32), wl0 = start - ws0;
    int one = 1; asm volatile("" : "+s"(one));
    const float NEG = -__builtin_inff();
    u32x4 wr[9];
    { const int tid = wave * 64 + lane_id_fresh(); win_fetch_k(wr, KB, bl, h, ws0, tid); }
    SCHED_FENCE();
    accv O2[4]; float m2, l2;
    { const int lane = lane_id_fresh(), q = lane & 15, quad = lane >> 4; attn_ctx_seg(lds, qf[0], qf[1], q, quad, 8 * (q >> 2) + (q & 3), one, O2, m2, l2); }
    __syncthreads();
    { const int tid = wave * 64 + lane_id_fresh(); win_put_k(wr, win, tid); }
    __syncthreads();
    const int lane = lane_id_fresh(), q = lane & 15, quad = lane >> 4, kq = 8 * (q >> 2) + (q & 3);
    const bf16x8 Bq0 = qf[0], Bq1 = qf[1];
    accv S[16];
    {
        const int kcol0 = kstart + kq, kcol1 = kcol0 + 4;
        const unsigned char* k0 = win + (wl0 * 64 + kcol0) * 128, *k1 = win + (wl0 * 64 + kcol1) * 128;
        const int f0 = win_fk(kcol0), f1 = win_fk(kcol1);
        const int o00 = (quad ^ f0) << 4, o01 = ((quad + 4) ^ f0) << 4, o10 = (quad ^ f1) << 4, o11 = ((quad + 4) ^ f1) << 4;
#pragma unroll
        for (int g4 = 0; g4 < 4; ++g4) {
            if (one) { asm volatile("");
                bf16x8 Kw[4][2];
#pragma unroll
                for (int i = 0; i < 4; ++i) { const int kb = 4 * g4 + i; const unsigned char* kp = ((kb & 1) ? k1 : k0) + (kb >> 1) * 64 * 128;
                    Kw[i][0] = *(const bf16x8*)(kp + ((kb & 1) ? o10 : o00)); Kw[i][1] = *(const bf16x8*)(kp + ((kb & 1) ? o11 : o01)); }
                SCHED_FENCE();
#pragma unroll
                for (int i = 0; i < 4; ++i) { accv s = {0.f, 0.f, 0.f, 0.f};
                    s = __builtin_amdgcn_mfma_f32_16x16x32_bf16(Kw[i][0], Bq0, s, 0, 0, 0); s = __builtin_amdgcn_mfma_f32_16x16x32_bf16(Kw[i][1], Bq1, s, 0, 0, 0); S[4 * g4 + i] = s; } }
        }
    }
    SCHED_FENCE();
    { const int tid = wave * 64 + lane; win_fetch_v(wr, VT, bl, h, ws0, tid); }
    SCHED_FENCE();
    float m1, l1; u32x2 Pl[16];
    {
        const int qc = 16 * j + q, wst = min(max(qc - 8, 0), 48);
        int cof[2][4];
#pragma unroll
        for (int hb = 0; hb < 2; ++hb)
#pragma unroll
            for (int rr = 0; rr < 4; ++rr) { const int kc = kstart + 8 * quad + 4 * hb + rr; const bool ok = (kc >= wst) && (kc < wst + 16); cof[hb][rr] = ok ? min(max(kc - qc + 15, 0), 30) : -1; }
        const int rob = (start - r + 7) * 31;
#pragma unroll
        for (int g4 = 0; g4 < 4; ++g4) {
            if (one) { asm volatile("");
                float bw[4][4];
#pragma unroll
                for (int i = 0; i < 4; ++i) { const int kb = 4 * g4 + i;
#pragma unroll
                    for (int rr = 0; rr < 4; ++rr) { const int c = cof[kb & 1][rr]; bw[i][rr] = RP[c < 0 ? 465 : rob + (kb >> 1) * 31 + c]; } }
#pragma unroll
                for (int i = 0; i < 4; ++i) { const int kb = 4 * g4 + i;
#pragma unroll
                    for (int rr = 0; rr < 4; ++rr) S[kb][rr] += bw[i][rr]; } }
        }
        float mx = NEG;
#pragma unroll
        for (int kb = 0; kb < 16; ++kb) mx = fmaxf(fmaxf(fmaxf(S[kb][0], S[kb][1]), fmaxf(S[kb][2], S[kb][3])), mx);
        mx = fmaxf(mx, SHX(mx, 16)); mx = fmaxf(mx, SHX(mx, 32));
        float sum = 0.f;
#pragma unroll
        for (int kb = 0; kb < 16; ++kb) { float p[4];
#pragma unroll
            for (int rr = 0; rr < 4; ++rr) { p[rr] = __builtin_amdgcn_exp2f(S[kb][rr] - mx); sum += p[rr]; }
            Pl[kb].x = pg8::cvt_pk_bf16(p[0], p[1]); Pl[kb].y = pg8::cvt_pk_bf16(p[2], p[3]); }
        sum += SHX(sum, 16); sum += SHX(sum, 32);
        m1 = mx; l1 = sum;
    }
    __syncthreads();
    { const int tid = wave * 64 + lane; win_put_v(wr, win, tid); }
    __syncthreads();
    if (nq >= 0) { const bf16* qn = QB + (size_t)(nq + q) * DM + 64 * h + 8 * quad; qf[0] = *(const bf16x8*)qn; qf[1] = *(const bf16x8*)(qn + 32); }
    accv O1[4];
#pragma unroll
    for (int db = 0; db < 4; ++db) O1[db] = (accv){0.f, 0.f, 0.f, 0.f};
    {
        const int chunk = (kstart >> 3) + quad;
#pragma unroll
        for (int g2 = 0; g2 < 4; ++g2) {
            if (one) { asm volatile("");
                u32x4 Vw[2][4];
#pragma unroll
                for (int p2 = 0; p2 < 2; ++p2)
#pragma unroll
                    for (int db = 0; db < 4; ++db) { const int dd = 16 * db + q; Vw[p2][db] = *(const u32x4*)(win + ((wl0 + 2 * g2 + p2) * 64 + dd) * 128 + ((chunk ^ ((dd >> 1) & 7)) << 4)); }
                SCHED_FENCE();
#pragma unroll
                for (int p2 = 0; p2 < 2; ++p2) { const int pi = 2 * g2 + p2;
                    u32x4 pw; pw.x = Pl[2 * pi].x; pw.y = Pl[2 * pi].y; pw.z = Pl[2 * pi + 1].x; pw.w = Pl[2 * pi + 1].y;
                    const bf16x8 Bp = __builtin_bit_cast(bf16x8, pw);
#pragma unroll
                    for (int db = 0; db < 4; ++db) O1[db] = __builtin_amdgcn_mfma_f32_16x16x32_bf16(__builtin_bit_cast(bf16x8, Vw[p2][db]), Bp, O1[db], 0, 0, 0); } }
        }
    }
    attn_store(YN + (size_t)(bl * SEQ + 64 * r + 16 * j + q) * DM + 64 * h + 4 * quad, O1, O2, m1, l1, m2, l2);
}
__device__ __forceinline__ void attn_ctx_unit(const Args& a, const unsigned char* lds, int bl, int h, int qb, bf16x8 (&qf)[2]) {
    bf16* YN = (bf16*)(a.ws + A_YN);
    int one = 1; asm volatile("" : "+s"(one));
    const int lane = lane_id_fresh(), q = lane & 15, quad = lane >> 4;
    accv O2[4], O1[4]; float m2, l2;
    attn_ctx_seg(lds, qf[0], qf[1], q, quad, 8 * (q >> 2) + (q & 3), one, O2, m2, l2);
#pragma unroll
    for (int db = 0; db < 4; ++db) O1[db] = (accv){0.f, 0.f, 0.f, 0.f};
    attn_store(YN + (size_t)(LATG + bl * CTXL + 16 * qb + q) * DM + 64 * h + 4 * quad, O1, O2, -__builtin_inff(), 0.f, m2, l2);
}
__device__ __forceinline__ void attn_block(const Args& a, unsigned char* lds, int l, int bu, bool ctx_out, int wave) {
    const int bl = bu >> 5, h = (bu >> 1) & 15, half = bu & 1;
    __syncthreads();
    attn_stage(a, lds, l, bl, h, wave * 64 + lane_id_fresh());
    __syncthreads();
    const int j = wave & 3, rw = 16 * half + (wave >> 2);
    bf16x8 qf[2];
    { const int lane = lane_id_fresh(); const bf16* qp = (const bf16*)(a.ws + A_QB) + (size_t)(bl * SEQ + 64 * rw + 16 * j + (lane & 15)) * DM + 64 * h + 8 * (lane >> 4); qf[0] = *(const bf16x8*)qp; qf[1] = *(const bf16x8*)(qp + 32); }
    for (int it = 0; it < 8; ++it) {
        const int nq = it < 7 ? bl * SEQ + 64 * (rw + 2 * it + 2) + 16 * j : (ctx_out ? LATG + bl * CTXL + 16 * (8 * half + wave) : -1);
        attn_iter(a, lds, bl, h, 16 * half + 2 * it, wave, qf, nq); }
    if (ctx_out) attn_ctx_unit(a, lds, bl, h, 8 * half + wave, qf);
    __syncthreads();
}
constexpr int NPH = 1 + 2 * 30;
__host__ __device__ constexpr bool phase_used(int ph) { if (ph == 0) return true; const int q = ph - 1, l = q / 30, r = q % 30; if (l == 0) return r < 24 ? (r % 12) <= 5 : r <= 26; return r < 24 && (r % 12) <= 10; }

#define RFL(x) __builtin_amdgcn_readfirstlane(x)
#if defined(__HIP_DEVICE_COMPILE__)
__device__ __forceinline__ Args load_kargs() { const __attribute__((address_space(4))) unsigned long long* p = (const __attribute__((address_space(4))) unsigned long long*)__builtin_amdgcn_kernarg_segment_ptr();
    asm volatile("" : "+s"(p)); Args r;
    typedef __attribute__((address_space(1))) float gf32; typedef __attribute__((address_space(1))) unsigned char gu8;
#pragma unroll
    for (int i = 0; i < 25; ++i) r.in[i] = (const float*)(const gf32*)p[i];
    r.out = (float*)(gf32*)p[25]; r.ws = (unsigned char*)(gu8*)p[26];
    const unsigned long long w = p[27]; r.ph_lo = (int)(unsigned)w; r.ph_hi = (int)(unsigned)(w >> 32);
    return r; }
#define LOAD_KARGS() load_kargs()
#else
#define LOAD_KARGS() a_in
#endif
#define PHASE_IDS() const Args a = LOAD_KARGS(); unsigned char* const ws = a.ws; (void)ws; int lane_l; asm volatile("v_mbcnt_lo_u32_b32 %0, -1, 0\n\tv_mbcnt_hi_u32_b32 %0, -1, %0" : "=v"(lane_l)); int wave_l = wave_s; asm volatile("" : "+s"(wave_l)); const int lane = lane_l, wave = wave_l, tid = wave_l * 64 + lane, gw = blk * NWAVES + wave, NGW = G * NWAVES; const float* modl = (const float*)(ws + WS_MOD) + (size_t)l * 17 * NMOD; const float* xin_lat = (l == 0 ? a.in[I_X] : a.out) + (size_t)g * LATG * DM; const float* xin_ctx = (l == 0 ? a.in[I_CTX] : (const float*)(ws + WS_XC)) + (size_t)g * CTXG * DM; float* xs_lat = a.out + (size_t)g * LATG * DM; float* xs_ctx = (float*)(ws + WS_XC) + (size_t)g * CTXG * DM; bf16* xsb_lat = (bf16*)a.out + (size_t)g * LATG * XS_LD; bf16* xsb_ctx = (bf16*)(ws + WS_XC) + (size_t)g * CTXG * XS_LD; (void)xsb_lat; (void)xsb_ctx; (void)modl; (void)xin_lat; (void)xin_ctx; (void)xs_lat; (void)xs_ctx; (void)lane; (void)wave; (void)gw; (void)NGW; (void)tid
__global__ void __launch_bounds__(NTHR, 2) fwd(Args a_in) {
    extern __shared__ __attribute__((aligned(16))) unsigned char lds[];
    const int tid = threadIdx.x, lane = tid & 63, wave = __builtin_amdgcn_readfirstlane(tid >> 6), G = gridDim.x, blk = blockIdx.x;
    const int wave_s = wave;
    if (tid < 16) ((unsigned*)(lds + MISC_OFF))[tid] = 0u;
    __syncthreads();
    XcdBarrier bar = xcd_barrier_post((unsigned*)(a_in.ws + WS_CTL) + CW_BAR, (volatile LAS unsigned*)(lds + MISC_OFF));
    const int lo = a_in.ph_lo, hi = a_in.ph_hi;
#ifndef PHMASK
#define PHMASK 0xFFFF
#endif
#define IN(k) (lo <= (k) && (k) < hi)
#define EN(k) ((PHMASK >> (k)) & 1)
#define SEAM(k) do { if ((k) + 1 < hi) xcd_barrier(bar); } while (0)
    PG8_LAS unsigned char* ring = (PG8_LAS unsigned char*)lds;

    if (EN(0) && IN(0)) { phase_prologue(a_in, lds, blk, G, wave, lane, tid, G == 256); SEAM(0); }

    for (int l = 0; l < NLAYER; ++l) {
        for (int g = 0; g < NGRP; ++g) {
            const int pb = 1 + 30 * l + 12 * g;
            if (hi <= pb || lo >= pb + 12) continue;
            int blk_l = blockIdx.x, G_l = gridDim.x; asm volatile("" : "+s"(blk_l), "+s"(G_l));
            const int blk = blk_l, G = G_l;
            const bool ctx_out = (l == 0);

            if (EN(1) && IN(pb + 0)) {
                PHASE_IDS();
                bf16* H = (bf16*)(ws + A_H);
                { const int rpw = (RG + NGW - 1) / NGW, r0 = gw * rpw, nr = RG - r0 < rpw ? RG - r0 : rpw;
                  if (l == 0) modulate_rows<false, false>(xin_lat, xin_ctx, LATG, g * BG, modl, 0, H, r0, nr, lane, nullptr, nullptr, nullptr, nullptr);
                  else {
                      const int rl = (LATG + NGW - 1) / NGW, l0r = gw * rl, nl = LATG - l0r < rl ? LATG - l0r : rl, rc = (CTXG + NGW - 1) / NGW, c0r = gw * rc, nc = CTXG - c0r < rc ? CTXG - c0r : rc;
                      modulate_rows<false, true, false>(xsb_lat, xsb_ctx, LATG, g * BG, modl, 0, H, l0r, nl, lane, nullptr, nullptr, nullptr, nullptr);
                      modulate_rows<false, true, true>(xsb_lat, xsb_ctx, LATG, g * BG, modl, 0, H, LATG + c0r, nc, lane, nullptr, nullptr, nullptr, nullptr, xsb_lat); } }
                SEAM(pb + 0);
            }
            if (EN(2) && IN(pb + 1)) {
                PHASE_IDS();
                pg8::Gemm gm{(const pg8::bf16_t*)(ws + A_H), (const pg8::bf16_t*)(ws + WS_WIN) + (size_t)l * NIN * DM, RG, NIN, DM, DM};
                int nn1 = ctx_out ? 28 : 12; asm volatile("" : "+s"(nn1));
                RectOrder S{64, 28, 8, nn1, G, blk, DM / 64};
                EpiIn E{ws, a.in[I_QG] + l * HD, a.in[I_KG] + l * HD};
                pg8::gemm_phase<EpiIn, RectOrder, false>(ring, gm, S, E, nullptr, tid);
                SEAM(pb + 1);
            }
            if (EN(3) && IN(pb + 2)) {
                PHASE_IDS();
                for (int u = blk; u < 256; u += G) rglru_unit(a, lds, l, u, ctx_out, wave, lane, tid);
                for (int bu = blk; bu < 256; bu += G) attn_block(a, lds, l, bu, ctx_out, wave);
                SEAM(pb + 2);
            }
            int nMmix = ctx_out ? 72 : 64; asm volatile("" : "+s"(nMmix));
            if (EN(4) && IN(pb + 3)) {
                PHASE_IDS();
                pg8::Gemm gm{(const pg8::bf16_t*)(ws + A_H), (const pg8::bf16_t*)(ws + WS_WRO) + (size_t)l * DM * DM, RG, DM, DM, DM};
                RectOrder S{nMmix, 4, 0, 0, G, blk, DM / 64};
                EpiGate<0> E{(const bf16*)(ws + A_SR), nullptr, (bf16*)(ws + A_T1)};
                pg8::gemm_phase<EpiGate<0>, RectOrder, false>(ring, gm, S, E, nullptr, tid);
                if (l == 0 && G == 256) moe_convert_slice(a, lds, 3 * g + 0, blk, wave, lane);
                __syncthreads();
            }
            if (EN(5) && IN(pb + 4)) {
                PHASE_IDS();
                pg8::Gemm gm{(const pg8::bf16_t*)(ws + A_YN), (const pg8::bf16_t*)(ws + WS_WNO) + (size_t)l * DM * DM, RG, DM, DM, DM};
                RectOrder S{nMmix, 4, 0, 0, G, blk, DM / 64};
                EpiGate<1> E{(const bf16*)(ws + A_SN), (const bf16*)(ws + A_T1), (bf16*)(ws + A_XR)};
                pg8::gemm_phase<EpiGate<1>, RectOrder, false>(ring, gm, S, E, nullptr, tid);
                if (l == 0 && G == 256) moe_convert_slice(a, lds, 3 * g + 1, blk, wave, lane);
                SEAM(pb + 4);
            }
            if (EN(6) && IN(pb + 5)) {
                PHASE_IDS();
                pg8::Gemm gm{(const pg8::bf16_t*)(ws + A_XR), (const pg8::bf16_t*)(ws + WS_WOUT) + (size_t)l * DM * DM, RG, DM, DM, DM};
                RectOrder S{nMmix, 4, 0, 0, G, blk, DM / 64};
                if (l == 0) { EpiRes<true> E{xin_lat, xin_ctx, xsb_lat, xsb_ctx, modl, 2, g * BG, 64}; pg8::gemm_phase<EpiRes<true>, RectOrder, false>(ring, gm, S, E, nullptr, tid); }
                else { EpiRes<false> E{xsb_lat, xsb_ctx, xsb_lat, xsb_ctx, modl, 2, g * BG, 64}; pg8::gemm_phase<EpiRes<false>, RectOrder, false>(ring, gm, S, E, nullptr, tid); }
                if (l == 0 && G == 256) moe_convert_slice(a, lds, 3 * g + 2, blk, wave, lane);
                if (l == 0 && g == 0 && MK_ONE_LAUNCH) __syncthreads(); else SEAM(pb + 5);
            }
            if (l == 0) continue;
            if (EN(7) && IN(pb + 6)) {
                PHASE_IDS();
                bf16* H2 = (bf16*)(ws + A_H2M); int* cntl = (int*)(lds + 1024);
                int* re = (int*)(ws + WS_MISC + MS_ROUTE_E); float* rw = (float*)(ws + WS_MISC + MS_ROUTE_W); int* cntg = (int*)(ws + WS_MISC + MS_CNT);
                for (int c = blk; c < LATG / 64; c += G) {
                    if (tid < 8) cntl[tid] = 0;
                    __syncthreads();
                    modulate_rows<true, true>(xsb_lat, xsb_lat, LATG, g * BG, modl, 3, H2, c * 64 + wave * 8, 8, lane, a.in[I_ROUTER], re, rw, cntl);
                    __syncthreads();
                    if (tid < 8) cntg[c * 8 + tid] = cntl[tid];
                    __syncthreads();
                }
                SEAM(pb + 6);
            }
            if (EN(8) && IN(pb + 7)) {
                PHASE_IDS();
                int* pre = (int*)lds;
                int* toff = (int*)(lds + 8192);
                int* plist = (int*)(lds + 8192 + 128);
                const int* cntg = (const int*)(ws + WS_MISC + MS_CNT); const int* re = (const int*)(ws + WS_MISC + MS_ROUTE_E); const float* rw = (const float*)(ws + WS_MISC + MS_ROUTE_W);
                int* tokslot = (int*)(ws + WS_MISC + MS_TOKSLOT); float* slotw = (float*)(ws + WS_MISC + MS_SLOTW);
                const bf16* H2 = (const bf16*)(ws + A_H2M); bf16* AM = (bf16*)(ws + A_AM);
                for (int i = tid; i < 2048; i += NTHR) pre[i] = cntg[i];
                __syncthreads();
                if (tid < 8) { int run = 0; for (int c = 0; c < 256; ++c) { const int v = pre[c * 8 + tid]; pre[c * 8 + tid] = run; run += v; } toff[10 + tid] = run; }
                __syncthreads();
                if (tid == 0) { int t = 0; for (int e = 0; e < 8; ++e) { toff[e] = t; t += (toff[10 + e] + 255) >> 8; } toff[8] = t; toff[9] = t;
                    if (blk == 0) { int* tg = (int*)(ws + WS_MISC + MS_TOFF); for (int e = 0; e < 10; ++e) tg[e] = toff[e]; } }
                __syncthreads();
                for (int c = blk; c < LATG / 64; c += G) {
                    if (wave == 0) { const int r = c * 64 + lane, ee = re[r], e0 = ee & 255, e1 = ee >> 8; int s0 = 0, s1 = 0;
                        const unsigned long long lt = (1ull << lane) - 1ull;
#pragma unroll
                        for (int e = 0; e < 8; ++e) { const unsigned long long m0 = __ballot(e0 == e), m1 = __ballot(e1 == e);
                            const int base = toff[e] * 256 + pre[c * 8 + e];
                            if (e0 == e) s0 = base + __popcll(m0 & lt);
                            if (e1 == e) s1 = base + __popcll(m0) + __popcll(m1 & lt); }
                        tokslot[2 * r] = s0; tokslot[2 * r + 1] = s1; slotw[s0] = rw[2 * r]; slotw[s1] = rw[2 * r + 1];
                        plist[4 * lane] = s0; plist[4 * lane + 1] = r; plist[4 * lane + 2] = s1; plist[4 * lane + 3] = r; }
                    __syncthreads();
                    for (int pb8 = wave * 16; pb8 < wave * 16 + 16; pb8 += 8) {
                        u32x4 t0[8], t1[8];
#pragma unroll
                        for (int i = 0; i < 8; ++i) { const int r = plist[2 * (pb8 + i) + 1]; const u32x4* src = (const u32x4*)(H2 + (size_t)r * DM); t0[i] = src[lane]; t1[i] = src[64 + lane]; }
#pragma unroll
                        for (int i = 0; i < 8; ++i) { const int slot = plist[2 * (pb8 + i)]; u32x4* dst = (u32x4*)(AM + (size_t)slot * DM); dst[lane] = t0[i]; dst[64 + lane] = t1[i]; } }
                    __syncthreads();
                }
                SEAM(pb + 7);
            }
            if (EN(9) && IN(pb + 8)) {
                PHASE_IDS();
                const int* tg = (const int*)(ws + WS_MISC + MS_TOFF);
                pg8::Gemm gm{(const pg8::bf16_t*)(ws + A_AM), (const pg8::bf16_t*)(ws + WS_WM13), MOE_ROWS_MAX, 2 * DFE, DM, DM};
                MoeOrder S{RFL(tg[8]), 28, G, blk, RFL(tg[1]), RFL(tg[2]), RFL(tg[3]), RFL(tg[4]), RFL(tg[5]), RFL(tg[6]), RFL(tg[7]), DM / 64};
                EpiSwi<true> E{(bf16*)(ws + A_ACTM), DFE, 28, (const float*)(ws + WS_MISC + MS_SLOTW)};
                pg8::gemm_phase<EpiSwi<true>, MoeOrder, false>(ring, gm, S, E, nullptr, tid);
                SEAM(pb + 8);
            }
            if (EN(10) && IN(pb + 9)) {
                PHASE_IDS();
                const int* tg = (const int*)(ws + WS_MISC + MS_TOFF);
                pg8::Gemm gm{(const pg8::bf16_t*)(ws + A_ACTM), (const pg8::bf16_t*)(ws + WS_WM2), MOE_ROWS_MAX, DM, DFE, DFE};
                MoeDownOrder S{RFL(tg[8]), G, blk, RFL(tg[1]), RFL(tg[2]), RFL(tg[3]), RFL(tg[4]), RFL(tg[5]), RFL(tg[6]), RFL(tg[7])};
                EpiY E{(bf16*)(ws + A_Y), 4, (bf16*)(ws + A_YPART)};
                pg8::gemm_phase<EpiY, MoeDownOrder, false>(ring, gm, S, E, nullptr, tid);
                SEAM(pb + 9);
            }
            if (EN(11) && IN(pb + 10)) {
                PHASE_IDS();
                const int* tokslot = (const int*)(ws + WS_MISC + MS_TOKSLOT); const bf16* Y = (const bf16*)(ws + A_Y); const bf16* YP = (const bf16*)(ws + A_YPART);
                for (int r = gw; r < LATG; r += NGW) { const int s0 = tokslot[2 * r], s1 = tokslot[2 * r + 1], mrow = g * BG + r / SEQ;
                    const float* gp = modl + (size_t)mrow * NMOD + 5 * DM; float* xr = xs_lat + (size_t)r * DM; const bf16* xb = xsb_lat + (size_t)r * XS_LD;
                    u32x2 y0[4], y1[4], xw[4]; f32x4 gv[4], xv[4];
                    const bool o0 = (s0 >> 8) >= MOE_MAIN_TILES, o1 = (s1 >> 8) >= MOE_MAIN_TILES;
                    const bf16* p0 = o0 ? YP + (size_t)(s0 - MOE_MAIN_TILES * 256) * DM : Y + (size_t)s0 * DM; const bf16* p1 = o1 ? YP + (size_t)(s1 - MOE_MAIN_TILES * 256) * DM : Y + (size_t)s1 * DM;
#pragma unroll
                    for (int j = 0; j < 4; ++j) { const int col = 4 * lane + 256 * j;
                        y0[j] = *(const u32x2*)(p0 + col); y1[j] = *(const u32x2*)(p1 + col); gv[j] = *(const f32x4*)(gp + col); xw[j] = *(const u32x2*)(xb + col); }
#pragma unroll
                    for (int j = 0; j < 4; ++j) xv[j] = (f32x4){bflo(xw[j].x), bfhi(xw[j].x), bflo(xw[j].y), bfhi(xw[j].y)};
                    f32x4 ys[4];
#pragma unroll
                    for (int j = 0; j < 4; ++j) ys[j] = (f32x4){bflo(y0[j].x) + bflo(y1[j].x), bfhi(y0[j].x) + bfhi(y1[j].x), bflo(y0[j].y) + bflo(y1[j].y), bfhi(y0[j].y) + bfhi(y1[j].y)};
                    if (o0 || o1) {
                        for (int ks = 1; ks < MOE_KS; ++ks) { const size_t po = (size_t)ks * 8 * 256 * DM;
#pragma unroll
                            for (int j = 0; j < 4; ++j) { const int col = 4 * lane + 256 * j;
                                if (o0) { const u32x2 t = *(const u32x2*)(p0 + po + col); ys[j].x += bflo(t.x); ys[j].y += bfhi(t.x); ys[j].z += bflo(t.y); ys[j].w += bfhi(t.y); }
                                if (o1) { const u32x2 t = *(const u32x2*)(p1 + po + col); ys[j].x += bflo(t.x); ys[j].y += bfhi(t.x); ys[j].z += bflo(t.y); ys[j].w += bfhi(t.y); } } } }
#pragma unroll
                    for (int j = 0; j < 4; ++j) ys[j] = xv[j] + gv[j] * ys[j];
                    asm volatile("s_waitcnt vmcnt(0)" ::: "memory");
#pragma unroll
                    for (int j = 0; j < 4; ++j) { const int col = 4 * lane + 256 * j; *(f32x4*)(xr + col) = ys[j]; } }
                if (g + 1 < NGRP && MK_ONE_LAUNCH) {} else SEAM(pb + 10);
            }
        }
        if (l == 0 && !(hi <= 25 || lo >= 28)) {
            int blk_l = blockIdx.x, G_l = gridDim.x; asm volatile("" : "+s"(blk_l), "+s"(G_l));
            const int blk = blk_l, G = G_l, g = 0; (void)g;
            constexpr int NLAT = NB * SEQ, NALL = NLAT + NB * CTXL;
            if (EN(7) && IN(25)) {
                PHASE_IDS();
                bf16* H2 = (bf16*)(ws + A_H2);
                { const int rpw = (NALL + NGW - 1) / NGW, r0 = gw * rpw, nr = NALL - r0 < rpw ? NALL - r0 : rpw;
                  modulate_rows<false, true>(a.out, ws + WS_XC, NLAT, 0, modl, 3, H2, r0, nr, lane, nullptr, nullptr, nullptr, nullptr); }
                SEAM(25);
            }
            if (EN(8) && IN(26)) {
                PHASE_IDS();
                pg8::Gemm gm{(const pg8::bf16_t*)(ws + A_H2), (const pg8::bf16_t*)(ws + WS_WF13), NALL, 2 * DFF, DM, DM};
                RectOrder S{144, 22, 0, 0, G, blk, DM / 64};
                EpiSwi<false> E{(bf16*)(ws + A_ACT), DFF, 22, nullptr};
                pg8::gemm_phase<EpiSwi<false>, RectOrder, false>(ring, gm, S, E, nullptr, tid);
                SEAM(26);
            }
            if (EN(9) && IN(27)) {
                PHASE_IDS();
                pg8::Gemm gm{(const pg8::bf16_t*)(ws + A_ACT), (const pg8::bf16_t*)(ws + WS_WF2), NALL, DM, DFF, DFF};
                FfnDownOrder S{G, blk};
                EpiRes<false, true> E{a.out, ws + WS_XC, (bf16*)a.out, (bf16*)(ws + WS_XC), modl, 5, 0, 128};
                pg8::gemm_phase<EpiRes<false, true>, FfnDownOrder, false>(ring, gm, S, E, nullptr, tid);
                SEAM(27);
            }
        }
    }
#undef IN
#undef SEAM
}

extern "C" void kernel_launch(void* const* d_in, const int* in_sizes, int n_in, void* d_out, int out_size, void* d_ws, size_t ws_size, hipStream_t stream) {
    static int grid = 0;
    if (grid == 0) {
        if (n_in != 25 || out_size != NB * SEQ * DM || ws_size < WS_END) { fprintf(stderr, "kernel_launch: unexpected shapes (n_in %d, out %d, ws %zu < %zu)\n", n_in, out_size, ws_size, (size_t)WS_END); grid = -1; return; }
        int dev = 0, cus = 0, per_cu = 0;
        if (hipGetDevice(&dev) != hipSuccess || hipDeviceGetAttribute(&cus, hipDeviceAttributeMultiprocessorCount, dev) != hipSuccess) { grid = -1; return; }
        if (hipFuncSetAttribute((const void*)fwd, hipFuncAttributeMaxDynamicSharedMemorySize, LDS_BYTES) != hipSuccess) { fprintf(stderr, "kernel_launch: hipFuncSetAttribute failed\n"); grid = -1; return; }
        if (hipOccupancyMaxActiveBlocksPerMultiprocessor(&per_cu, (const void*)fwd, NTHR, LDS_BYTES) != hipSuccess || per_cu < 1) fprintf(stderr, "kernel_launch: occupancy query reports %d\n", per_cu);
        (void)hipGetLastError();
        grid = cus;
    }
    if (grid < 0) return;
    if (hipMemsetAsync((char*)d_ws + WS_CTL, 0, CTL_ZERO_BYTES, stream) != hipSuccess) return;
    Args a{};
    for (int i = 0; i < 25; ++i) a.in[i] = (const float*)d_in[i];
    a.out = (float*)d_out; a.ws = (unsigned char*)d_ws;
#if MK_ONE_LAUNCH
    a.ph_lo = 0; a.ph_hi = NPH;
    hipLaunchKernelGGL(fwd, dim3(grid), dim3(NTHR), LDS_BYTES, stream, a);
#else
    for (int ph = 0; ph < NPH; ++ph) { if (!phase_used(ph)) continue; a.ph_lo = ph; a.ph_hi = ph + 1; hipLaunchKernelGGL(fwd, dim3(grid), dim3(NTHR), LDS_BYTES, stream, a); }
#endif
}
```

```cpp
#include <hip/hip_runtime.h>
#include <cstdio>
#include <cstdint>
#include <type_traits>
#ifndef MK_ONE_LAUNCH
#define MK_ONE_LAUNCH 1
#endif
#define XB_TMO      128
#define XB_XCNT(j)  (256  + 64 * (j))
#define XB_XSUB(j)  (1280 + 64 * (j))
#define XB_XGEN(j)  (2304 + 64 * (j))
#define XB_TOP      3328
#define XB_TOPGEN   3392
#define XCD_BAR_WORDS 3456
#define XB_SPIN_CAP (1u << 22)
#define LAS __attribute__((address_space(3)))

__device__ __forceinline__ unsigned xb_ld(unsigned* p)              { return __hip_atomic_load(p, __ATOMIC_RELAXED, __HIP_MEMORY_SCOPE_AGENT); }
__device__ __forceinline__ unsigned xb_add(unsigned* p, unsigned v) { return __hip_atomic_fetch_add(p, v, __ATOMIC_RELAXED, __HIP_MEMORY_SCOPE_AGENT); }
__device__ __forceinline__ unsigned xb_xcc_id() { return (unsigned)__builtin_amdgcn_s_getreg((3 << 11) | 20) & 0xFu; }
#define XB_SPIN(cond, bar) do { unsigned _sp = 0; while (cond) { __builtin_amdgcn_s_sleep(1); \
    if ((++_sp & 255u) == 0u) { if (xb_ld(&(bar)[XB_TMO])) break; if (_sp > XB_SPIN_CAP) { atomicAdd(&(bar)[XB_TMO], 1u); break; } } } } while (0)

struct XcdBarrier {
    unsigned* bar; unsigned x;
    volatile LAS unsigned* st;
};

__device__ __forceinline__ XcdBarrier xcd_barrier_post(unsigned* bar, volatile LAS unsigned* st) {
    XcdBarrier b; b.bar = bar; b.x = xb_xcc_id(); b.st = st;
    if (threadIdx.x == 0) (void)xb_add(&bar[XB_XCNT(b.x)], 1u);
    return b;
}
__device__ __forceinline__ void xcd_barrier_complete(unsigned* bar, unsigned x, unsigned& nloc, unsigned& nx) {
    const unsigned G = gridDim.x * gridDim.y * gridDim.z;
    unsigned sum, cnt, mine, sp = 0u;
    for (;;) {
        sum = 0u; cnt = 0u; mine = 0u;
#pragma unroll
        for (unsigned j = 0; j < 16; ++j) { const unsigned c = xb_ld(&bar[XB_XCNT(j)]); sum += c; cnt += (c > 0u) ? 1u : 0u; mine = (j == x) ? c : mine; }
        if (sum == G) break;
        __builtin_amdgcn_s_sleep(1);
        if ((++sp & 255u) == 0u) { if (xb_ld(&bar[XB_TMO])) break; if (sp > XB_SPIN_CAP) { atomicAdd(&bar[XB_TMO], 1u); break; } }
    }
    nloc = mine > 0u ? mine : 1u; nx = cnt > 0u ? cnt : 1u;
}

__device__ __forceinline__ void xcd_barrier(const XcdBarrier& b) {
    asm volatile("s_waitcnt vmcnt(0)" ::: "memory");
    __syncthreads();
    if (threadIdx.x == 0) {
        unsigned* bar = b.bar;
        __builtin_amdgcn_s_waitcnt(0);
        unsigned nloc = b.st[0], nx = b.st[1];
        if (nloc == 0u) { xcd_barrier_complete(bar, b.x, nloc, nx); b.st[0] = nloc; b.st[1] = nx; }
        const unsigned old = xb_add(&bar[XB_XSUB(b.x)], 1u);
        const unsigned gen = old / nloc;
        if (old + 1u == (gen + 1u) * nloc) {
            __builtin_amdgcn_fence(__ATOMIC_RELEASE, "agent");
            asm volatile("s_waitcnt vmcnt(0)" ::: "memory");
            const unsigned og = xb_add(&bar[XB_TOP], 1u);
            const unsigned tg = og / nx;
            if (og + 1u == (tg + 1u) * nx) xb_add(&bar[XB_TOPGEN], 1u);
            else XB_SPIN(xb_ld(&bar[XB_TOPGEN]) == tg, bar);
            __builtin_amdgcn_fence(__ATOMIC_ACQUIRE, "agent");
            xb_add(&bar[XB_XGEN(b.x)], 1u);
            asm volatile("s_waitcnt vmcnt(0)" ::: "memory");
        } else {
            XB_SPIN(xb_ld(&bar[XB_XGEN(b.x)]) == gen, bar);
            __builtin_amdgcn_fence(__ATOMIC_ACQUIRE, "agent");
            asm volatile("s_waitcnt vmcnt(0)" ::: "memory");
        }
    }
    __syncthreads();
}

namespace pg8 {
#define PG8_LAS __attribute__((address_space(3)))
typedef unsigned short bf16_t;
typedef short bf16x8 __attribute__((ext_vector_type(8)));
typedef float f32x4 __attribute__((ext_vector_type(4)));
typedef unsigned u32x4 __attribute__((ext_vector_type(4)));
constexpr int BM = 256, BK = 64, HALF = 128, HTB = HALF * BK * 2  , STAGE_BYTES = 8 * HTB, NXCD = 8, WGM = 8;

__host__ __device__ __forceinline__ int lds_byte(int r, int c) { const int st = (r >> 4) * 2 + (c >> 5), rr = r & 15, cc = c & 31, ob = rr * 64 + cc * 2; return st * 1024 + (ob ^ (((ob >> 9) & 1) << 5)); }
__host__ __device__ __forceinline__ void stage_rc(int b, int& R, int& C) { const int st = b / 1024, sb = b % 1024, swz = sb ^ (((sb >> 9) & 1) << 5); R = (st >> 1) * 16 + swz / 64; C = (st & 1) * 32 + (swz % 64) / 2; }
__host__ __device__ __forceinline__ int perm32(int rho) { const int n = rho >> 4, i = rho & 15; return 8 * (i >> 2) + 4 * n + (i & 3); }

struct Unit { int pm, pn, koff, nt; };
struct Gemm { const bf16_t* A; const bf16_t* Bt; int M, N, K, ld; };
__device__ __forceinline__ unsigned cvt_pk_bf16(float lo, float hi) { unsigned r; asm volatile("v_cvt_pk_bf16_f32 %0, %1, %2" : "=v"(r) : "v"(lo), "v"(hi)); return r; }
typedef float f32x2 __attribute__((ext_vector_type(2)));
template <class Epi, class Sched, bool STAMP = false, bool GATHER = false>
__device__ __forceinline__ void gemm_phase(PG8_LAS unsigned char* lds, const Gemm g, const Sched& S, const Epi& E, unsigned long long* stamps, int tid_in, const PG8_LAS int* rowmap = nullptr) {
    int tid_l = tid_in; asm volatile("" : "+v"(tid_l));
    const int tid = tid_l, wid = __builtin_amdgcn_readfirstlane(tid >> 6), lane = tid & 63, wr = wid >> 2, wc = wid & 3, fr = lane & 15, fq = lane >> 4;
    const int K = g.ld;
    int ts_lo = 0, ts_hi = 0, nts = 0; const unsigned long long rt_entry = STAMP ? (unsigned long long)wall_clock64() : 0ull;
#define PG8_STAMP() do { if (STAMP && wid == 0 && nts < 64) { const unsigned long long _c = (unsigned long long)clock64(); \
        ts_lo = (lane == nts) ? (int)(unsigned)_c : ts_lo; ts_hi = (lane == nts) ? (int)(unsigned)(_c >> 32) : ts_hi; ++nts; } } while (0)
    PG8_STAMP();
    unsigned voffA[2], voffB[2];
#pragma unroll
    for (int i = 0; i < 2; ++i) { int R, C; stage_rc(tid * 16 + i * 8192, R, C); const int Rb = Epi::PERM ? ((R & ~31) + perm32(R & 31)) : R;
        voffA[i] = (unsigned)(R * K + C) * 2u; voffB[i] = (unsigned)(Rb * K + C) * 2u; }
    unsigned vAc[2][2] = {{0u, 0u}, {0u, 0u}}, vAn[2][2] = {{0u, 0u}, {0u, 0u}};
#define PG8_GVOFF(dst, ui_) do { _Pragma("unroll") for (int h_ = 0; h_ < 2; ++h_) _Pragma("unroll") for (int i_ = 0; i_ < 2; ++i_) { int R_, C_; stage_rc(tid * 16 + i_ * 8192, R_, C_); \
        dst[h_][i_] = (unsigned)(rowmap[(ui_) * 256 + h_ * 128 + R_] * K + C_) * 2u; } } while (0)
    const size_t kstep = (size_t)(BK * 2);
    const size_t hstep = (size_t)HALF * K * 2;
    const size_t tstep = 2 * hstep;
    const unsigned ldsw = (unsigned)wid * 1024u;
    const int aoff = lds_byte(wr * 64 + fr, fq * 8), boff = lds_byte(wc * 32 + fr, fq * 8);
#define PG8_SA(b, h) (((b) * 2 + (h)) * HTB)
#define PG8_SB(b, h) ((4 + (b) * 2 + (h)) * HTB)
#define PG8_STAGE(bufoff, gbase, voff) do { _Pragma("unroll") for (int _i = 0; _i < 2; ++_i) \
        __builtin_amdgcn_global_load_lds((const unsigned*)((const char*)(gbase) + (voff)[_i]), (PG8_LAS unsigned*)(lds + (bufoff) + ldsw + _i * 8192), 16, 0, 0); } while (0)
#define PG8_STAGE_A(bufoff, gbase, h, V) do { if constexpr (GATHER) { PG8_STAGE(bufoff, gbase, V[h]); } else { PG8_STAGE(bufoff, (gbase) + ((h) ? hstep : 0), voffA); } } while (0)
#define PG8_LDA(dst, b, h) do { _Pragma("unroll") for (int m = 0; m < 4; ++m) _Pragma("unroll") for (int k = 0; k < 2; ++k) dst[m][k] = *(const PG8_LAS bf16x8*)(lds + PG8_SA(b, h) + aoff + m * 2048 + k * 1024); } while (0)
#define PG8_LDB(dst, b, h) do { _Pragma("unroll") for (int n = 0; n < 2; ++n) _Pragma("unroll") for (int k = 0; k < 2; ++k) dst[n][k] = *(const PG8_LAS bf16x8*)(lds + PG8_SB(b, h) + boff + n * 2048 + k * 1024); } while (0)
#define PG8_MMA(ai, bj, At, Bt) do { __builtin_amdgcn_s_setprio(1); _Pragma("unroll") for (int m = 0; m < 4; ++m) _Pragma("unroll") for (int n = 0; n < 2; ++n) _Pragma("unroll") for (int k = 0; k < 2; ++k) \
        acc[ai][bj][m][n] = __builtin_amdgcn_mfma_f32_16x16x32_bf16(Bt[n][k], At[m][k], acc[ai][bj][m][n], 0, 0, 0); __builtin_amdgcn_s_setprio(0); } while (0)
#define PG8_WAIT_V(n) asm volatile("s_waitcnt vmcnt(" #n ")" ::: "memory")
#define PG8_WAIT_L(n) asm volatile("s_waitcnt lgkmcnt(" #n ")" ::: "memory")
#define PG8_BAR __builtin_amdgcn_s_barrier()
#define PG8_SCHED __builtin_amdgcn_sched_barrier(0)
    Unit cur, nxt; int ui = 0;
    if (!S.next(0, cur)) return;
    f32x4 acc[2][2][4][2];
#pragma unroll
    for (int a = 0; a < 2; ++a)
#pragma unroll
        for (int b = 0; b < 2; ++b)
#pragma unroll
            for (int m = 0; m < 4; ++m)
#pragma unroll
                for (int n = 0; n < 2; ++n) acc[a][b][m][n] = (f32x4){0.f, 0.f, 0.f, 0.f};
    bf16x8 At[4][2], B0[2][2], B1[2][2];
    const char* cA = (const char*)g.A + (GATHER ? (size_t)0 : (size_t)cur.pm * tstep) + cur.koff; const char* cB = (const char*)g.Bt + (size_t)cur.pn * tstep + cur.koff;
    if constexpr (GATHER) PG8_GVOFF(vAc, 0);
    if constexpr (Epi::HAS_SWAP) { if (E.swap_ab(cur)) { const char* t_ = cA; cA = cB; cB = t_; } }
    S.a_ready(cur);
    PG8_STAGE(PG8_SB(0, 0), cB, voffB); PG8_STAGE_A(PG8_SA(0, 0), cA, 0, vAc); PG8_STAGE(PG8_SB(0, 1), cB + hstep, voffB); PG8_STAGE_A(PG8_SA(0, 1), cA, 1, vAc);
    if (wr == 1) PG8_BAR;
    PG8_WAIT_V(4); PG8_BAR;
    PG8_STAGE(PG8_SB(1, 0), cB + kstep, voffB); PG8_STAGE_A(PG8_SA(1, 0), cA + kstep, 0, vAc); PG8_STAGE(PG8_SB(1, 1), cB + hstep + kstep, voffB);
    PG8_WAIT_V(6); PG8_BAR;
    PG8_STAMP();
    for (;;) {
        const bool has_next = S.next(ui + 1, nxt);
        const char* nA_ = has_next ? (const char*)g.A + (GATHER ? (size_t)0 : (size_t)nxt.pm * tstep) + nxt.koff : cA; const char* nB_ = has_next ? (const char*)g.Bt + (size_t)nxt.pn * tstep + nxt.koff : cB;
        const char* nA = nA_; const char* nB = nB_;
        if constexpr (Epi::HAS_SWAP) { if (has_next && E.swap_ab(nxt)) { nA = nB_; nB = nA_; } }
        if constexpr (GATHER) { if (has_next) PG8_GVOFF(vAn, ui + 1); else { _Pragma("unroll") for (int h_ = 0; h_ < 2; ++h_) _Pragma("unroll") for (int i_ = 0; i_ < 2; ++i_) vAn[h_][i_] = vAc[h_][i_]; } }
        const int nt = cur.nt;
        for (int t = 0; t < nt; t += 2) {
            const bool last = (t == nt - 2);
            const char* a1 = cA + (size_t)(t + 1) * kstep;
            const char* a2 = last ? nA : cA + (size_t)(t + 2) * kstep; const char* b2 = last ? nB : cB + (size_t)(t + 2) * kstep;
            const char* a3 = a2 + kstep; const char* b3 = b2 + kstep;
            if (last && has_next) S.a_ready(nxt);
            unsigned vA2[2][2];
            if constexpr (GATHER) { _Pragma("unroll") for (int h_ = 0; h_ < 2; ++h_) _Pragma("unroll") for (int i_ = 0; i_ < 2; ++i_) vA2[h_][i_] = last ? vAn[h_][i_] : vAc[h_][i_]; }
            PG8_LDB(B0, 0, 0); PG8_SCHED; PG8_LDA(At, 0, 0); PG8_STAGE_A(PG8_SA(1, 1), a1, 1, vAc);
            PG8_WAIT_L(8); PG8_BAR; PG8_WAIT_L(0); PG8_MMA(0, 0, At, B0); PG8_BAR; PG8_SCHED;
            PG8_LDB(B1, 0, 1); PG8_STAGE(PG8_SB(0, 0), b2, voffB);
            PG8_BAR; PG8_WAIT_L(0); PG8_MMA(0, 1, At, B1); PG8_BAR;
            PG8_LDA(At, 0, 1); PG8_STAGE_A(PG8_SA(0, 0), a2, 0, vA2);
            PG8_BAR; PG8_WAIT_L(0); PG8_MMA(1, 0, At, B0); PG8_BAR; PG8_SCHED;
            PG8_STAGE(PG8_SB(0, 1), b2 + hstep, voffB);
            PG8_WAIT_V(6); PG8_BAR; PG8_MMA(1, 1, At, B1); PG8_BAR;
            PG8_LDB(B0, 1, 0); PG8_SCHED; PG8_LDA(At, 1, 0); PG8_STAGE_A(PG8_SA(0, 1), a2, 1, vA2);
            PG8_WAIT_L(8); PG8_BAR; PG8_WAIT_L(0); PG8_MMA(0, 0, At, B0); PG8_BAR; PG8_SCHED;
            PG8_LDB(B1, 1, 1); PG8_STAGE(PG8_SB(1, 0), b3, voffB);
            PG8_BAR; PG8_WAIT_L(0); PG8_MMA(0, 1, At, B1); PG8_BAR;
            PG8_LDA(At, 1, 1); PG8_STAGE_A(PG8_SA(1, 0), a3, 0, vA2);
            PG8_BAR; PG8_WAIT_L(0); PG8_MMA(1, 0, At, B0); PG8_BAR; PG8_SCHED;
            PG8_STAGE(PG8_SB(1, 1), b3 + hstep, voffB);
            PG8_WAIT_V(6); PG8_BAR; PG8_MMA(1, 1, At, B1); PG8_BAR;
        }
        PG8_STAMP();
        if constexpr (!Epi::AFTER_DRAIN) { E(acc, cur, wr, wc, fr, fq); S.done(cur); }
        PG8_STAMP();
        if (!has_next) break;
#pragma unroll
        for (int a = 0; a < 2; ++a)
#pragma unroll
            for (int b = 0; b < 2; ++b)
#pragma unroll
                for (int m = 0; m < 4; ++m)
#pragma unroll
                    for (int n = 0; n < 2; ++n) acc[a][b][m][n] = (f32x4){0.f, 0.f, 0.f, 0.f};
        cur = nxt; cA = nA; cB = nB; ++ui;
        if constexpr (GATHER) { _Pragma("unroll") for (int h_ = 0; h_ < 2; ++h_) _Pragma("unroll") for (int i_ = 0; i_ < 2; ++i_) vAc[h_][i_] = vAn[h_][i_]; }
    }
    PG8_WAIT_V(0);
    if (wr == 0) PG8_BAR;
    PG8_BAR;
    if constexpr (Epi::AFTER_DRAIN) { E.fused(acc, cur, wr, wc, fr, fq, lds, wid, lane); S.done(cur); }
    PG8_STAMP();
    if (STAMP && wid == 0) { stamps[lane] = lane < nts ? (((unsigned long long)(unsigned)ts_hi << 32) | (unsigned)ts_lo) : 0ull;
        if (lane == 62) stamps[62] = rt_entry; if (lane == 63) stamps[63] = (unsigned long long)wall_clock64(); }
#undef PG8_STAMP
#undef PG8_SA
#undef PG8_SB
#undef PG8_STAGE
#undef PG8_STAGE_A
#undef PG8_GVOFF
#undef PG8_LDA
#undef PG8_LDB
#undef PG8_MMA
#undef PG8_WAIT_V
#undef PG8_WAIT_L
#undef PG8_BAR
#undef PG8_SCHED
}
}
typedef unsigned short bf16;
typedef float f32x4 __attribute__((ext_vector_type(4)));
typedef short bf16x8 __attribute__((ext_vector_type(8)));
typedef short s16x4 __attribute__((ext_vector_type(4)));
typedef unsigned u32x4 __attribute__((ext_vector_type(4)));
typedef unsigned u32x2 __attribute__((ext_vector_type(2)));
constexpr int NB = 16, SEQ = 2048, DM = 1024, CTXL = 256, NLAYER = 2;
constexpr int NGRP = 2, BG = NB / NGRP;
constexpr int LATG = BG * SEQ, CTXG = BG * CTXL, RG = LATG + CTXG;
constexpr int NIN = 7168, DFF = 2816, DFE = 3584, NEXP = 8, NMOD = 6 * DM;
constexpr int NHEAD = 16, HD = 64;
constexpr int MOE_TILES_MAX = 136, MOE_ROWS_MAX = MOE_TILES_MAX * 256;
constexpr float EPS = 1e-6f;
constexpr int NWAVES = 8, NTHR = 512;
constexpr size_t MiB = 1u << 20;
constexpr size_t WS_CTL = 0, CTL_ZERO_BYTES = 64 * 1024;
constexpr size_t WS_MOD = 1 * MiB;
constexpr size_t WS_MISC = 2 * MiB;
constexpr size_t WS_XC = 4 * MiB;
constexpr size_t WS_WIN = 20 * MiB;
constexpr size_t WS_WRO = 48 * MiB, WS_WNO = 52 * MiB, WS_WOUT = 56 * MiB;
constexpr size_t WS_WF13 = 60 * MiB;
constexpr size_t WS_WF2 = 71 * MiB;
constexpr size_t WS_WM13 = 77 * MiB;
constexpr size_t WS_WM2 = 189 * MiB;
constexpr size_t WS_ARENA = 245 * MiB;
constexpr size_t SLAB = (size_t)RG * DM * 2;
static_assert(SLAB == 36 * MiB, "slab");
constexpr size_t A_H = WS_ARENA + 0 * SLAB;
constexpr size_t A_XR = WS_ARENA + 1 * SLAB;
constexpr size_t A_KB = WS_ARENA + 2 * SLAB;
constexpr size_t A_VT = WS_ARENA + 3 * SLAB;
constexpr size_t A_YG = WS_ARENA + 4 * SLAB;
constexpr size_t A_QB = WS_ARENA + 5 * SLAB;
constexpr size_t A_SR = WS_ARENA + 6 * SLAB;
constexpr size_t A_SN = WS_ARENA + 7 * SLAB;
constexpr size_t A_YN = WS_ARENA + 8 * SLAB;
constexpr size_t A_T1 = WS_ARENA + 9 * SLAB;
constexpr size_t A_H2 = WS_ARENA, A_ACT = WS_ARENA + 72 * MiB;
constexpr size_t A_AM = WS_ARENA;
constexpr size_t A_ACTM = WS_ARENA + 68 * MiB;
constexpr size_t A_Y = WS_ARENA + 306 * MiB;
constexpr size_t A_YPART = A_AM + 36 * MiB;
static_assert(A_YPART >= WS_ARENA + SLAB && A_YPART + (size_t)7 * 8 * 256 * DM * 2 <= A_ACTM, "partial-output buffer");
constexpr size_t A_H2M = A_Y;
constexpr size_t WS_END = WS_ARENA + 374 * MiB;
static_assert((size_t)MOE_ROWS_MAX * DM * 2 == 68 * MiB && (size_t)MOE_ROWS_MAX * DFE * 2 == 238 * MiB, "moe map");
static_assert(A_T1 + SLAB <= WS_END && A_ACT + (size_t)2 * RG * DFF * 2 <= WS_END, "mixer / ffn map");
constexpr size_t MS_TOFF = 0;
constexpr size_t MS_CNT = 4096;
constexpr size_t MS_ROUTE_E = 16384;
constexpr size_t MS_ROUTE_W = 16384 + 65536;
constexpr size_t MS_TOKSLOT = MS_ROUTE_W + 131072;
constexpr size_t MS_SLOTW = MS_TOKSLOT + 131072;
constexpr size_t MS_ROWMAP = MS_SLOTW + (size_t)MOE_ROWS_MAX * 4;
static_assert(MS_ROWMAP + MOE_ROWS_MAX * 4 <= 2 * MiB, "misc map");
constexpr int CW_BAR = 1024;
static_assert((CW_BAR + XCD_BAR_WORDS) * 4 <= (int)CTL_ZERO_BYTES, "ctl");
constexpr int XS_LD = 2 * DM;
constexpr int MOE_GATHER_UNITS = 15;
static_assert(MOE_TILES_MAX * 28 <= MOE_GATHER_UNITS * 256, "MoE up units per workgroup");
constexpr int RING_BYTES = 131072, LDS_BYTES = 147456, MISC_OFF = LDS_BYTES - 64;
static_assert(RING_BYTES + MOE_GATHER_UNITS * 1024 <= MISC_OFF, "gather map in LDS");

__device__ __forceinline__ unsigned pk2(float lo, float hi) { unsigned r; asm("v_cvt_pk_bf16_f32 %0, %1, %2" : "=v"(r) : "v"(lo), "v"(hi)); return r; }
__device__ __forceinline__ unsigned f2bf(float f) { return pk2(f, f) & 0xffffu; }
__device__ __forceinline__ float bf2f(unsigned short b) { return __builtin_bit_cast(float, ((unsigned)b) << 16); }
__device__ __forceinline__ float bflo(unsigned w) { return __builtin_bit_cast(float, w << 16); }
__device__ __forceinline__ float bfhi(unsigned w) { return __builtin_bit_cast(float, w & 0xffff0000u); }
#define SHX(x, m) __builtin_bit_cast(float, __builtin_amdgcn_ds_bpermute(((lane) ^ (m)) << 2, __builtin_bit_cast(int, (float)(x))))
#define SHUP(x, d) __builtin_bit_cast(float, __builtin_amdgcn_ds_bpermute(((lane) >= (d) ? (lane) - (d) : (lane)) << 2, __builtin_bit_cast(int, (float)(x))))
__device__ __forceinline__ int lane_id_fresh() { int l; asm volatile("v_mbcnt_lo_u32_b32 %0, -1, 0\n\tv_mbcnt_hi_u32_b32 %0, -1, %0" : "=v"(l)); return l; }
__device__ __forceinline__ float wave_sum(float v, int lane) {
#pragma unroll
    for (int o = 1; o < 64; o <<= 1) v += SHX(v, o);
    return v;
}
__device__ __forceinline__ float sigmoidf_(float x) { return __builtin_amdgcn_rcpf(1.0f + __builtin_amdgcn_exp2f(-1.44269504f * x)); }
__device__ __forceinline__ float siluf_(float x) { return x * sigmoidf_(x); }
__device__ __forceinline__ float gelu_tanh_(float x) { const float u = 0.7978845608f * (x + 0.044715f * x * x * x); return x * sigmoidf_(2.0f * u); }
#define LDS_WAIT() asm volatile("s_waitcnt lgkmcnt(0)" ::: "memory")

struct Args { const float* in[25]; float* out; unsigned char* ws; int ph_lo, ph_hi; };
enum { I_X = 0, I_C, I_CTX, I_CCTX, I_WMOD, I_BMOD, I_WIN, I_CONVW, I_CONVB, I_LAM, I_RGW, I_RGB, I_QG, I_KG, I_RPB, I_WRO, I_WNO, I_WOUT, I_F1, I_F3, I_F2, I_ROUTER, I_M1, I_M3, I_M2 };

__device__ __forceinline__ int map_row(int mode, int n) {
    if (mode == 1) { const int t = n >> 8, cl = n & 255, wc = cl >> 6, bj = (cl >> 5) & 1, j = cl & 31; return (t << 8) + 128 * bj + 32 * wc + j; }
    if (mode == 2) return ((n >> 7) << 8) + (n & 127);
    if (mode == 3) return ((n >> 7) << 8) + 128 + (n & 127);
    return n;
}
struct TItem { const float* src; bf16* dst; int K, N, mode, k0, n0; };
__device__ __forceinline__ TItem titem(const float* W, int K, int N, bf16* WT, int mode, int tile, int k, int w) { const int n8 = N / 256, kb = 4 * (tile / n8) + k, nb = 8 * (tile % n8) + w; return TItem{W, WT, K, N, mode, 64 * kb, 32 * nb}; }
__device__ __forceinline__ void titem_load(const TItem& d, f32x4 (&t)[8], int lane) {
#pragma unroll
    for (int i = 0; i < 8; ++i) t[i] = *(const f32x4*)(d.src + (size_t)(d.k0 + 8 * i + (lane >> 3)) * d.N + d.n0 + 4 * (lane & 7));
}
__device__ __forceinline__ void titem_finish(const TItem& d, const f32x4 (&t)[8], float* scr, int lane) {
#pragma unroll
    for (int i = 0; i < 8; ++i) { float* p = scr + (8 * i + (lane >> 3)) * 33 + 4 * (lane & 7); p[0] = t[i].x; p[1] = t[i].y; p[2] = t[i].z; p[3] = t[i].w; }
    LDS_WAIT(); asm volatile("" ::: "memory");
    const int c = lane & 7; const float sc = d.mode == 2 ? -1.44269504f : 1.0f;
#pragma unroll
    for (int j = 0; j < 4; ++j) { const int n = (lane >> 3) + 8 * j; const float* s = scr + (8 * c) * 33 + n;
        u32x4 o; o.x = pk2(s[0 * 33] * sc, s[1 * 33] * sc); o.y = pk2(s[2 * 33] * sc, s[3 * 33] * sc); o.z = pk2(s[4 * 33] * sc, s[5 * 33] * sc); o.w = pk2(s[6 * 33] * sc, s[7 * 33] * sc);
        *(u32x4*)(d.dst + (size_t)map_row(d.mode, d.n0 + n) * d.K + d.k0 + 8 * c) = o; }
    LDS_WAIT(); asm volatile("" ::: "memory");
}
constexpr int TL_IN = (DM / 256) * (NIN / 256), TL_SQ = (DM / 256) * (DM / 256), TL_F1 = (DM / 256) * (DFF / 256), TL_F2 = (DFF / 256) * (DM / 256), TL_M1 = (DM / 256) * (DFE / 256), TL_M2 = (DFE / 256) * (DM / 256);
constexpr int NT_IN = 2 * TL_IN, NT_SQ = 6 * TL_SQ, NT_F = 2 * TL_F1 + TL_F2, NT_M13 = 16 * TL_M1, NT_MOE = NT_M13 + 8 * TL_M2, NT_EAGER = NT_IN + NT_SQ + NT_F, NTILES = NT_EAGER + NT_MOE;
static_assert(NIN % 256 == 0 && DFF % 256 == 0 && DFE % 256 == 0 && DM % 256 == 0, "conversion tiles");
__device__ __forceinline__ TItem conv_item(const Args& a, int r, int k, int w) {
    unsigned char* ws = a.ws;
    if (r < NT_IN) { const int l = r / TL_IN; return titem(a.in[I_WIN] + (size_t)l * DM * NIN, DM, NIN, (bf16*)(ws + WS_WIN) + (size_t)l * NIN * DM, 1, r % TL_IN, k, w); } r -= NT_IN;
    if (r < NT_SQ) { const int m = r / TL_SQ, which = m >> 1, l = m & 1; const float* s0 = a.in[I_WRO]; const float* s1 = a.in[I_WNO]; const float* s2 = a.in[I_WOUT];
        const float* src = (which == 0 ? s0 : (which == 1 ? s1 : s2)) + (size_t)l * DM * DM;
        bf16* dst = (bf16*)(ws + (which == 0 ? WS_WRO : (which == 1 ? WS_WNO : WS_WOUT))) + (size_t)l * DM * DM; return titem(src, DM, DM, dst, 0, r % TL_SQ, k, w); } r -= NT_SQ;
    if (r < NT_F) { if (r < TL_F1) return titem(a.in[I_F1], DM, DFF, (bf16*)(ws + WS_WF13), 2, r, k, w);
        if (r < 2 * TL_F1) return titem(a.in[I_F3], DM, DFF, (bf16*)(ws + WS_WF13), 3, r - TL_F1, k, w);
        return titem(a.in[I_F2], DFF, DM, (bf16*)(ws + WS_WF2), 0, r - 2 * TL_F1, k, w); } r -= NT_F;
    if (r < NT_M13) { const int m = r / TL_M1, e = m >> 1, up = m & 1; const float* s1 = a.in[I_M1]; const float* s3 = a.in[I_M3];
        return titem((up ? s3 : s1) + (size_t)e * DM * DFE, DM, DFE, (bf16*)(ws + WS_WM13) + (size_t)e * 2 * DFE * DM, up ? 3 : 2, r % TL_M1, k, w); } r -= NT_M13;
    { const int e = r / TL_M2; return titem(a.in[I_M2] + (size_t)e * DFE * DM, DFE, DM, (bf16*)(ws + WS_WM2) + (size_t)e * DM * DFE, 0, r % TL_M2, k, w); }
}
__device__ __forceinline__ void conv_tile(const Args& a, float* scr, int tile, int wave, int lane) {
    f32x4 t[4][8]; TItem d[4];
#pragma unroll
    for (int k = 0; k < 4; ++k) { d[k] = conv_item(a, tile, k, wave); titem_load(d[k], t[k], lane); }
#pragma unroll
    for (int k = 0; k < 4; ++k) titem_finish(d[k], t[k], scr, lane);
}
static_assert(NT_MOE == 6 * 224, "lazy MoE conversion slices");
__device__ __forceinline__ void moe_convert_slice(const Args& a, unsigned char* lds, int s, int blk, int wave, int lane) {
    if (blk < 32) return;
    conv_tile(a, (float*)(lds + wave * 16384), NT_EAGER + s * 224 + (blk - 32), wave, lane);
}
__device__ __forceinline__ void phase_prologue(const Args& a, unsigned char* lds, int blk, int G, int wave, int lane, int tid, bool lazy_moe) {
    unsigned char* ws = a.ws;
    float* scr = (float*)(lds + wave * 16384);
    const int ntiles = lazy_moe ? NT_EAGER : NTILES;
    for (int t = blk; t < ntiles; t += G) conv_tile(a, scr, t, wave, lane);
    __syncthreads();
    float* sc = (float*)lds;
    float* red = (float*)(lds + 17 * 1024 * 4);
    bool have = false;
    for (int u = blk; u < 2 * (NMOD / 64); u += G) {
        if (!have) { for (int i = tid; i < 17 * 1024; i += NTHR) { const float v = (i < 16 * 1024) ? a.in[I_C][i] : a.in[I_CCTX][i - 16 * 1024]; sc[i] = siluf_(v); } have = true; }
        __syncthreads();
        const int l = u / (NMOD / 64), n0 = (u % (NMOD / 64)) * 64;
        const float* wm = a.in[I_WMOD] + (size_t)l * DM * NMOD + n0 + lane;
        float acc[17];
#pragma unroll
        for (int r = 0; r < 17; ++r) acc[r] = 0.f;
        for (int k0 = wave * 128; k0 < wave * 128 + 128; k0 += 16) { float w[16];
#pragma unroll
            for (int i = 0; i < 16; ++i) w[i] = wm[(size_t)(k0 + i) * NMOD];
#pragma unroll
            for (int i = 0; i < 16; ++i)
#pragma unroll
                for (int r = 0; r < 17; ++r) acc[r] += sc[r * 1024 + k0 + i] * w[i]; }
#pragma unroll
        for (int r = 0; r < 17; ++r) red[(wave * 17 + r) * 64 + lane] = acc[r];
        __syncthreads();
        for (int i = tid; i < 17 * 64; i += NTHR) { const int r = i >> 6, c = i & 63; float s = 0.f;
#pragma unroll
            for (int w = 0; w < 8; ++w) s += red[(w * 17 + r) * 64 + c];
            ((float*)(ws + WS_MOD))[((size_t)l * 17 + r) * NMOD + n0 + c] = s + a.in[I_BMOD][l * NMOD + n0 + c]; }
    }
    __syncthreads();
}

#define DPP_ADD_(v, ctrl, rmask) v += __builtin_bit_cast(float, __builtin_amdgcn_update_dpp(0, __builtin_bit_cast(int, v), ctrl, rmask, 0xf, false))
__device__ __forceinline__ float wave_sum_dpp(float v) {
    DPP_ADD_(v, 0x111, 0xf); DPP_ADD_(v, 0x112, 0xf); DPP_ADD_(v, 0x114, 0xf); DPP_ADD_(v, 0x118, 0xf);
    DPP_ADD_(v, 0x142, 0xa); DPP_ADD_(v, 0x143, 0xc);
    return __builtin_bit_cast(float, __builtin_amdgcn_readlane(__builtin_bit_cast(int, v), 63));
}
template <bool ROUTE, bool XBF, bool CP = false>
__device__ __forceinline__ void modulate_rows(const void* __restrict__ xl_, const void* __restrict__ xc_, int nlat, int mbase, const float* __restrict__ modl, int shoff, bf16* __restrict__ out,
                                              int r0, int n, int lane, const float* __restrict__ router, int* __restrict__ re, float* __restrict__ rw, int* cntl, const bf16* __restrict__ cpart = nullptr) {
    if (n <= 0) return;
    f32x4 rt[ROUTE ? 32 : 1];
    if (ROUTE) {
#pragma unroll
        for (int j = 0; j < 4; ++j)
#pragma unroll
            for (int i = 0; i < 4; ++i) { const int col = 4 * lane + 256 * j + i; rt[2 * (4 * j + i)] = *(const f32x4*)(router + col * 8); rt[2 * (4 * j + i) + 1] = *(const f32x4*)(router + col * 8 + 4); } }
    typedef typename std::conditional<XBF, u32x2, f32x4>::type rowv;
    constexpr size_t XLD = XBF ? (size_t)XS_LD * 2 : (size_t)DM * 4;
    const unsigned char* xl = (const unsigned char*)xl_; const unsigned char* xc = (const unsigned char*)xc_;
    rowv vn[4]; f32x4 s4[4], h4[4];
    { const rowv* p = (const rowv*)(r0 >= nlat ? xc + (size_t)(r0 - nlat) * XLD : xl + (size_t)r0 * XLD);
#pragma unroll
      for (int j = 0; j < 4; ++j) vn[j] = p[lane + 64 * j]; }
    u32x2 pv[CP ? 4 : 1][4];
    if constexpr (CP) { if (r0 >= nlat) {
#pragma unroll
        for (int p = 0; p < 4; ++p) { const u32x2* q = (const u32x2*)(cpart + (size_t)(4 * (r0 - nlat) + p) * XS_LD + DM);
#pragma unroll
            for (int j = 0; j < 4; ++j) pv[p][j] = q[lane + 64 * j]; } } }
    int mprev = -1;
    for (int i = 0; i < n; ++i) {
        const int r = r0 + i;
        f32x4 v[4];
#pragma unroll
        for (int j = 0; j < 4; ++j) { if constexpr (XBF) v[j] = (f32x4){bflo(vn[j].x), bfhi(vn[j].x), bflo(vn[j].y), bfhi(vn[j].y)}; else v[j] = vn[j]; }
        if constexpr (CP) { if (r >= nlat) {
#pragma unroll
            for (int p = 0; p < 4; ++p)
#pragma unroll
                for (int j = 0; j < 4; ++j) { v[j].x += bflo(pv[p][j].x); v[j].y += bfhi(pv[p][j].x); v[j].z += bflo(pv[p][j].y); v[j].w += bfhi(pv[p][j].y); } } }
        if (i + 1 < n) { const int rn = r + 1; const rowv* p = (const rowv*)(rn >= nlat ? xc + (size_t)(rn - nlat) * XLD : xl + (size_t)rn * XLD);
#pragma unroll
            for (int j = 0; j < 4; ++j) vn[j] = p[lane + 64 * j];
            if constexpr (CP) { if (rn >= nlat) {
#pragma unroll
                for (int p = 0; p < 4; ++p) { const u32x2* q = (const u32x2*)(cpart + (size_t)(4 * (rn - nlat) + p) * XS_LD + DM);
#pragma unroll
                    for (int j = 0; j < 4; ++j) pv[p][j] = q[lane + 64 * j]; } } } }
        const int mrow = r >= nlat ? 16 : mbase + r / SEQ;
        if (mrow != mprev) { mprev = mrow; const f32x4* hp = (const f32x4*)(modl + (size_t)mrow * NMOD + (size_t)shoff * DM); const f32x4* sp = hp + DM / 4;
#pragma unroll
            for (int j = 0; j < 4; ++j) { s4[j] = sp[lane + 64 * j] + 1.0f; h4[j] = hp[lane + 64 * j]; } }
        float ss = 0.f;
#pragma unroll
        for (int j = 0; j < 4; ++j) ss += (v[j].x * v[j].x + v[j].y * v[j].y) + (v[j].z * v[j].z + v[j].w * v[j].w);
        ss = wave_sum_dpp(ss);
        const float rinv = __builtin_amdgcn_rsqf(ss * (1.0f / DM) + EPS);
#pragma unroll
        for (int j = 0; j < 4; ++j) v[j] = v[j] * rinv * s4[j] + h4[j];
        unsigned long long* o8 = (unsigned long long*)(out + (size_t)r * DM) + lane;
#pragma unroll
        for (int j = 0; j < 4; ++j) o8[64 * j] = (unsigned long long)pk2(v[j].x, v[j].y) | ((unsigned long long)pk2(v[j].z, v[j].w) << 32);
        if (ROUTE) {
            float lg[8];
#pragma unroll
            for (int e = 0; e < 8; ++e) lg[e] = 0.f;
#pragma unroll
            for (int j = 0; j < 4; ++j)
#pragma unroll
                for (int k = 0; k < 4; ++k) { const f32x4 q0 = rt[2 * (4 * j + k)], q1 = rt[2 * (4 * j + k) + 1]; const float x = v[j][k];
                    lg[0] += x * q0.x; lg[1] += x * q0.y; lg[2] += x * q0.z; lg[3] += x * q0.w; lg[4] += x * q1.x; lg[5] += x * q1.y; lg[6] += x * q1.z; lg[7] += x * q1.w; }
#pragma unroll
            for (int e = 0; e < 8; ++e) lg[e] = wave_sum_dpp(lg[e]);
            int e0 = 0; float v0 = lg[0];
#pragma unroll
            for (int e = 1; e < 8; ++e) if (lg[e] > v0) { v0 = lg[e]; e0 = e; }
            int e1 = -1; float v1 = -3.0e38f;
#pragma unroll
            for (int e = 0; e < 8; ++e) if (e != e0 && lg[e] > v1) { v1 = lg[e]; e1 = e; }
            const float w0 = 1.0f / (1.0f + __expf(v1 - v0));
            if (lane == 0) { re[r] = e0 | (e1 << 8); rw[2 * r] = w0; rw[2 * r + 1] = 1.0f - w0; atomicAdd(&cntl[e0], 1); atomicAdd(&cntl[e1], 1); }
        }
    }
}
#ifndef RECT_GH
#define RECT_GH 4
#endif
__device__ __forceinline__ void rect_unit(int L, int nM, int nN, int& pm, int& pn) {
    const int per = RECT_GH * nN, gid = L / per, fm = gid * RECT_GH, gs = (nM - fm) < RECT_GH ? (nM - fm) : RECT_GH, rem = L - gid * per;
    pm = fm + rem % gs; pn = rem / gs;
}
__device__ __forceinline__ int xcd_remap(int L, int nU) { const int q = nU >> 3, r = nU & 7, xcd = L & 7, off = L >> 3; return (xcd < r ? xcd * (q + 1) : r * (q + 1) + (xcd - r) * q) + off; }
struct RectOrder {
    int nM0, nN0, nM1, nN1, G, c, ntk;
    __device__ __forceinline__ bool next(int i, pg8::Unit& u) const {
        const int n0 = nM0 * nN0, nU = n0 + nM1 * nN1; int L = i * G + c;
        if (L >= nU) return false;
        L = xcd_remap(L, nU); u.koff = 0; u.nt = ntk;
        if (L < n0) { rect_unit(L, nM0, nN0, u.pm, u.pn); return true; }
        rect_unit(L - n0, nM1, nN1, u.pm, u.pn); u.pm += nM0; return true;
    }
    __device__ __forceinline__ void a_ready(const pg8::Unit&) const {}
    __device__ __forceinline__ void done(const pg8::Unit&) const {}
};
struct MoeOrder {
    int nT, nN, G, c, t1, t2, t3, t4, t5, t6, t7, ntk;
    __device__ __forceinline__ bool next(int i, pg8::Unit& u) const {
        const int nU = nT * nN; int L = i * G + c; if (L >= nU) return false;
        L = xcd_remap(L, nU); u.koff = 0; u.nt = ntk;
        int pm, pn; rect_unit(L, nT, nN, pm, pn);
        const int e = (pm >= t1) + (pm >= t2) + (pm >= t3) + (pm >= t4) + (pm >= t5) + (pm >= t6) + (pm >= t7);
        u.pm = pm; u.pn = e * nN + pn; return true;
    }
    __device__ __forceinline__ void a_ready(const pg8::Unit&) const {}
    __device__ __forceinline__ void done(const pg8::Unit&) const {}
};

constexpr int MOE_MAIN_TILES = 128, MOE_KS = 7, MOE_KS_TILES = 8;
struct MoeDownOrder {
    int nT, G, c, t1, t2, t3, t4, t5, t6, t7;
    __device__ __forceinline__ int expert(int pm) const { return (pm >= t1) + (pm >= t2) + (pm >= t3) + (pm >= t4) + (pm >= t5) + (pm >= t6) + (pm >= t7); }
    __device__ __forceinline__ bool next(int i, pg8::Unit& u) const {
        const int Tm = nT < MOE_MAIN_TILES ? nT : MOE_MAIN_TILES, nmain = Tm * 4; int L = i * G + c;
        if (L < nmain) { L = xcd_remap(L, nmain); int pm, pn; rect_unit(L, Tm, 4, pm, pn); u.pm = pm; u.pn = expert(pm) * 4 + pn; u.koff = 0; u.nt = DFE / 64; return true; }
        const int j = L - nmain, novf = (nT - Tm) * 4 * MOE_KS; if (j >= novf) return false;
        const int ks = j % MOE_KS, pn = (j / MOE_KS) & 3, pm = MOE_MAIN_TILES + j / (4 * MOE_KS);
        u.pm = pm; u.pn = expert(pm) * 4 + pn; u.koff = ks * MOE_KS_TILES * 64 * 2; u.nt = MOE_KS_TILES; return true;
    }
    __device__ __forceinline__ void a_ready(const pg8::Unit&) const {}
    __device__ __forceinline__ void done(const pg8::Unit&) const {}
};
static_assert(MOE_KS * MOE_KS_TILES * 64 == DFE, "MoE down K split");
constexpr int FD_MAIN_TILES = 128, FD_KS = 4;
struct FfnDownOrder {
    int G, c;
    __device__ __forceinline__ bool next(int i, pg8::Unit& u) const {
        constexpr int nmain = FD_MAIN_TILES * 4; int L = i * G + c;
        if (L < nmain) { L = xcd_remap(L, nmain); rect_unit(L, FD_MAIN_TILES, 4, u.pm, u.pn); u.koff = 0; u.nt = DFF / 64; return true; }
        const int j = L - nmain; if (j >= 16 * 4 * FD_KS) return false;
        const int ks = j & 3; u.pn = (j >> 2) & 3; u.pm = FD_MAIN_TILES + (j >> 4);
        u.koff = (12 * ks - 2 * (ks >> 1) * (ks & 1)) * 64 * 2; u.nt = 12 - 2 * (ks >> 1); return true;
    }
    __device__ __forceinline__ void a_ready(const pg8::Unit&) const {}
    __device__ __forceinline__ void done(const pg8::Unit&) const {}
};
static_assert(DFF / 64 == 44 && NB * CTXL == 16 * 256 && NB * SEQ == FD_MAIN_TILES * 256, "FFN down K split");

typedef pg8::f32x4 accv;
__device__ __forceinline__ u32x4 pack8(const accv& a, const accv& b) { u32x4 w; w.x = pg8::cvt_pk_bf16(a[0], a[1]); w.y = pg8::cvt_pk_bf16(a[2], a[3]); w.z = pg8::cvt_pk_bf16(b[0], b[1]); w.w = pg8::cvt_pk_bf16(b[2], b[3]); return w; }

struct EpiIn {
    static constexpr bool PERM = true, AFTER_DRAIN = false, HAS_SWAP = true;
    unsigned char* ws; const float* qg; const float* kg;
    __device__ __forceinline__ bool swap_ab(const pg8::Unit& u) const { return (u.pn >> 2) == 2; }
    __device__ __forceinline__ void operator()(const accv (&acc)[2][2][4][2], const pg8::Unit& u, int wr, int wc, int fr_in, int fq) const {
        int fr = fr_in; asm volatile("" : "+v"(fr));
        const int part = u.pn >> 2, ht = (u.pn & 3) * 4 + wc;
        const int row0 = u.pm * 256 + wr * 64 + fr, colb = ht * 64 + 8 * fq;
        if (part == 2) {
            const bool isc = u.pm >= 64; const int bl = isc ? u.pm - 64 : (u.pm >> 3), T = isc ? CTXL : SEQ, t0 = (isc ? 0 : (u.pm & 7) * 256) + wc * 32 + 8 * fq;
            bf16* vt = (bf16*)(ws + A_VT) + (isc ? (size_t)LATG * DM : 0) + ((size_t)(bl * 16 + (u.pn & 3) * 4 + 2 * wr) * 64 + fr) * T + t0;
#pragma unroll
            for (int ai = 0; ai < 2; ++ai)
#pragma unroll
                for (int m = 0; m < 4; ++m)
#pragma unroll
                    for (int bj = 0; bj < 2; ++bj) *(u32x4*)(vt + (size_t)((m >> 1) * 64 + 32 * ai + 16 * (m & 1)) * T + 128 * bj) = pack8(acc[ai][bj][m][0], acc[ai][bj][m][1]);
            return;
        }
        bf16* dst = (bf16*)(ws + (part == 0 ? A_XR : part == 1 ? A_KB : part == 3 ? A_YG : part == 4 ? A_QB : part == 5 ? A_SR : A_SN));
        float gn[2][2][4];
        if (part == 1 || part == 4) { const float* gp = (part == 1 ? kg : qg) + 8 * fq; const float sc = (part == 4) ? 0.125f * 1.44269504f : 1.0f;
#pragma unroll
            for (int bj = 0; bj < 2; ++bj)
#pragma unroll
                for (int n = 0; n < 2; ++n)
#pragma unroll
                    for (int j = 0; j < 4; ++j) gn[bj][n][j] = gp[32 * bj + 4 * n + j] * sc; }
#pragma unroll
        for (int ai = 0; ai < 2; ++ai)
#pragma unroll
            for (int m = 0; m < 4; ++m) {
                accv v[2][2];
#pragma unroll
                for (int bj = 0; bj < 2; ++bj)
#pragma unroll
                    for (int n = 0; n < 2; ++n) v[bj][n] = acc[ai][bj][m][n];
                if (part == 1 || part == 4) {
                    float ss = 0.f;
#pragma unroll
                    for (int bj = 0; bj < 2; ++bj)
#pragma unroll
                        for (int n = 0; n < 2; ++n) ss += (v[bj][n][0] * v[bj][n][0] + v[bj][n][1] * v[bj][n][1]) + (v[bj][n][2] * v[bj][n][2] + v[bj][n][3] * v[bj][n][3]);
                    { const int lane = fq * 16 + fr; ss += SHX(ss, 16); ss += SHX(ss, 32); }
                    const float rinv = __builtin_amdgcn_rsqf(ss * (1.0f / 64.0f) + EPS);
#pragma unroll
                    for (int bj = 0; bj < 2; ++bj)
#pragma unroll
                        for (int n = 0; n < 2; ++n)
#pragma unroll
                            for (int j = 0; j < 4; ++j) v[bj][n][j] = v[bj][n][j] * rinv * gn[bj][n][j];
                } else if (part == 3) {
#pragma unroll
                    for (int bj = 0; bj < 2; ++bj)
#pragma unroll
                        for (int n = 0; n < 2; ++n)
#pragma unroll
                            for (int j = 0; j < 4; ++j) v[bj][n][j] = gelu_tanh_(v[bj][n][j]);
                } else if (part >= 5) {
#pragma unroll
                    for (int bj = 0; bj < 2; ++bj)
#pragma unroll
                        for (int n = 0; n < 2; ++n)
#pragma unroll
                            for (int j = 0; j < 4; ++j) v[bj][n][j] = sigmoidf_(v[bj][n][j]);
                }
                bf16* rowp = dst + (size_t)(row0 + ai * 128 + m * 16) * DM + colb;
#pragma unroll
                for (int bj = 0; bj < 2; ++bj) *(u32x4*)(rowp + 32 * bj) = pack8(v[bj][0], v[bj][1]);
            }
    }
};
template <int MODE> struct EpiGate {
    static constexpr bool PERM = true, AFTER_DRAIN = false, HAS_SWAP = false;
    const bf16* gate; const bf16* add; bf16* out;
    __device__ __forceinline__ void operator()(const accv (&acc)[2][2][4][2], const pg8::Unit& u, int wr, int wc, int fr_in, int fq) const {
        int fr = fr_in; asm volatile("" : "+v"(fr));
        const int row0 = u.pm * 256 + wr * 64 + fr, col0 = u.pn * 256 + wc * 32 + 8 * fq;
#pragma unroll
        for (int ai = 0; ai < 2; ++ai) {
            u32x4 gw[4][2], aw[4][2];
#pragma unroll
            for (int m = 0; m < 4; ++m)
#pragma unroll
                for (int bj = 0; bj < 2; ++bj) { const size_t ro = (size_t)(row0 + ai * 128 + m * 16) * DM + col0 + bj * 128;
                    gw[m][bj] = *(const u32x4*)(gate + ro); if (MODE == 1) aw[m][bj] = *(const u32x4*)(add + ro); }
#pragma unroll
            for (int m = 0; m < 4; ++m)
#pragma unroll
                for (int bj = 0; bj < 2; ++bj) { const size_t ro = (size_t)(row0 + ai * 128 + m * 16) * DM + col0 + bj * 128;
                    const u32x4 g = gw[m][bj];
                    accv v0 = acc[ai][bj][m][0], v1 = acc[ai][bj][m][1];
                    v0[0] *= bflo(g.x); v0[1] *= bfhi(g.x); v0[2] *= bflo(g.y); v0[3] *= bfhi(g.y); v1[0] *= bflo(g.z); v1[1] *= bfhi(g.z); v1[2] *= bflo(g.w); v1[3] *= bfhi(g.w);
                    if (MODE == 1) { const u32x4 a4 = aw[m][bj];
                        v0[0] += bflo(a4.x); v0[1] += bfhi(a4.x); v0[2] += bflo(a4.y); v0[3] += bfhi(a4.y); v1[0] += bflo(a4.z); v1[1] += bfhi(a4.z); v1[2] += bflo(a4.w); v1[3] += bfhi(a4.w); }
                    *(u32x4*)(out + ro) = pack8(v0, v1); }
            asm volatile("" ::: "memory");
        }
    }
};
template <bool INF32, bool SPLITCTX = false> struct EpiRes {
    static constexpr bool PERM = true, AFTER_DRAIN = false, HAS_SWAP = false;
    const void* xold_lat; const void* xold_ctx; bf16* xnew_lat; bf16* xnew_ctx;
    const float* modl; int gchunk; int sbase; int nlat;
    __device__ __forceinline__ void operator()(const accv (&acc)[2][2][4][2], const pg8::Unit& u, int wr, int wc, int fr_in, int fq) const {
        int fr = fr_in; asm volatile("" : "+v"(fr));
        const bool isc = u.pm >= nlat; const int mrow = isc ? 16 : (sbase + (u.pm >> 3));
        const int rbase = (isc ? (u.pm - nlat) * 256 : u.pm * 256) + wr * 64 + fr, col0 = u.pn * 256 + wc * 32 + 8 * fq;
        const bool iscp = SPLITCTX ? false : isc;
        const float* xof = (const float*)(iscp ? xold_ctx : xold_lat) + (size_t)rbase * DM + col0; const bf16* xob = (const bf16*)(iscp ? xold_ctx : xold_lat) + (size_t)rbase * XS_LD + col0;
        bf16* xn = (iscp ? xnew_ctx : xnew_lat) + (size_t)rbase * XS_LD + col0;
        const float* gp = modl + (size_t)mrow * NMOD + gchunk * DM + col0;
        accv gv[2][2];
#pragma unroll
        for (int bj = 0; bj < 2; ++bj)
#pragma unroll
            for (int n = 0; n < 2; ++n) gv[bj][n] = *(const accv*)(gp + bj * 128 + n * 4);
        if constexpr (SPLITCTX) {
            if (isc) { const int kt = u.koff >> 7, ks = (kt >= 12) + (kt >= 24) + (kt >= 34);
#pragma unroll
                for (int ai = 0; ai < 2; ++ai)
#pragma unroll
                    for (int m = 0; m < 4; ++m) { const int cr = rbase + ai * 128 + m * 16, gg = cr >> 11, cl = cr & 2047;
                        bf16* pp = xnew_lat + (size_t)(gg * LATG + 4 * cl + ks) * XS_LD + DM + col0;
#pragma unroll
                        for (int bj = 0; bj < 2; ++bj) *(u32x4*)(pp + bj * 128) = pack8(gv[bj][0] * acc[ai][bj][m][0], gv[bj][1] * acc[ai][bj][m][1]); }
                return; }
        }
#pragma unroll
        for (int ai = 0; ai < 2; ++ai) {
            accv xv[4][2][2];
            if constexpr (INF32) {
#pragma unroll
                for (int m = 0; m < 4; ++m)
#pragma unroll
                    for (int bj = 0; bj < 2; ++bj)
#pragma unroll
                        for (int n = 0; n < 2; ++n) xv[m][bj][n] = *(const accv*)(xof + (size_t)(ai * 128 + m * 16) * DM + bj * 128 + n * 4);
            } else {
                u32x4 xw[4][2];
#pragma unroll
                for (int m = 0; m < 4; ++m)
#pragma unroll
                    for (int bj = 0; bj < 2; ++bj) xw[m][bj] = *(const u32x4*)(xob + (size_t)(ai * 128 + m * 16) * XS_LD + bj * 128);
#pragma unroll
                for (int m = 0; m < 4; ++m)
#pragma unroll
                    for (int bj = 0; bj < 2; ++bj) { xv[m][bj][0] = (accv){bflo(xw[m][bj].x), bfhi(xw[m][bj].x), bflo(xw[m][bj].y), bfhi(xw[m][bj].y)}; xv[m][bj][1] = (accv){bflo(xw[m][bj].z), bfhi(xw[m][bj].z), bflo(xw[m][bj].w), bfhi(xw[m][bj].w)}; }
            }
#pragma unroll
            for (int m = 0; m < 4; ++m)
#pragma unroll
                for (int bj = 0; bj < 2; ++bj) *(u32x4*)(xn + (size_t)(ai * 128 + m * 16) * XS_LD + bj * 128) = pack8(xv[m][bj][0] + gv[bj][0] * acc[ai][bj][m][0], xv[m][bj][1] + gv[bj][1] * acc[ai][bj][m][1]);
            asm volatile("" ::: "memory");
        }
    }
};
template <bool MOE> struct EpiSwi {
    static constexpr bool PERM = true, AFTER_DRAIN = false, HAS_SWAP = false;
    bf16* out; int ldc; int nN; const float* roww;
    __device__ __forceinline__ void operator()(const accv (&acc)[2][2][4][2], const pg8::Unit& u, int wr, int wc, int fr_in, int fq) const {
        int fr = fr_in; asm volatile("" : "+v"(fr));
        const int pnl = MOE ? (u.pn % nN) : u.pn;
        const int row0 = u.pm * 256 + wr * 64 + fr, col0 = pnl * 128 + wc * 32 + 8 * fq;
        float rwv[2][4];
#pragma unroll
        for (int ai = 0; ai < 2; ++ai)
#pragma unroll
            for (int m = 0; m < 4; ++m) rwv[ai][m] = MOE ? roww[row0 + ai * 128 + m * 16] : 1.0f;
#pragma unroll
        for (int ai = 0; ai < 2; ++ai)
#pragma unroll
            for (int m = 0; m < 4; ++m) { const int row = row0 + ai * 128 + m * 16; const float rw = rwv[ai][m] * -0.69314718f;
                const pg8::f32x2 rw2 = {rw, rw}; accv v[2];
#pragma unroll
                for (int n = 0; n < 2; ++n)
#pragma unroll
                    for (int jp = 0; jp < 2; ++jp) { const pg8::f32x2 gq = {acc[ai][0][m][n][2 * jp], acc[ai][0][m][n][2 * jp + 1]}, uq = {acc[ai][1][m][n][2 * jp], acc[ai][1][m][n][2 * jp + 1]};
                        pg8::f32x2 dq = (pg8::f32x2){__builtin_amdgcn_exp2f(gq.x), __builtin_amdgcn_exp2f(gq.y)} + 1.0f;
                        const pg8::f32x2 rq = {__builtin_amdgcn_rcpf(dq.x), __builtin_amdgcn_rcpf(dq.y)}, oq = (gq * uq) * (rq * rw2);
                        v[n][2 * jp] = oq.x; v[n][2 * jp + 1] = oq.y; }
                *(u32x4*)(out + (size_t)row * ldc + col0) = pack8(v[0], v[1]); }
    }
};
struct EpiY {
    static constexpr bool PERM = true, AFTER_DRAIN = false, HAS_SWAP = false;
    bf16* out; int nN; bf16* part;
    __device__ __forceinline__ void operator()(const accv (&acc)[2][2][4][2], const pg8::Unit& u, int wr, int wc, int fr_in, int fq) const {
        int fr = fr_in; asm volatile("" : "+v"(fr));
        const int pnl = u.pn % nN, col0 = pnl * 256 + wc * 32 + 8 * fq;
        bf16* base = u.pm < MOE_MAIN_TILES ? out + (size_t)(u.pm * 256) * DM : part + ((size_t)((u.koff / (MOE_KS_TILES * 128)) * 8 + (u.pm - MOE_MAIN_TILES)) * 256) * DM;
        const int row0 = wr * 64 + fr;
#pragma unroll
        for (int ai = 0; ai < 2; ++ai)
#pragma unroll
            for (int m = 0; m < 4; ++m)
#pragma unroll
                for (int bj = 0; bj < 2; ++bj) *(u32x4*)(base + (size_t)(row0 + ai * 128 + m * 16) * DM + col0 + bj * 128) = pack8(acc[ai][bj][m][0], acc[ai][bj][m][1]);
    }
};
constexpr int RL_XRAW = 0, RL_XCB = 33792, RL_XCF = 70656, RL_WAGG = 104448, RL_HB = RL_WAGG + 2048, RL_HB_LD = 36, RL_END = RL_HB + 2 * 128 * RL_HB_LD * 4;
static_assert(RL_END <= MISC_OFF, "RG-LRU LDS map");
struct RlStep { int L, rowbase, tlo; bool store, comb; };
__device__ __forceinline__ RlStep rl_step(int st, int dirw, int bl, bool ctx_out) {
    RlStep s; const int seq = st >= 2, ch = seq ? st - 2 : st, nst = seq ? 16 : 2;
    s.L = seq ? SEQ : CTXL; s.rowbase = seq ? bl * SEQ : LATG + bl * CTXL;
    s.tlo = dirw ? s.L - 128 * (ch + 1) : 128 * ch;
    s.store = seq || ctx_out; s.comb = ch >= nst / 2; return s;
}
#define LDS_BARRIER() asm volatile("s_waitcnt lgkmcnt(0)\n\ts_barrier" ::: "memory")
__device__ __forceinline__ void rglru_unit(const Args& a, unsigned char* lds, int l, int unit, bool ctx_out, int wave, int lane_in, int tid_in) {
    int lane = lane_in, tid = tid_in; asm volatile("" : "+v"(lane), "+v"(tid));
    unsigned char* ws = a.ws;
    const int bl = unit >> 5, n = (unit >> 1) & 15, hf = unit & 1;
    const bf16* XR = (const bf16*)(ws + A_XR); bf16* YR = (bf16*)(ws + A_H); const bf16* YG = (const bf16*)(ws + A_YG);
    const int col = lane & 15, quad = lane >> 4, dirw = wave >> 2, wd = wave & 3, td = tid & 255;
    bf16* xraw = (bf16*)(lds + RL_XRAW) + dirw * 132 * 64;
    bf16* xcb = (bf16*)(lds + RL_XCB) + dirw * 128 * 72;
    float* wagg = (float*)(lds + RL_WAGG) + dirw * 256;
    float* hb = (float*)(lds + RL_HB) + dirw * 128 * RL_HB_LD;
    __syncthreads();
    const int cp = td & 31, tg = td >> 5;
    pg8::f32x2 cwv[4], cbv;
    { const float* cbp = a.in[I_CONVB] + (size_t)l * DM + 64 * n + 2 * cp; cbv = (pg8::f32x2){cbp[0], cbp[1]};
#pragma unroll
      for (int j = 0; j < 4; ++j) { const float* cwp = a.in[I_CONVW] + (size_t)l * 4 * DM + j * DM + 64 * n + 2 * cp; cwv[j] = (pg8::f32x2){cwp[0], cwp[1]}; } }
    bf16x8 Bf[2][2][2];
#pragma unroll
    for (int gt = 0; gt < 2; ++gt)
#pragma unroll
        for (int nb = 0; nb < 2; ++nb)
#pragma unroll
            for (int ks = 0; ks < 2; ++ks) { const float* wp = a.in[I_RGW] + ((size_t)((((l * 2 + dirw) * 2 + gt) * 16 + n) * 64 + 32 * ks + 8 * quad)) * 64 + 32 * hf + 16 * nb + col;
                const float sg = -1.44269504f;
                u32x4 w; w.x = pk2(wp[0] * sg, wp[64] * sg); w.y = pk2(wp[128] * sg, wp[192] * sg); w.z = pk2(wp[256] * sg, wp[320] * sg); w.w = pk2(wp[384] * sg, wp[448] * sg); Bf[gt][nb][ks] = __builtin_bit_cast(bf16x8, w); }
    float b0[2], b1[2], c8[2], hin[2];
#pragma unroll
    for (int nb = 0; nb < 2; ++nb) { const int c = 64 * n + 32 * hf + 16 * nb + col;
        b0[nb] = -1.44269504f * a.in[I_RGB][((l * 2 + dirw) * 2 + 0) * DM + c]; b1[nb] = -1.44269504f * a.in[I_RGB][((l * 2 + dirw) * 2 + 1) * DM + c];
        const float lam = a.in[I_LAM][(l * 2 + dirw) * DM + c]; c8[nb] = 8.0f * (fminf(lam, 0.f) - log1pf(__expf(-fabsf(lam)))); hin[nb] = 0.f; }
    u32x4 xr[5];
#define RL_FETCH(S_) do { _Pragma("unroll") for (int i = 0; i < 5; ++i) { const int c = td + 256 * i, row = c >> 3, part = c & 7, t = (S_).tlo - 2 + row; \
        xr[i] = (u32x4){0u, 0u, 0u, 0u}; if (row < 131 && t >= 0 && t < (S_).L) xr[i] = *(const u32x4*)(XR + (unsigned)(((S_).rowbase + t) * DM + 64 * n + 8 * part)); } } while (0)
#define RL_PUT() do { _Pragma("unroll") for (int i = 0; i < 5; ++i) { const int c = td + 256 * i; if (c < 131 * 8) *(u32x4*)(xraw + c * 8) = xr[i]; } } while (0)
#define RL_CONV() do { const int rlo = dirw ? 112 - 16 * tg : 16 * tg; pg8::f32x2 xv[19]; \
        _Pragma("unroll") for (int i = 0; i < 19; ++i) { const unsigned w_ = *(const unsigned*)(xraw + (rlo + i) * 64 + 2 * cp); xv[i] = (pg8::f32x2){bflo(w_), bfhi(w_)}; } \
        unsigned pk_[16]; \
        _Pragma("unroll") for (int i = 0; i < 16; ++i) { pg8::f32x2 v_ = cbv; \
            _Pragma("unroll") for (int j = 0; j < 4; ++j) v_ += cwv[j] * xv[i + j]; \
            pk_[i] = pk2(v_.x, v_.y); } \
          \
        if (dirw) { bf16* pb_ = xcb + (16 * tg + 15) * 72 + 2 * cp; _Pragma("unroll") for (int i = 0; i < 16; ++i) *(unsigned*)(pb_ - i * 72) = pk_[i]; } \
        else { bf16* pf_ = xcb + (16 * tg) * 72 + 2 * cp; _Pragma("unroll") for (int i = 0; i < 16; ++i) *(unsigned*)(pf_ + i * 72) = pk_[i]; } } while (0)
    u32x4 oy[2], og[2];
#define RL_OUT_LOAD(SO_) do { if ((SO_).store && (SO_).comb) { const int sl_ = td >> 1, t_ = (SO_).tlo + (dirw ? 127 - sl_ : sl_); const unsigned go_ = (unsigned)(((SO_).rowbase + t_) * DM + 64 * n + 32 * hf + 16 * (td & 1)); \
        oy[0] = *(const u32x4*)(YR + go_); oy[1] = *(const u32x4*)(YR + go_ + 8); og[0] = *(const u32x4*)(YG + go_); og[1] = *(const u32x4*)(YG + go_ + 8); } } while (0)
#define RL_OUT_FINISH(SO_) do { if ((SO_).store) { const int sl_ = td >> 1, t_ = (SO_).tlo + (dirw ? 127 - sl_ : sl_); const unsigned go_ = (unsigned)(((SO_).rowbase + t_) * DM + 64 * n + 32 * hf + 16 * (td & 1)); \
        const f32x4* hp_ = (const f32x4*)(hb + sl_ * RL_HB_LD + 16 * (td & 1)); f32x4 hv_[4]; _Pragma("unroll") for (int i_ = 0; i_ < 4; ++i_) hv_[i_] = hp_[i_]; \
        if ((SO_).comb) { _Pragma("unroll") for (int k_ = 0; k_ < 2; ++k_) { const unsigned yw_[4] = {oy[k_].x, oy[k_].y, oy[k_].z, oy[k_].w}, gw_[4] = {og[k_].x, og[k_].y, og[k_].z, og[k_].w}; \
            _Pragma("unroll") for (int e_ = 0; e_ < 4; ++e_) { const int v_ = 2 * k_ + (e_ >> 1), c_ = 2 * (e_ & 1); \
                hv_[v_][c_] = (bflo(yw_[e_]) + hv_[v_][c_]) * bflo(gw_[e_]); hv_[v_][c_ + 1] = (bfhi(yw_[e_]) + hv_[v_][c_ + 1]) * bfhi(gw_[e_]); } } } \
        u32x4 o0_, o1_; o0_.x = pk2(hv_[0][0], hv_[0][1]); o0_.y = pk2(hv_[0][2], hv_[0][3]); o0_.z = pk2(hv_[1][0], hv_[1][1]); o0_.w = pk2(hv_[1][2], hv_[1][3]); \
        o1_.x = pk2(hv_[2][0], hv_[2][1]); o1_.y = pk2(hv_[2][2], hv_[2][3]); o1_.z = pk2(hv_[3][0], hv_[3][1]); o1_.w = pk2(hv_[3][2], hv_[3][3]); \
        *(u32x4*)(YR + go_) = o0_; *(u32x4*)(YR + go_ + 8) = o1_; } } while (0)
    { const RlStep s0 = rl_step(0, dirw, bl, ctx_out); RL_FETCH(s0); RL_PUT(); }
    __syncthreads();
    RL_CONV();
    { const RlStep s1 = rl_step(1, dirw, bl, ctx_out); RL_FETCH(s1); }
    __syncthreads();
    for (int st = 0; st < 18; ++st) {
        const RlStep S = rl_step(st, dirw, bl, ctx_out);
        if (st > 0) { const RlStep Sp = rl_step(st - 1, dirw, bl, ctx_out); RL_OUT_FINISH(Sp); }
        if (st + 1 < 18) RL_PUT();
        if (st + 2 < 18) { const RlStep Sn = rl_step(st + 2, dirw, bl, ctx_out); RL_FETCH(Sn); }
        float hl[2][2][4], PP[2][2][4], EA[2][2], EH[2][2];
#pragma unroll
        for (int mb = 0; mb < 2; ++mb) {
            const bf16* ap = xcb + (32 * wd + 16 * mb + col) * 72 + 8 * quad;
            const bf16x8 A0 = *(const bf16x8*)ap, A1 = *(const bf16x8*)(ap + 32);
#pragma unroll
            for (int nb = 0; nb < 2; ++nb) {
                accv g0 = {0.f, 0.f, 0.f, 0.f}, g1 = {0.f, 0.f, 0.f, 0.f};
                g0 = __builtin_amdgcn_mfma_f32_16x16x32_bf16(A0, Bf[0][nb][0], g0, 0, 0, 0); g0 = __builtin_amdgcn_mfma_f32_16x16x32_bf16(A1, Bf[0][nb][1], g0, 0, 0, 0);
                g1 = __builtin_amdgcn_mfma_f32_16x16x32_bf16(A0, Bf[1][nb][0], g1, 0, 0, 0); g1 = __builtin_amdgcn_mfma_f32_16x16x32_bf16(A1, Bf[1][nb][1], g1, 0, 0, 0);
                float pa = 1.f, hh = 0.f;
#pragma unroll
                for (int r = 0; r < 4; ++r) { const int sl = 32 * wd + 16 * mb + 4 * quad + r;
                    const float rg = __builtin_amdgcn_rcpf(1.0f + __builtin_amdgcn_exp2f(g0[r] + b0[nb])), ig = __builtin_amdgcn_rcpf(1.0f + __builtin_amdgcn_exp2f(g1[r] + b1[nb])), la = c8[nb] * rg, av = __builtin_amdgcn_exp2f(1.44269504f * la);
                    const float om = fmaxf(1.0f - av * av, 0.0f);
                    const float uu = __builtin_amdgcn_sqrtf(om) * ig * bf2f(xcb[sl * 72 + 32 * hf + 16 * nb + col]);
                    hh = av * hh + uu; pa *= av; hl[mb][nb][r] = hh; PP[mb][nb][r] = pa; }
                float IA = pa, IH = hh;
                { const float pA = SHUP(IA, 16), pH = SHUP(IH, 16); if (quad >= 1) { IH = IA * pH + IH; IA = IA * pA; } }
                { const float pA = SHUP(IA, 32), pH = SHUP(IH, 32); if (quad >= 2) { IH = IA * pH + IH; IA = IA * pA; } }
                float eA = SHUP(IA, 16), eH = SHUP(IH, 16); if (quad == 0) { eA = 1.f; eH = 0.f; }
                const float gA = __builtin_bit_cast(float, __builtin_amdgcn_ds_bpermute((48 + col) << 2, __builtin_bit_cast(int, IA)));
                const float gH = __builtin_bit_cast(float, __builtin_amdgcn_ds_bpermute((48 + col) << 2, __builtin_bit_cast(int, IH)));
                if (mb == 0) { EA[0][nb] = eA; EH[0][nb] = eH; EA[1][nb] = gA; EH[1][nb] = gH; }
                else { const float a0 = EA[1][nb], h0 = EH[1][nb];
                    EA[1][nb] = eA * a0; EH[1][nb] = eA * h0 + eH;
                    if (quad == 3) { wagg[((wd * 2 + nb) * 16 + col) * 2] = gA * a0; wagg[((wd * 2 + nb) * 16 + col) * 2 + 1] = gA * h0 + gH; } }
            }
            __builtin_amdgcn_sched_barrier(0);
        }
        __syncthreads();
        RL_OUT_LOAD(S);
#pragma unroll
        for (int nb = 0; nb < 2; ++nb) {
            float h = hin[nb], hw = 0.f;
#pragma unroll
            for (int w = 0; w < 4; ++w) { if (w == wd) hw = h; const float wa = wagg[((w * 2 + nb) * 16 + col) * 2], wh = wagg[((w * 2 + nb) * 16 + col) * 2 + 1]; h = wa * h + wh; }
            hin[nb] = h;
            if (S.store) {
#pragma unroll
                for (int mb = 0; mb < 2; ++mb) { const float hs = EA[mb][nb] * hw + EH[mb][nb];
#pragma unroll
                    for (int r = 0; r < 4; ++r) { const int sl = 32 * wd + 16 * mb + 4 * quad + r; hb[sl * RL_HB_LD + 16 * nb + col] = hl[mb][nb][r] + PP[mb][nb][r] * hs; } }
            }
        }
        if (st + 1 < 18) RL_CONV();
        LDS_BARRIER();
    }
    { const RlStep Sl = rl_step(17, dirw, bl, ctx_out); RL_OUT_FINISH(Sl); }
    __syncthreads();
#undef RL_OUT_LOAD
#undef RL_OUT_FINISH
#undef RL_FETCH
#undef RL_PUT
#undef RL_CONV
}

constexpr int AT_KC = 0, AT_KC_LD = 72, AT_VC = 256 * 72 * 2, AT_VC_LD = 264, AT_RP = AT_VC + 64 * 264 * 2, AT_WIN = AT_RP + 2048, AT_END = AT_WIN + 9 * 64 * 128;
static_assert(AT_END <= MISC_OFF, "attention LDS map");
#define SCHED_FENCE() __builtin_amdgcn_sched_barrier(0)
__device__ __forceinline__ void attn_stage(const Args& a, unsigned char* lds, int l, int bl, int h, int tid) {
    unsigned char* ws = a.ws;
    const bf16* KB = (const bf16*)(ws + A_KB); const bf16* VT = (const bf16*)(ws + A_VT);
    bf16* KC = (bf16*)(lds + AT_KC); bf16* VC = (bf16*)(lds + AT_VC); float* RP = (float*)(lds + AT_RP);
    u32x4 tk[4], tv[4];
    const bf16* vsrc = VT + (size_t)LATG * DM + (size_t)(bl * 16 + h) * 64 * CTXL;
#pragma unroll
    for (int i = 0; i < 4; ++i) { const int c = tid + 512 * i; tk[i] = *(const u32x4*)(KB + (size_t)(LATG + bl * CTXL + (c >> 3)) * DM + 64 * h + 8 * (c & 7)); tv[i] = *(const u32x4*)(vsrc + (size_t)(c >> 5) * CTXL + 8 * (c & 31)); }
#pragma unroll
    for (int i = 0; i < 4; ++i) { const int c = tid + 512 * i; *(u32x4*)(KC + (c >> 3) * AT_KC_LD + 8 * (c & 7)) = tk[i]; *(u32x4*)(VC + (c >> 5) * AT_VC_LD + 8 * (c & 31)) = tv[i]; }
    const float* rp = a.in[I_RPB] + (size_t)(l * 16 + h) * 465;
    if (tid < 466) RP[tid] = tid < 465 ? rp[tid] * 1.44269504f : -__builtin_inff();
}
__device__ __forceinline__ int win_fk(int kcol) { return ((kcol >> 1) & 1) | (((kcol >> 3) & 3) << 1); }
__device__ __forceinline__ void win_fetch_k(u32x4 (&wr)[9], const bf16* KB, int bl, int h, int ws0, int tid) {
#pragma unroll
    for (int i = 0; i < 9; ++i) { const int c = tid + 512 * i, kidx = c >> 3, chunk = c & 7, wi = kidx >> 6, kcol = kidx & 63, grow = min(ws0 + wi, 31);
        wr[i] = *(const u32x4*)(KB + (unsigned)((bl * SEQ + 64 * grow + kcol) * DM + 64 * h + 8 * chunk)); }
}
__device__ __forceinline__ void win_put_k(const u32x4 (&wr)[9], unsigned char* win, int tid) {
#pragma unroll
    for (int i = 0; i < 9; ++i) { const int c = tid + 512 * i, kidx = c >> 3, chunk = c & 7, kcol = kidx & 63; *(u32x4*)(win + kidx * 128 + ((chunk ^ win_fk(kcol)) << 4)) = wr[i]; }
}
__device__ __forceinline__ void win_fetch_v(u32x4 (&wr)[9], const bf16* VT, int bl, int h, int ws0, int tid) {
#pragma unroll
    for (int i = 0; i < 9; ++i) { const int c = tid + 512 * i, line = c >> 3, chunk = c & 7, wi = line >> 6, dd = line & 63, grow = min(ws0 + wi, 31);
        wr[i] = *(const u32x4*)(VT + (unsigned)(((bl * 16 + h) * 64 + dd) * SEQ + 64 * grow + 8 * chunk)); }
}
__device__ __forceinline__ void win_put_v(const u32x4 (&wr)[9], unsigned char* win, int tid) {
#pragma unroll
    for (int i = 0; i < 9; ++i) { const int c = tid + 512 * i, line = c >> 3, chunk = c & 7, dd = line & 63; *(u32x4*)(win + line * 128 + ((chunk ^ ((dd >> 1) & 7)) << 4)) = wr[i]; }
}
__device__ __forceinline__ void attn_ctx_seg(const unsigned char* lds, const bf16x8 Bq0, const bf16x8 Bq1, int q, int quad, int kq, int one, accv (&O2)[4], float& m2, float& l2) {
    const bf16* KC = (const bf16*)(lds + AT_KC); const bf16* VC = (const bf16*)(lds + AT_VC);
    const float NEG = -__builtin_inff();
    accv S[16];
    const bf16* kc0 = KC + kq * AT_KC_LD + 8 * quad;
#pragma unroll
    for (int g4 = 0; g4 < 4; ++g4) {
        if (one) { asm volatile("");
            bf16x8 Kc[4][2];
#pragma unroll
            for (int i = 0; i < 4; ++i) { const int kb = 4 * g4 + i; const bf16* kp = kc0 + (32 * (kb >> 1) + 4 * (kb & 1)) * AT_KC_LD; Kc[i][0] = *(const bf16x8*)kp; Kc[i][1] = *(const bf16x8*)(kp + 32); }
            SCHED_FENCE();
#pragma unroll
            for (int i = 0; i < 4; ++i) { accv s = {0.f, 0.f, 0.f, 0.f};
                s = __builtin_amdgcn_mfma_f32_16x16x32_bf16(Kc[i][0], Bq0, s, 0, 0, 0); s = __builtin_amdgcn_mfma_f32_16x16x32_bf16(Kc[i][1], Bq1, s, 0, 0, 0); S[4 * g4 + i] = s; } }
    }
    float mx = NEG;
#pragma unroll
    for (int kb = 0; kb < 16; ++kb) mx = fmaxf(fmaxf(fmaxf(S[kb][0], S[kb][1]), fmaxf(S[kb][2], S[kb][3])), mx);
    { const int lane = quad * 16 + q; mx = fmaxf(mx, SHX(mx, 16)); mx = fmaxf(mx, SHX(mx, 32)); }
    float sum = 0.f; u32x2 Pc[16];
#pragma unroll
    for (int kb = 0; kb < 16; ++kb) { float p[4];
#pragma unroll
        for (int rr = 0; rr < 4; ++rr) { p[rr] = __builtin_amdgcn_exp2f(S[kb][rr] - mx); sum += p[rr]; }
        Pc[kb].x = pg8::cvt_pk_bf16(p[0], p[1]); Pc[kb].y = pg8::cvt_pk_bf16(p[2], p[3]); }
    { const int lane = quad * 16 + q; sum += SHX(sum, 16); sum += SHX(sum, 32); }
    m2 = mx; l2 = sum;
#pragma unroll
    for (int db = 0; db < 4; ++db) O2[db] = (accv){0.f, 0.f, 0.f, 0.f};
    const bf16* vb = VC + q * AT_VC_LD + 8 * quad;
#pragma unroll
    for (int g2 = 0; g2 < 4; ++g2) {
        if (one) { asm volatile("");
            u32x4 Vc[2][4];
#pragma unroll
            for (int p2 = 0; p2 < 2; ++p2)
#pragma unroll
                for (int db = 0; db < 4; ++db) Vc[p2][db] = *(const u32x4*)(vb + 16 * db * AT_VC_LD + 32 * (2 * g2 + p2));
            SCHED_FENCE();
#pragma unroll
            for (int p2 = 0; p2 < 2; ++p2) { const int pi = 2 * g2 + p2;
                u32x4 pw; pw.x = Pc[2 * pi].x; pw.y = Pc[2 * pi].y; pw.z = Pc[2 * pi + 1].x; pw.w = Pc[2 * pi + 1].y;
                const bf16x8 Bp = __builtin_bit_cast(bf16x8, pw);
#pragma unroll
                for (int db = 0; db < 4; ++db) O2[db] = __builtin_amdgcn_mfma_f32_16x16x32_bf16(__builtin_bit_cast(bf16x8, Vc[p2][db]), Bp, O2[db], 0, 0, 0); } }
    }
}
__device__ __forceinline__ void attn_store(bf16* op, const accv (&O1)[4], const accv (&O2)[4], float m1, float l1, float m2, float l2) {
    const float m = fmaxf(m1, m2), f1 = __builtin_amdgcn_exp2f(m1 - m), f2 = __builtin_amdgcn_exp2f(m2 - m);
    const float inv = 1.0f / (l1 * f1 + l2 * f2), g1 = f1 * inv, g2 = f2 * inv;
#pragma unroll
    for (int db = 0; db < 4; ++db) { u32x2 w; w.x = pk2(O1[db][0] * g1 + O2[db][0] * g2, O1[db][1] * g1 + O2[db][1] * g2); w.y = pk2(O1[db][2] * g1 + O2[db][2] * g2, O1[db][3] * g1 + O2[db][3] * g2); *(u32x2*)(op + 16 * db) = w; }
}
__device__ __forceinline__ void attn_iter(const Args& a, unsigned char* lds, int bl, int h, int r0, int wave, bf16x8 (&qf)[2], int nq) {
    unsigned char* ws = a.ws;
    const bf16* QB = (const bf16*)(ws + A_QB); const bf16* KB = (const bf16*)(ws + A_KB); const bf16* VT = (const bf16*)(ws + A_VT); bf16* YN = (bf16*)(ws + A_YN);
    const float* RP = (const float*)(lds + AT_RP); unsigned char* win = lds + AT_WIN;
    const int r = r0 + (wave >> 2), j = wave & 3;
    const int ws0 = min(max(r0 - 4, 0), 24), start = min(max(r - 4, 0), 24), kstart = min(max(16 * j - 8, 0), 32), wl0 = start - ws0;
    int one = 1; asm volatile("" : "+s"(one));
    const float NEG = -__builtin_inff();
    u32x4 wr[9];
    { const int tid = wave * 64 + lane_id_fresh(); win_fetch_k(wr, KB, bl, h, ws0, tid); }
    SCHED_FENCE();
    accv O2[4]; float m2, l2;
    { const int lane = lane_id_fresh(), q = lane & 15, quad = lane >> 4; attn_ctx_seg(lds, qf[0], qf[1], q, quad, 8 * (q >> 2) + (q & 3), one, O2, m2, l2); }
    __syncthreads();
    { const int tid = wave * 64 + lane_id_fresh(); win_put_k(wr, win, tid); }
    __syncthreads();
    const int lane = lane_id_fresh(), q = lane & 15, quad = lane >> 4, kq = 8 * (q >> 2) + (q & 3);
    const bf16x8 Bq0 = qf[0], Bq1 = qf[1];
    accv S[16];
    {
        const int kcol0 = kstart + kq, kcol1 = kcol0 + 4;
        const unsigned char* k0 = win + (wl0 * 64 + kcol0) * 128, *k1 = win + (wl0 * 64 + kcol1) * 128;
        const int f0 = win_fk(kcol0), f1 = win_fk(kcol1);
        const int o00 = (quad ^ f0) << 4, o01 = ((quad + 4) ^ f0) << 4, o10 = (quad ^ f1) << 4, o11 = ((quad + 4) ^ f1) << 4;
#pragma unroll
        for (int g4 = 0; g4 < 4; ++g4) {
            if (one) { asm volatile("");
                bf16x8 Kw[4][2];
#pragma unroll
                for (int i = 0; i < 4; ++i) { const int kb = 4 * g4 + i; const unsigned char* kp = ((kb & 1) ? k1 : k0) + (kb >> 1) * 64 * 128;
                    Kw[i][0] = *(const bf16x8*)(kp + ((kb & 1) ? o10 : o00)); Kw[i][1] = *(const bf16x8*)(kp + ((kb & 1) ? o11 : o01)); }
                SCHED_FENCE();
#pragma unroll
                for (int i = 0; i < 4; ++i) { accv s = {0.f, 0.f, 0.f, 0.f};
                    s = __builtin_amdgcn_mfma_f32_16x16x32_bf16(Kw[i][0], Bq0, s, 0, 0, 0); s = __builtin_amdgcn_mfma_f32_16x16x32_bf16(Kw[i][1], Bq1, s, 0, 0, 0); S[4 * g4 + i] = s; } }
        }
    }
    SCHED_FENCE();
    { const int tid = wave * 64 + lane; win_fetch_v(wr, VT, bl, h, ws0, tid); }
    SCHED_FENCE();
    float m1, l1; u32x2 Pl[16];
    {
        const int qc = 16 * j + q, wst = min(max(qc - 8, 0), 48);
        int cof[2][4];
#pragma unroll
        for (int hb = 0; hb < 2; ++hb)
#pragma unroll
            for (int rr = 0; rr < 4; ++rr) { const int kc = kstart + 8 * quad + 4 * hb + rr; const bool ok = (kc >= wst) && (kc < wst + 16); cof[hb][rr] = ok ? min(max(kc - qc + 15, 0), 30) : -1; }
        const int rob = (start - r + 7) * 31;
#pragma unroll
        for (int g4 = 0; g4 < 4; ++g4) {
            if (one) { asm volatile("");
                float bw[4][4];
#pragma unroll
                for (int i = 0; i < 4; ++i) { const int kb = 4 * g4 + i;
#pragma unroll
                    for (int rr = 0; rr < 4; ++rr) { const int c = cof[kb & 1][rr]; bw[i][rr] = RP[c < 0 ? 465 : rob + (kb >> 1) * 31 + c]; } }
#pragma unroll
                for (int i = 0; i < 4; ++i) { const int kb = 4 * g4 + i;
#pragma unroll
                    for (int rr = 0; rr < 4; ++rr) S[kb][rr] += bw[i][rr]; } }
        }
        float mx = NEG;
#pragma unroll
        for (int kb = 0; kb < 16; ++kb) mx = fmaxf(fmaxf(fmaxf(S[kb][0], S[kb][1]), fmaxf(S[kb][2], S[kb][3])), mx);
        mx = fmaxf(mx, SHX(mx, 16)); mx = fmaxf(mx, SHX(mx, 32));
        float sum = 0.f;
#pragma unroll
        for (int kb = 0; kb < 16; ++kb) { float p[4];
#pragma unroll
            for (int rr = 0; rr < 4; ++rr) { p[rr] = __builtin_amdgcn_exp2f(S[kb][rr] - mx); sum += p[rr]; }
            Pl[kb].x = pg8::cvt_pk_bf16(p[0], p[1]); Pl[kb].y = pg8::cvt_pk_bf16(p[2], p[3]); }
        sum += SHX(sum, 16); sum += SHX(sum, 32);
        m1 = mx; l1 = sum;
    }
    __syncthreads();
    { const int tid = wave * 64 + lane; win_put_v(wr, win, tid); }
    __syncthreads();
    if (nq >= 0) { const bf16* qn = QB + (size_t)(nq + q) * DM + 64 * h + 8 * quad; qf[0] = *(const bf16x8*)qn; qf[1] = *(const bf16x8*)(qn + 32); }
    accv O1[4];
#pragma unroll
    for (int db = 0; db < 4; ++db) O1[db] = (accv){0.f, 0.f, 0.f, 0.f};
    {
        const int chunk = (kstart >> 3) + quad;
#pragma unroll
        for (int g2 = 0; g2 < 4; ++g2) {
            if (one) { asm volatile("");
                u32x4 Vw[2][4];
#pragma unroll
                for (int p2 = 0; p2 < 2; ++p2)
#pragma unroll
                    for (int db = 0; db < 4; ++db) { const int dd = 16 * db + q; Vw[p2][db] = *(const u32x4*)(win + ((wl0 + 2 * g2 + p2) * 64 + dd) * 128 + ((chunk ^ ((dd >> 1) & 7)) << 4)); }
                SCHED_FENCE();
#pragma unroll
                for (int p2 = 0; p2 < 2; ++p2) { const int pi = 2 * g2 + p2;
                    u32x4 pw; pw.x = Pl[2 * pi].x; pw.y = Pl[2 * pi].y; pw.z = Pl[2 * pi + 1].x; pw.w = Pl[2 * pi + 1].y;
                    const bf16x8 Bp = __builtin_bit_cast(bf16x8, pw);
#pragma unroll
                    for (int db = 0; db < 4; ++db) O1[db] = __builtin_amdgcn_mfma_f32_16x16x32_bf16(__builtin_bit_cast(bf16x8, Vw[p2][db]), Bp, O1[db], 0, 0, 0); } }
        }
    }
    attn_store(YN + (size_t)(bl * SEQ + 64 * r + 16 * j + q) * DM + 64 * h + 4 * quad, O1, O2, m1, l1, m2, l2);
}
__device__ __forceinline__ void attn_ctx_unit(const Args& a, const unsigned char* lds, int bl, int h, int qb, bf16x8 (&qf)[2]) {
    bf16* YN = (bf16*)(a.ws + A_YN);
    int one = 1; asm volatile("" : "+s"(one));
    const int lane = lane_id_fresh(), q = lane & 15, quad = lane >> 4;
    accv O2[4], O1[4]; float m2, l2;
    attn_ctx_seg(lds, qf[0], qf[1], q, quad, 8 * (q >> 2) + (q & 3), one, O2, m2, l2);
#pragma unroll
    for (int db = 0; db < 4; ++db) O1[db] = (accv){0.f, 0.f, 0.f, 0.f};
    attn_store(YN + (size_t)(LATG + bl * CTXL + 16 * qb + q) * DM + 64 * h + 4 * quad, O1, O2, -__builtin_inff(), 0.f, m2, l2);
}
__device__ __forceinline__ void attn_block(const Args& a, unsigned char* lds, int l, int bu, bool ctx_out, int wave) {
    const int bl = bu >> 5, h = (bu >> 1) & 15, half = bu & 1;
    __syncthreads();
    attn_stage(a, lds, l, bl, h, wave * 64 + lane_id_fresh());
    __syncthreads();
    const int j = wave & 3, rw = 16 * half + (wave >> 2);
    bf16x8 qf[2];
    { const int lane = lane_id_fresh(); const bf16* qp = (const bf16*)(a.ws + A_QB) + (size_t)(bl * SEQ + 64 * rw + 16 * j + (lane & 15)) * DM + 64 * h + 8 * (lane >> 4); qf[0] = *(const bf16x8*)qp; qf[1] = *(const bf16x8*)(qp + 32); }
    for (int it = 0; it < 8; ++it) {
        const int nq = it < 7 ? bl * SEQ + 64 * (rw + 2 * it + 2) + 16 * j : (ctx_out ? LATG + bl * CTXL + 16 * (8 * half + wave) : -1);
        attn_iter(a, lds, bl, h, 16 * half + 2 * it, wave, qf, nq); }
    if (ctx_out) attn_ctx_unit(a, lds, bl, h, 8 * half + wave, qf);
    __syncthreads();
}
constexpr int NPH = 1 + 2 * 30;
__host__ __device__ constexpr bool phase_used(int ph) { if (ph == 0) return true; const int q = ph - 1, l = q / 30, r = q % 30; if (l == 0) return r < 24 ? (r % 12) <= 5 : r <= 26; return r < 24 && (r % 12) <= 10; }

#define RFL(x) __builtin_amdgcn_readfirstlane(x)
#if defined(__HIP_DEVICE_COMPILE__)
__device__ __forceinline__ Args load_kargs() { const __attribute__((address_space(4))) unsigned long long* p = (const __attribute__((address_space(4))) unsigned long long*)__builtin_amdgcn_kernarg_segment_ptr();
    asm volatile("" : "+s"(p)); Args r;
    typedef __attribute__((address_space(1))) float gf32; typedef __attribute__((address_space(1))) unsigned char gu8;
#pragma unroll
    for (int i = 0; i < 25; ++i) r.in[i] = (const float*)(const gf32*)p[i];
    r.out = (float*)(gf32*)p[25]; r.ws = (unsigned char*)(gu8*)p[26];
    const unsigned long long w = p[27]; r.ph_lo = (int)(unsigned)w; r.ph_hi = (int)(unsigned)(w >> 32);
    return r; }
#define LOAD_KARGS() load_kargs()
#else
#define LOAD_KARGS() a_in
#endif
#define PHASE_IDS() const Args a = LOAD_KARGS(); unsigned char* const ws = a.ws; (void)ws; int lane_l; asm volatile("v_mbcnt_lo_u32_b32 %0, -1, 0\n\tv_mbcnt_hi_u32_b32 %0, -1, %0" : "=v"(lane_l)); int wave_l = wave_s; asm volatile("" : "+s"(wave_l)); const int lane = lane_l, wave = wave_l, tid = wave_l * 64 + lane, gw = blk * NWAVES + wave, NGW = G * NWAVES; const float* modl = (const float*)(ws + WS_MOD) + (size_t)l * 17 * NMOD; const float* xin_lat = (l == 0 ? a.in[I_X] : a.out) + (size_t)g * LATG * DM; const float* xin_ctx = (l == 0 ? a.in[I_CTX] : (const float*)(ws + WS_XC)) + (size_t)g * CTXG * DM; float* xs_lat = a.out + (size_t)g * LATG * DM; float* xs_ctx = (float*)(ws + WS_XC) + (size_t)g * CTXG * DM; bf16* xsb_lat = (bf16*)a.out + (size_t)g * LATG * XS_LD; bf16* xsb_ctx = (bf16*)(ws + WS_XC) + (size_t)g * CTXG * XS_LD; (void)xsb_lat; (void)xsb_ctx; (void)modl; (void)xin_lat; (void)xin_ctx; (void)xs_lat; (void)xs_ctx; (void)lane; (void)wave; (void)gw; (void)NGW; (void)tid
__global__ void __launch_bounds__(NTHR, 2) fwd(Args a_in) {
    extern __shared__ __attribute__((aligned(16))) unsigned char lds[];
    const int tid = threadIdx.x, lane = tid & 63, wave = __builtin_amdgcn_readfirstlane(tid >> 6), G = gridDim.x, blk = blockIdx.x;
    const int wave_s = wave;
    if (tid < 16) ((unsigned*)(lds + MISC_OFF))[tid] = 0u;
    __syncthreads();
    XcdBarrier bar = xcd_barrier_post((unsigned*)(a_in.ws + WS_CTL) + CW_BAR, (volatile LAS unsigned*)(lds + MISC_OFF));
    const int lo = a_in.ph_lo, hi = a_in.ph_hi;
#ifndef PHMASK
#define PHMASK 0xFFFF
#endif
#define IN(k) (lo <= (k) && (k) < hi)
#define EN(k) ((PHMASK >> (k)) & 1)
#define SEAM(k) do { if ((k) + 1 < hi) xcd_barrier(bar); } while (0)
    PG8_LAS unsigned char* ring = (PG8_LAS unsigned char*)lds;

    if (EN(0) && IN(0)) { phase_prologue(a_in, lds, blk, G, wave, lane, tid, G == 256); SEAM(0); }

    for (int l = 0; l < NLAYER; ++l) {
        for (int g = 0; g < NGRP; ++g) {
            const int pb = 1 + 30 * l + 12 * g;
            if (hi <= pb || lo >= pb + 12) continue;
            int blk_l = blockIdx.x, G_l = gridDim.x; asm volatile("" : "+s"(blk_l), "+s"(G_l));
            const int blk = blk_l, G = G_l;
            const bool ctx_out = (l == 0);

            if (EN(1) && IN(pb + 0)) {
                PHASE_IDS();
                bf16* H = (bf16*)(ws + A_H);
                { const int rpw = (RG + NGW - 1) / NGW, r0 = gw * rpw, nr = RG - r0 < rpw ? RG - r0 : rpw;
                  if (l == 0) modulate_rows<false, false>(xin_lat, xin_ctx, LATG, g * BG, modl, 0, H, r0, nr, lane, nullptr, nullptr, nullptr, nullptr);
                  else {
                      const int rl = (LATG + NGW - 1) / NGW, l0r = gw * rl, nl = LATG - l0r < rl ? LATG - l0r : rl, rc = (CTXG + NGW - 1) / NGW, c0r = gw * rc, nc = CTXG - c0r < rc ? CTXG - c0r : rc;
                      modulate_rows<false, true, false>(xsb_lat, xsb_ctx, LATG, g * BG, modl, 0, H, l0r, nl, lane, nullptr, nullptr, nullptr, nullptr);
                      modulate_rows<false, true, true>(xsb_lat, xsb_ctx, LATG, g * BG, modl, 0, H, LATG + c0r, nc, lane, nullptr, nullptr, nullptr, nullptr, xsb_lat); } }
                SEAM(pb + 0);
            }
            if (EN(2) && IN(pb + 1)) {
                PHASE_IDS();
                pg8::Gemm gm{(const pg8::bf16_t*)(ws + A_H), (const pg8::bf16_t*)(ws + WS_WIN) + (size_t)l * NIN * DM, RG, NIN, DM, DM};
                int nn1 = ctx_out ? 28 : 12; asm volatile("" : "+s"(nn1));
                RectOrder S{64, 28, 8, nn1, G, blk, DM / 64};
                EpiIn E{ws, a.in[I_QG] + l * HD, a.in[I_KG] + l * HD};
                pg8::gemm_phase<EpiIn, RectOrder, false>(ring, gm, S, E, nullptr, tid);
                SEAM(pb + 1);
            }
            if (EN(3) && IN(pb + 2)) {
                PHASE_IDS();
                for (int u = blk; u < 256; u += G) rglru_unit(a, lds, l, u, ctx_out, wave, lane, tid);
                for (int bu = blk; bu < 256; bu += G) attn_block(a, lds, l, bu, ctx_out, wave);
                SEAM(pb + 2);
            }
            int nMmix = ctx_out ? 72 : 64; asm volatile("" : "+s"(nMmix));
            if (EN(4) && IN(pb + 3)) {
                PHASE_IDS();
                pg8::Gemm gm{(const pg8::bf16_t*)(ws + A_H), (const pg8::bf16_t*)(ws + WS_WRO) + (size_t)l * DM * DM, RG, DM, DM, DM};
                RectOrder S{nMmix, 4, 0, 0, G, blk, DM / 64};
                EpiGate<0> E{(const bf16*)(ws + A_SR), nullptr, (bf16*)(ws + A_T1)};
                pg8::gemm_phase<EpiGate<0>, RectOrder, false>(ring, gm, S, E, nullptr, tid);
                if (l == 0 && G == 256) moe_convert_slice(a, lds, 3 * g + 0, blk, wave, lane);
                __syncthreads();
            }
            if (EN(5) && IN(pb + 4)) {
                PHASE_IDS();
                pg8::Gemm gm{(const pg8::bf16_t*)(ws + A_YN), (const pg8::bf16_t*)(ws + WS_WNO) + (size_t)l * DM * DM, RG, DM, DM, DM};
                RectOrder S{nMmix, 4, 0, 0, G, blk, DM / 64};
                EpiGate<1> E{(const bf16*)(ws + A_SN), (const bf16*)(ws + A_T1), (bf16*)(ws + A_XR)};
                pg8::gemm_phase<EpiGate<1>, RectOrder, false>(ring, gm, S, E, nullptr, tid);
                if (l == 0 && G == 256) moe_convert_slice(a, lds, 3 * g + 1, blk, wave, lane);
                SEAM(pb + 4);
            }
            if (EN(6) && IN(pb + 5)) {
                PHASE_IDS();
                pg8::Gemm gm{(const pg8::bf16_t*)(ws + A_XR), (const pg8::bf16_t*)(ws + WS_WOUT) + (size_t)l * DM * DM, RG, DM, DM, DM};
                RectOrder S{nMmix, 4, 0, 0, G, blk, DM / 64};
                if (l == 0) { EpiRes<true> E{xin_lat, xin_ctx, xsb_lat, xsb_ctx, modl, 2, g * BG, 64}; pg8::gemm_phase<EpiRes<true>, RectOrder, false>(ring, gm, S, E, nullptr, tid); }
                else { EpiRes<false> E{xsb_lat, xsb_ctx, xsb_lat, xsb_ctx, modl, 2, g * BG, 64}; pg8::gemm_phase<EpiRes<false>, RectOrder, false>(ring, gm, S, E, nullptr, tid); }
                if (l == 0 && G == 256) moe_convert_slice(a, lds, 3 * g + 2, blk, wave, lane);
                if (l == 0 && g == 0 && MK_ONE_LAUNCH) __syncthreads(); else SEAM(pb + 5);
            }
            if (l == 0) continue;
            if (EN(7) && IN(pb + 6)) {
                PHASE_IDS();
                bf16* H2 = (bf16*)(ws + A_H2M); int* cntl = (int*)(lds + 1024);
                int* re = (int*)(ws + WS_MISC + MS_ROUTE_E); float* rw = (float*)(ws + WS_MISC + MS_ROUTE_W); int* cntg = (int*)(ws + WS_MISC + MS_CNT);
                for (int c = blk; c < LATG / 64; c += G) {
                    if (tid < 8) cntl[tid] = 0;
                    __syncthreads();
                    modulate_rows<true, true>(xsb_lat, xsb_lat, LATG, g * BG, modl, 3, H2, c * 64 + wave * 8, 8, lane, a.in[I_ROUTER], re, rw, cntl);
                    __syncthreads();
                    if (tid < 8) cntg[c * 8 + tid] = cntl[tid];
                    __syncthreads();
                }
                SEAM(pb + 6);
            }
            if (EN(8) && IN(pb + 7)) {
                PHASE_IDS();
                int* pre = (int*)lds;
                int* toff = (int*)(lds + 8192);
                const int* cntg = (const int*)(ws + WS_MISC + MS_CNT); const int* re = (const int*)(ws + WS_MISC + MS_ROUTE_E); const float* rw = (const float*)(ws + WS_MISC + MS_ROUTE_W);
                int* tokslot = (int*)(ws + WS_MISC + MS_TOKSLOT); float* slotw = (float*)(ws + WS_MISC + MS_SLOTW); int* rowmap = (int*)(ws + WS_MISC + MS_ROWMAP);
                for (int i = tid; i < 2048; i += NTHR) pre[i] = cntg[i];
                __syncthreads();
                if (tid < 8) { int run = 0; for (int c = 0; c < 256; ++c) { const int v = pre[c * 8 + tid]; pre[c * 8 + tid] = run; run += v; } toff[10 + tid] = run; }
                __syncthreads();
                if (tid == 0) { int t = 0; for (int e = 0; e < 8; ++e) { toff[e] = t; t += (toff[10 + e] + 255) >> 8; } toff[8] = t; toff[9] = t;
                    if (blk == 0) { int* tg = (int*)(ws + WS_MISC + MS_TOFF); for (int e = 0; e < 10; ++e) tg[e] = toff[e]; } }
                __syncthreads();
                for (int e = blk; e < 8; e += G) {
                    for (int s = toff[e] * 256 + toff[10 + e] + tid; s < toff[e + 1] * 256; s += NTHR) rowmap[s] = 0; }
                for (int c = blk; c < LATG / 64; c += G) {
                    if (wave == 0) { const int r = c * 64 + lane, ee = re[r], e0 = ee & 255, e1 = ee >> 8; int s0 = 0, s1 = 0;
                        const unsigned long long lt = (1ull << lane) - 1ull;
#pragma unroll
                        for (int e = 0; e < 8; ++e) { const unsigned long long m0 = __ballot(e0 == e), m1 = __ballot(e1 == e);
                            const int base = toff[e] * 256 + pre[c * 8 + e];
                            if (e0 == e) s0 = base + __popcll(m0 & lt);
                            if (e1 == e) s1 = base + __popcll(m0) + __popcll(m1 & lt); }
                        tokslot[2 * r] = s0; tokslot[2 * r + 1] = s1; slotw[s0] = rw[2 * r]; slotw[s1] = rw[2 * r + 1]; rowmap[s0] = r; rowmap[s1] = r; }
                }
                SEAM(pb + 7);
            }
            if (EN(9) && IN(pb + 8)) {
                PHASE_IDS();
                const int* tg = (const int*)(ws + WS_MISC + MS_TOFF);
                pg8::Gemm gm{(const pg8::bf16_t*)(ws + A_H2M), (const pg8::bf16_t*)(ws + WS_WM13), MOE_ROWS_MAX, 2 * DFE, DM, DM};
                MoeOrder S{RFL(tg[8]), 28, G, blk, RFL(tg[1]), RFL(tg[2]), RFL(tg[3]), RFL(tg[4]), RFL(tg[5]), RFL(tg[6]), RFL(tg[7]), DM / 64};
                EpiSwi<true> E{(bf16*)(ws + A_ACTM), DFE, 28, (const float*)(ws + WS_MISC + MS_SLOTW)};
                PG8_LAS int* umap = (PG8_LAS int*)(ring + RING_BYTES);
                { const int* rowmap = (const int*)(ws + WS_MISC + MS_ROWMAP); pg8::Unit uu;
                  for (int i = 0; i < MOE_GATHER_UNITS && S.next(i, uu); ++i) { if (tid < 256) umap[i * 256 + tid] = rowmap[uu.pm * 256 + tid]; } }
                __syncthreads();
                pg8::gemm_phase<EpiSwi<true>, MoeOrder, false, true>(ring, gm, S, E, nullptr, tid, umap);
                SEAM(pb + 8);
            }
            if (EN(10) && IN(pb + 9)) {
                PHASE_IDS();
                const int* tg = (const int*)(ws + WS_MISC + MS_TOFF);
                pg8::Gemm gm{(const pg8::bf16_t*)(ws + A_ACTM), (const pg8::bf16_t*)(ws + WS_WM2), MOE_ROWS_MAX, DM, DFE, DFE};
                MoeDownOrder S{RFL(tg[8]), G, blk, RFL(tg[1]), RFL(tg[2]), RFL(tg[3]), RFL(tg[4]), RFL(tg[5]), RFL(tg[6]), RFL(tg[7])};
                EpiY E{(bf16*)(ws + A_Y), 4, (bf16*)(ws + A_YPART)};
                pg8::gemm_phase<EpiY, MoeDownOrder, false>(ring, gm, S, E, nullptr, tid);
                SEAM(pb + 9);
            }
            if (EN(11) && IN(pb + 10)) {
                PHASE_IDS();
                const int* tokslot = (const int*)(ws + WS_MISC + MS_TOKSLOT); const bf16* Y = (const bf16*)(ws + A_Y); const bf16* YP = (const bf16*)(ws + A_YPART);
                for (int r = gw; r < LATG; r += NGW) { const int s0 = tokslot[2 * r], s1 = tokslot[2 * r + 1], mrow = g * BG + r / SEQ;
                    const float* gp = modl + (size_t)mrow * NMOD + 5 * DM; float* xr = xs_lat + (size_t)r * DM; const bf16* xb = xsb_lat + (size_t)r * XS_LD;
                    u32x2 y0[4], y1[4], xw[4]; f32x4 gv[4], xv[4];
                    const bool o0 = (s0 >> 8) >= MOE_MAIN_TILES, o1 = (s1 >> 8) >= MOE_MAIN_TILES;
                    const bf16* p0 = o0 ? YP + (size_t)(s0 - MOE_MAIN_TILES * 256) * DM : Y + (size_t)s0 * DM; const bf16* p1 = o1 ? YP + (size_t)(s1 - MOE_MAIN_TILES * 256) * DM : Y + (size_t)s1 * DM;
#pragma unroll
                    for (int j = 0; j < 4; ++j) { const int col = 4 * lane + 256 * j;
                        y0[j] = *(const u32x2*)(p0 + col); y1[j] = *(const u32x2*)(p1 + col); gv[j] = *(const f32x4*)(gp + col); xw[j] = *(const u32x2*)(xb + col); }
#pragma unroll
                    for (int j = 0; j < 4; ++j) xv[j] = (f32x4){bflo(xw[j].x), bfhi(xw[j].x), bflo(xw[j].y), bfhi(xw[j].y)};
                    f32x4 ys[4];
#pragma unroll
                    for (int j = 0; j < 4; ++j) ys[j] = (f32x4){bflo(y0[j].x) + bflo(y1[j].x), bfhi(y0[j].x) + bfhi(y1[j].x), bflo(y0[j].y) + bflo(y1[j].y), bfhi(y0[j].y) + bfhi(y1[j].y)};
                    if (o0 || o1) {
                        for (int ks = 1; ks < MOE_KS; ++ks) { const size_t po = (size_t)ks * 8 * 256 * DM;
#pragma unroll
                            for (int j = 0; j < 4; ++j) { const int col = 4 * lane + 256 * j;
                                if (o0) { const u32x2 t = *(const u32x2*)(p0 + po + col); ys[j].x += bflo(t.x); ys[j].y += bfhi(t.x); ys[j].z += bflo(t.y); ys[j].w += bfhi(t.y); }
                                if (o1) { const u32x2 t = *(const u32x2*)(p1 + po + col); ys[j].x += bflo(t.x); ys[j].y += bfhi(t.x); ys[j].z += bflo(t.y); ys[j].w += bfhi(t.y); } } } }
#pragma unroll
                    for (int j = 0; j < 4; ++j) ys[j] = xv[j] + gv[j] * ys[j];
                    asm volatile("s_waitcnt vmcnt(0)" ::: "memory");
#pragma unroll
                    for (int j = 0; j < 4; ++j) { const int col = 4 * lane + 256 * j; *(f32x4*)(xr + col) = ys[j]; } }
                if (g + 1 < NGRP && MK_ONE_LAUNCH) {} else SEAM(pb + 10);
            }
        }
        if (l == 0 && !(hi <= 25 || lo >= 28)) {
            int blk_l = blockIdx.x, G_l = gridDim.x; asm volatile("" : "+s"(blk_l), "+s"(G_l));
            const int blk = blk_l, G = G_l, g = 0; (void)g;
            constexpr int NLAT = NB * SEQ, NALL = NLAT + NB * CTXL;
            if (EN(7) && IN(25)) {
                PHASE_IDS();
                bf16* H2 = (bf16*)(ws + A_H2);
                { const int rpw = (NALL + NGW - 1) / NGW, r0 = gw * rpw, nr = NALL - r0 < rpw ? NALL - r0 : rpw;
                  modulate_rows<false, true>(a.out, ws + WS_XC, NLAT, 0, modl, 3, H2, r0, nr, lane, nullptr, nullptr, nullptr, nullptr); }
                SEAM(25);
            }
            if (EN(8) && IN(26)) {
                PHASE_IDS();
                pg8::Gemm gm{(const pg8::bf16_t*)(ws + A_H2), (const pg8::bf16_t*)(ws + WS_WF13), NALL, 2 * DFF, DM, DM};
                RectOrder S{144, 22, 0, 0, G, blk, DM / 64};
                EpiSwi<false> E{(bf16*)(ws + A_ACT), DFF, 22, nullptr};
                pg8::gemm_phase<EpiSwi<false>, RectOrder, false>(ring, gm, S, E, nullptr, tid);
                SEAM(26);
            }
            if (EN(9) && IN(27)) {
                PHASE_IDS();
                pg8::Gemm gm{(const pg8::bf16_t*)(ws + A_ACT), (const pg8::bf16_t*)(ws + WS_WF2), NALL, DM, DFF, DFF};
                FfnDownOrder S{G, blk};
                EpiRes<false, true> E{a.out, ws + WS_XC, (bf16*)a.out, (bf16*)(ws + WS_XC), modl, 5, 0, 128};
                pg8::gemm_phase<EpiRes<false, true>, FfnDownOrder, false>(ring, gm, S, E, nullptr, tid);
                SEAM(27);
            }
        }
    }
#undef IN
#undef SEAM
}

extern "C" void kernel_launch(void* const* d_in, const int* in_sizes, int n_in, void* d_out, int out_size, void* d_ws, size_t ws_size, hipStream_t stream) {
    static int grid = 0;
    if (grid == 0) {
        if (n_in != 25 || out_size != NB * SEQ * DM || ws_size < WS_END) { fprintf(stderr, "kernel_launch: unexpected shapes (n_in %d, out %d, ws %zu < %zu)\n", n_in, out_size, ws_size, (size_t)WS_END); grid = -1; return; }
        int dev = 0, cus = 0, per_cu = 0;
        if (hipGetDevice(&dev) != hipSuccess || hipDeviceGetAttribute(&cus, hipDeviceAttributeMultiprocessorCount, dev) != hipSuccess) { grid = -1; return; }
        if (hipFuncSetAttribute((const void*)fwd, hipFuncAttributeMaxDynamicSharedMemorySize, LDS_BYTES) != hipSuccess) { fprintf(stderr, "kernel_launch: hipFuncSetAttribute failed\n"); grid = -1; return; }
        if (hipOccupancyMaxActiveBlocksPerMultiprocessor(&per_cu, (const void*)fwd, NTHR, LDS_BYTES) != hipSuccess || per_cu < 1) fprintf(stderr, "kernel_launch: occupancy query reports %d\n", per_cu);
        (void)hipGetLastError();
        grid = cus;
    }
    if (grid < 0) return;
    if (hipMemsetAsync((char*)d_ws + WS_CTL, 0, CTL_ZERO_BYTES, stream) != hipSuccess) return;
    Args a{};
    for (int i = 0; i < 25; ++i) a.in[i] = (const float*)d_in[i];
    a.out = (float*)d_out; a.ws = (unsigned char*)d_ws;
#if MK_ONE_LAUNCH
    a.ph_lo = 0; a.ph_hi = NPH;
    hipLaunchKernelGGL(fwd, dim3(grid), dim3(NTHR), LDS_BYTES, stream, a);
#else
    for (int ph = 0; ph < NPH; ++ph) { if (!phase_used(ph)) continue; a.ph_lo = ph; a.ph_hi = ph + 1; hipLaunchKernelGGL(fwd, dim3(grid), dim3(NTHR), LDS_BYTES, stream, a); }
#endif
}
```

```cpp
#include <hip/hip_runtime.h>
#include <cstdio>
#include <cstdint>
#include <type_traits>
#ifndef MK_ONE_LAUNCH
#define MK_ONE_LAUNCH 1
#endif
#define XB_TMO      128
#define XB_XCNT(j)  (256  + 64 * (j))
#define XB_XSUB(j)  (1280 + 64 * (j))
#define XB_XGEN(j)  (2304 + 64 * (j))
#define XB_TOP      3328
#define XB_TOPGEN   3392
#define XCD_BAR_WORDS 3456
#define XB_SPIN_CAP (1u << 22)
#define LAS __attribute__((address_space(3)))

__device__ __forceinline__ unsigned xb_ld(unsigned* p)              { return __hip_atomic_load(p, __ATOMIC_RELAXED, __HIP_MEMORY_SCOPE_AGENT); }
__device__ __forceinline__ unsigned xb_add(unsigned* p, unsigned v) { return __hip_atomic_fetch_add(p, v, __ATOMIC_RELAXED, __HIP_MEMORY_SCOPE_AGENT); }
__device__ __forceinline__ unsigned xb_xcc_id() { return (unsigned)__builtin_amdgcn_s_getreg((3 << 11) | 20) & 0xFu; }
#define XB_SPIN(cond, bar) do { unsigned _sp = 0; while (cond) { __builtin_amdgcn_s_sleep(1); \
    if ((++_sp & 255u) == 0u) { if (xb_ld(&(bar)[XB_TMO])) break; if (_sp > XB_SPIN_CAP) { atomicAdd(&(bar)[XB_TMO], 1u); break; } } } } while (0)

struct XcdBarrier {
    unsigned* bar; unsigned x;
    volatile LAS unsigned* st;
};

__device__ __forceinline__ XcdBarrier xcd_barrier_post(unsigned* bar, volatile LAS unsigned* st) {
    XcdBarrier b; b.bar = bar; b.x = xb_xcc_id(); b.st = st;
    if (threadIdx.x == 0) (void)xb_add(&bar[XB_XCNT(b.x)], 1u);
    return b;
}
__device__ __forceinline__ void xcd_barrier_complete(unsigned* bar, unsigned x, unsigned& nloc, unsigned& nx) {
    const unsigned G = gridDim.x * gridDim.y * gridDim.z;
    unsigned sum, cnt, mine, sp = 0u;
    for (;;) {
        sum = 0u; cnt = 0u; mine = 0u;
#pragma unroll
        for (unsigned j = 0; j < 16; ++j) { const unsigned c = xb_ld(&bar[XB_XCNT(j)]); sum += c; cnt += (c > 0u) ? 1u : 0u; mine = (j == x) ? c : mine; }
        if (sum == G) break;
        __builtin_amdgcn_s_sleep(1);
        if ((++sp & 255u) == 0u) { if (xb_ld(&bar[XB_TMO])) break; if (sp > XB_SPIN_CAP) { atomicAdd(&bar[XB_TMO], 1u); break; } }
    }
    nloc = mine > 0u ? mine : 1u; nx = cnt > 0u ? cnt : 1u;
}

__device__ __forceinline__ void xcd_barrier(const XcdBarrier& b) {
    asm volatile("s_waitcnt vmcnt(0)" ::: "memory");
    __syncthreads();
    if (threadIdx.x == 0) {
        unsigned* bar = b.bar;
        __builtin_amdgcn_s_waitcnt(0);
        unsigned nloc = b.st[0], nx = b.st[1];
        if (nloc == 0u) { xcd_barrier_complete(bar, b.x, nloc, nx); b.st[0] = nloc; b.st[1] = nx; }
        const unsigned old = xb_add(&bar[XB_XSUB(b.x)], 1u);
        const unsigned gen = old / nloc;
        if (old + 1u == (gen + 1u) * nloc) {
            __builtin_amdgcn_fence(__ATOMIC_RELEASE, "agent");
            asm volatile("s_waitcnt vmcnt(0)" ::: "memory");
            const unsigned og = xb_add(&bar[XB_TOP], 1u);
            const unsigned tg = og / nx;
            if (og + 1u == (tg + 1u) * nx) xb_add(&bar[XB_TOPGEN], 1u);
            else XB_SPIN(xb_ld(&bar[XB_TOPGEN]) == tg, bar);
            __builtin_amdgcn_fence(__ATOMIC_ACQUIRE, "agent");
            xb_add(&bar[XB_XGEN(b.x)], 1u);
            asm volatile("s_waitcnt vmcnt(0)" ::: "memory");
        } else {
            XB_SPIN(xb_ld(&bar[XB_XGEN(b.x)]) == gen, bar);
            __builtin_amdgcn_fence(__ATOMIC_ACQUIRE, "agent");
            asm volatile("s_waitcnt vmcnt(0)" ::: "memory");
        }
    }
    __syncthreads();
}

namespace pg8 {
#define PG8_LAS __attribute__((address_space(3)))
typedef unsigned short bf16_t;
typedef short bf16x8 __attribute__((ext_vector_type(8)));
typedef float f32x4 __attribute__((ext_vector_type(4)));
typedef unsigned u32x4 __attribute__((ext_vector_type(4)));
constexpr int BM = 256, BK = 64, HALF = 128, HTB = HALF * BK * 2  , STAGE_BYTES = 8 * HTB, NXCD = 8, WGM = 8;

__host__ __device__ __forceinline__ int lds_byte(int r, int c) { const int st = (r >> 4) * 2 + (c >> 5), rr = r & 15, cc = c & 31, ob = rr * 64 + cc * 2; return st * 1024 + (ob ^ (((ob >> 9) & 1) << 5)); }
__host__ __device__ __forceinline__ void stage_rc(int b, int& R, int& C) { const int st = b / 1024, sb = b % 1024, swz = sb ^ (((sb >> 9) & 1) << 5); R = (st >> 1) * 16 + swz / 64; C = (st & 1) * 32 + (swz % 64) / 2; }
__host__ __device__ __forceinline__ int perm32(int rho) { const int n = rho >> 4, i = rho & 15; return 8 * (i >> 2) + 4 * n + (i & 3); }

struct Unit { int pm, pn, koff, nt; };
struct Gemm { const bf16_t* A; const bf16_t* Bt; int M, N, K, ld; };
__device__ __forceinline__ unsigned cvt_pk_bf16(float lo, float hi) { unsigned r; asm volatile("v_cvt_pk_bf16_f32 %0, %1, %2" : "=v"(r) : "v"(lo), "v"(hi)); return r; }
typedef float f32x2 __attribute__((ext_vector_type(2)));
template <class Epi, class Sched, bool STAMP = false, bool GATHER = false>
__device__ __forceinline__ void gemm_phase(PG8_LAS unsigned char* lds, const Gemm g, const Sched& S, const Epi& E, unsigned long long* stamps, int tid_in, const PG8_LAS int* rowmap = nullptr) {
    int tid_l = tid_in; asm volatile("" : "+v"(tid_l));
    const int tid = tid_l, wid = __builtin_amdgcn_readfirstlane(tid >> 6), lane = tid & 63, wr = wid >> 2, wc = wid & 3, fr = lane & 15, fq = lane >> 4;
    const int K = g.ld;
    int ts_lo = 0, ts_hi = 0, nts = 0; const unsigned long long rt_entry = STAMP ? (unsigned long long)wall_clock64() : 0ull;
#define PG8_STAMP() do { if (STAMP && wid == 0 && nts < 64) { const unsigned long long _c = (unsigned long long)clock64(); \
        ts_lo = (lane == nts) ? (int)(unsigned)_c : ts_lo; ts_hi = (lane == nts) ? (int)(unsigned)(_c >> 32) : ts_hi; ++nts; } } while (0)
    PG8_STAMP();
    unsigned voffA[2], voffB[2];
#pragma unroll
    for (int i = 0; i < 2; ++i) { int R, C; stage_rc(tid * 16 + i * 8192, R, C); const int Rb = Epi::PERM ? ((R & ~31) + perm32(R & 31)) : R;
        voffA[i] = (unsigned)(R * K + C) * 2u; voffB[i] = (unsigned)(Rb * K + C) * 2u; }
    unsigned vAc[2][2] = {{0u, 0u}, {0u, 0u}}, vAn[2][2] = {{0u, 0u}, {0u, 0u}};
#define PG8_GVOFF(dst, ui_) do { _Pragma("unroll") for (int h_ = 0; h_ < 2; ++h_) _Pragma("unroll") for (int i_ = 0; i_ < 2; ++i_) { int R_, C_; stage_rc(tid * 16 + i_ * 8192, R_, C_); \
        dst[h_][i_] = (unsigned)(rowmap[(ui_) * 256 + h_ * 128 + R_] * K + C_) * 2u; } } while (0)
    const size_t kstep = (size_t)(BK * 2);
    const size_t hstep = (size_t)HALF * K * 2;
    const size_t tstep = 2 * hstep;
    const unsigned ldsw = (unsigned)wid * 1024u;
    const int aoff = lds_byte(wr * 64 + fr, fq * 8), boff = lds_byte(wc * 32 + fr, fq * 8);
#define PG8_SA(b, h) (((b) * 2 + (h)) * HTB)
#define PG8_SB(b, h) ((4 + (b) * 2 + (h)) * HTB)
#define PG8_STAGE(bufoff, gbase, voff) do { _Pragma("unroll") for (int _i = 0; _i < 2; ++_i) \
        __builtin_amdgcn_global_load_lds((const unsigned*)((const char*)(gbase) + (voff)[_i]), (PG8_LAS unsigned*)(lds + (bufoff) + ldsw + _i * 8192), 16, 0, 0); } while (0)
#define PG8_STAGE_A(bufoff, gbase, h, V) do { if constexpr (GATHER) { PG8_STAGE(bufoff, gbase, V[h]); } else { PG8_STAGE(bufoff, (gbase) + ((h) ? hstep : 0), voffA); } } while (0)
#define PG8_LDA(dst, b, h) do { _Pragma("unroll") for (int m = 0; m < 4; ++m) _Pragma("unroll") for (int k = 0; k < 2; ++k) dst[m][k] = *(const PG8_LAS bf16x8*)(lds + PG8_SA(b, h) + aoff + m * 2048 + k * 1024); } while (0)
#define PG8_LDB(dst, b, h) do { _Pragma("unroll") for (int n = 0; n < 2; ++n) _Pragma("unroll") for (int k = 0; k < 2; ++k) dst[n][k] = *(const PG8_LAS bf16x8*)(lds + PG8_SB(b, h) + boff + n * 2048 + k * 1024); } while (0)
#define PG8_MMA(ai, bj, At, Bt) do { __builtin_amdgcn_s_setprio(1); _Pragma("unroll") for (int m = 0; m < 4; ++m) _Pragma("unroll") for (int n = 0; n < 2; ++n) _Pragma("unroll") for (int k = 0; k < 2; ++k) \
        acc[ai][bj][m][n] = __builtin_amdgcn_mfma_f32_16x16x32_bf16(Bt[n][k], At[m][k], acc[ai][bj][m][n], 0, 0, 0); __builtin_amdgcn_s_setprio(0); } while (0)
#define PG8_WAIT_V(n) asm volatile("s_waitcnt vmcnt(" #n ")" ::: "memory")
#define PG8_WAIT_L(n) asm volatile("s_waitcnt lgkmcnt(" #n ")" ::: "memory")
#define PG8_BAR __builtin_amdgcn_s_barrier()
#define PG8_SCHED __builtin_amdgcn_sched_barrier(0)
    Unit cur, nxt; int ui = 0;
    if (!S.next(0, cur)) return;
    f32x4 acc[2][2][4][2];
#pragma unroll
    for (int a = 0; a < 2; ++a)
#pragma unroll
        for (int b = 0; b < 2; ++b)
#pragma unroll
            for (int m = 0; m < 4; ++m)
#pragma unroll
                for (int n = 0; n < 2; ++n) acc[a][b][m][n] = (f32x4){0.f, 0.f, 0.f, 0.f};
    bf16x8 At[4][2], B0[2][2], B1[2][2];
    const char* cA = (const char*)g.A + (GATHER ? (size_t)0 : (size_t)cur.pm * tstep) + cur.koff; const char* cB = (const char*)g.Bt + (size_t)cur.pn * tstep + cur.koff;
    if constexpr (GATHER) PG8_GVOFF(vAc, 0);
    if constexpr (Epi::HAS_SWAP) { if (E.swap_ab(cur)) { const char* t_ = cA; cA = cB; cB = t_; } }
    S.a_ready(cur);
    PG8_STAGE(PG8_SB(0, 0), cB, voffB); PG8_STAGE_A(PG8_SA(0, 0), cA, 0, vAc); PG8_STAGE(PG8_SB(0, 1), cB + hstep, voffB); PG8_STAGE_A(PG8_SA(0, 1), cA, 1, vAc);
    if (wr == 1) PG8_BAR;
    PG8_WAIT_V(4); PG8_BAR;
    PG8_STAGE(PG8_SB(1, 0), cB + kstep, voffB); PG8_STAGE_A(PG8_SA(1, 0), cA + kstep, 0, vAc); PG8_STAGE(PG8_SB(1, 1), cB + hstep + kstep, voffB);
    PG8_WAIT_V(6); PG8_BAR;
    PG8_STAMP();
    for (;;) {
        const bool has_next = S.next(ui + 1, nxt);
        const char* nA_ = has_next ? (const char*)g.A + (GATHER ? (size_t)0 : (size_t)nxt.pm * tstep) + nxt.koff : cA; const char* nB_ = has_next ? (const char*)g.Bt + (size_t)nxt.pn * tstep + nxt.koff : cB;
        const char* nA = nA_; const char* nB = nB_;
        if constexpr (Epi::HAS_SWAP) { if (has_next && E.swap_ab(nxt)) { nA = nB_; nB = nA_; } }
        if constexpr (GATHER) { if (has_next) PG8_GVOFF(vAn, ui + 1); else { _Pragma("unroll") for (int h_ = 0; h_ < 2; ++h_) _Pragma("unroll") for (int i_ = 0; i_ < 2; ++i_) vAn[h_][i_] = vAc[h_][i_]; } }
        const int nt = cur.nt;
        for (int t = 0; t < nt; t += 2) {
            const bool last = (t == nt - 2);
            const char* a1 = cA + (size_t)(t + 1) * kstep;
            const char* a2 = last ? nA : cA + (size_t)(t + 2) * kstep; const char* b2 = last ? nB : cB + (size_t)(t + 2) * kstep;
            const char* a3 = a2 + kstep; const char* b3 = b2 + kstep;
            if (last && has_next) S.a_ready(nxt);
            unsigned vA2[2][2];
            if constexpr (GATHER) { _Pragma("unroll") for (int h_ = 0; h_ < 2; ++h_) _Pragma("unroll") for (int i_ = 0; i_ < 2; ++i_) vA2[h_][i_] = last ? vAn[h_][i_] : vAc[h_][i_]; }
            PG8_LDB(B0, 0, 0); PG8_SCHED; PG8_LDA(At, 0, 0); PG8_STAGE_A(PG8_SA(1, 1), a1, 1, vAc);
            PG8_WAIT_L(8); PG8_BAR; PG8_WAIT_L(0); PG8_MMA(0, 0, At, B0); PG8_BAR; PG8_SCHED;
            PG8_LDB(B1, 0, 1); PG8_STAGE(PG8_SB(0, 0), b2, voffB);
            PG8_BAR; PG8_WAIT_L(0); PG8_MMA(0, 1, At, B1); PG8_BAR;
            PG8_LDA(At, 0, 1); PG8_STAGE_A(PG8_SA(0, 0), a2, 0, vA2);
            PG8_BAR; PG8_WAIT_L(0); PG8_MMA(1, 0, At, B0); PG8_BAR; PG8_SCHED;
            PG8_STAGE(PG8_SB(0, 1), b2 + hstep, voffB);
            PG8_WAIT_V(6); PG8_BAR; PG8_MMA(1, 1, At, B1); PG8_BAR;
            PG8_LDB(B0, 1, 0); PG8_SCHED; PG8_LDA(At, 1, 0); PG8_STAGE_A(PG8_SA(0, 1), a2, 1, vA2);
            PG8_WAIT_L(8); PG8_BAR; PG8_WAIT_L(0); PG8_MMA(0, 0, At, B0); PG8_BAR; PG8_SCHED;
            PG8_LDB(B1, 1, 1); PG8_STAGE(PG8_SB(1, 0), b3, voffB);
            PG8_BAR; PG8_WAIT_L(0); PG8_MMA(0, 1, At, B1); PG8_BAR;
            PG8_LDA(At, 1, 1); PG8_STAGE_A(PG8_SA(1, 0), a3, 0, vA2);
            PG8_BAR; PG8_WAIT_L(0); PG8_MMA(1, 0, At, B0); PG8_BAR; PG8_SCHED;
            PG8_STAGE(PG8_SB(1, 1), b3 + hstep, voffB);
            PG8_WAIT_V(6); PG8_BAR; PG8_MMA(1, 1, At, B1); PG8_BAR;
        }
        PG8_STAMP();
        if constexpr (!Epi::AFTER_DRAIN) { E(acc, cur, wr, wc, fr, fq); S.done(cur); }
        PG8_STAMP();
        if (!has_next) break;
#pragma unroll
        for (int a = 0; a < 2; ++a)
#pragma unroll
            for (int b = 0; b < 2; ++b)
#pragma unroll
                for (int m = 0; m < 4; ++m)
#pragma unroll
                    for (int n = 0; n < 2; ++n) acc[a][b][m][n] = (f32x4){0.f, 0.f, 0.f, 0.f};
        cur = nxt; cA = nA; cB = nB; ++ui;
        if constexpr (GATHER) { _Pragma("unroll") for (int h_ = 0; h_ < 2; ++h_) _Pragma("unroll") for (int i_ = 0; i_ < 2; ++i_) vAc[h_][i_] = vAn[h_][i_]; }
    }
    PG8_WAIT_V(0);
    if (wr == 0) PG8_BAR;
    PG8_BAR;
    if constexpr (Epi::AFTER_DRAIN) { E.fused(acc, cur, wr, wc, fr, fq, lds, wid, lane); S.done(cur); }
    PG8_STAMP();
    if (STAMP && wid == 0) { stamps[lane] = lane < nts ? (((unsigned long long)(unsigned)ts_hi << 32) | (unsigned)ts_lo) : 0ull;
        if (lane == 62) stamps[62] = rt_entry; if (lane == 63) stamps[63] = (unsigned long long)wall_clock64(); }
#undef PG8_STAMP
#undef PG8_SA
#undef PG8_SB
#undef PG8_STAGE
#undef PG8_STAGE_A
#undef PG8_GVOFF
#undef PG8_LDA
#undef PG8_LDB
#undef PG8_MMA
#undef PG8_WAIT_V
#undef PG8_WAIT_L
#undef PG8_BAR
#undef PG8_SCHED
}
}
typedef unsigned short bf16;
typedef float f32x4 __attribute__((ext_vector_type(4)));
typedef short bf16x8 __attribute__((ext_vector_type(8)));
typedef short s16x4 __attribute__((ext_vector_type(4)));
typedef unsigned u32x4 __attribute__((ext_vector_type(4)));
typedef unsigned u32x2 __attribute__((ext_vector_type(2)));
constexpr int NB = 16, SEQ = 2048, DM = 1024, CTXL = 256, NLAYER = 2;
constexpr int NGRP = 2, BG = NB / NGRP;
constexpr int LATG = BG * SEQ, CTXG = BG * CTXL, RG = LATG + CTXG;
constexpr int NIN = 7168, DFF = 2816, DFE = 3584, NEXP = 8, NMOD = 6 * DM;
constexpr int NHEAD = 16, HD = 64;
constexpr int MOE_TILES_MAX = 136, MOE_ROWS_MAX = MOE_TILES_MAX * 256;
constexpr float EPS = 1e-6f;
constexpr int NWAVES = 8, NTHR = 512;
constexpr size_t MiB = 1u << 20;
constexpr size_t WS_CTL = 0, CTL_ZERO_BYTES = 64 * 1024;
constexpr size_t WS_MOD = 1 * MiB;
constexpr size_t WS_MISC = 2 * MiB;
constexpr size_t WS_XC = 4 * MiB;
constexpr size_t WS_WIN = 20 * MiB;
constexpr size_t WS_WRO = 48 * MiB, WS_WNO = 52 * MiB, WS_WOUT = 56 * MiB;
constexpr size_t WS_WF13 = 60 * MiB;
constexpr size_t WS_WF2 = 71 * MiB;
constexpr size_t WS_WM13 = 77 * MiB;
constexpr size_t WS_WM2 = 189 * MiB;
constexpr size_t WS_ARENA = 245 * MiB;
constexpr size_t SLAB = (size_t)RG * DM * 2;
static_assert(SLAB == 36 * MiB, "slab");
constexpr size_t A_H = WS_ARENA + 0 * SLAB;
constexpr size_t A_XR = WS_ARENA + 1 * SLAB;
constexpr size_t A_KB = WS_ARENA + 2 * SLAB;
constexpr size_t A_VT = WS_ARENA + 3 * SLAB;
constexpr size_t A_YG = WS_ARENA + 4 * SLAB;
constexpr size_t A_QB = WS_ARENA + 5 * SLAB;
constexpr size_t A_SR = WS_ARENA + 6 * SLAB;
constexpr size_t A_SN = WS_ARENA + 7 * SLAB;
constexpr size_t A_YN = WS_ARENA + 8 * SLAB;
constexpr size_t A_T1 = WS_ARENA + 9 * SLAB;
constexpr size_t A_H2 = WS_ARENA, A_ACT = WS_ARENA + 72 * MiB;
constexpr size_t A_AM = WS_ARENA;
constexpr size_t A_ACTM = WS_ARENA + 68 * MiB;
constexpr size_t A_Y = WS_ARENA + 306 * MiB;
constexpr size_t A_YPART = A_AM + 36 * MiB;
static_assert(A_YPART >= WS_ARENA + SLAB && A_YPART + (size_t)7 * 8 * 256 * DM * 2 <= A_ACTM, "partial-output buffer");
constexpr size_t A_H2M = A_Y;
constexpr size_t WS_END = WS_ARENA + 374 * MiB;
static_assert((size_t)MOE_ROWS_MAX * DM * 2 == 68 * MiB && (size_t)MOE_ROWS_MAX * DFE * 2 == 238 * MiB, "moe map");
static_assert(A_T1 + SLAB <= WS_END && A_ACT + (size_t)2 * RG * DFF * 2 <= WS_END, "mixer / ffn map");
constexpr size_t MS_TOFF = 0;
constexpr size_t MS_CNT = 4096;
constexpr size_t MS_ROUTE_E = 16384;
constexpr size_t MS_ROUTE_W = 16384 + 65536;
constexpr size_t MS_TOKSLOT = MS_ROUTE_W + 131072;
constexpr size_t MS_SLOTW = MS_TOKSLOT + 131072;
constexpr size_t MS_ROWMAP = MS_SLOTW + (size_t)MOE_ROWS_MAX * 4;
static_assert(MS_ROWMAP + MOE_ROWS_MAX * 4 <= 2 * MiB, "misc map");
constexpr int CW_BAR = 1024;
static_assert((CW_BAR + XCD_BAR_WORDS) * 4 <= (int)CTL_ZERO_BYTES, "ctl");
constexpr int XS_LD = 2 * DM;
constexpr int MOE_GATHER_UNITS = 15;
static_assert(MOE_TILES_MAX * 28 <= MOE_GATHER_UNITS * 256, "MoE up units per workgroup");
constexpr int RING_BYTES = 131072, LDS_BYTES = 147456, MISC_OFF = LDS_BYTES - 64;
static_assert(RING_BYTES + MOE_GATHER_UNITS * 1024 <= MISC_OFF, "gather map in LDS");

__device__ __forceinline__ unsigned pk2(float lo, float hi) { unsigned r; asm("v_cvt_pk_bf16_f32 %0, %1, %2" : "=v"(r) : "v"(lo), "v"(hi)); return r; }
__device__ __forceinline__ unsigned f2bf(float f) { return pk2(f, f) & 0xffffu; }
__device__ __forceinline__ float bf2f(unsigned short b) { return __builtin_bit_cast(float, ((unsigned)b) << 16); }
__device__ __forceinline__ float bflo(unsigned w) { return __builtin_bit_cast(float, w << 16); }
__device__ __forceinline__ float bfhi(unsigned w) { return __builtin_bit_cast(float, w & 0xffff0000u); }
#define SHX(x, m) __builtin_bit_cast(float, __builtin_amdgcn_ds_bpermute(((lane) ^ (m)) << 2, __builtin_bit_cast(int, (float)(x))))
#define SHUP(x, d) __builtin_bit_cast(float, __builtin_amdgcn_ds_bpermute(((lane) >= (d) ? (lane) - (d) : (lane)) << 2, __builtin_bit_cast(int, (float)(x))))
__device__ __forceinline__ int lane_id_fresh() { int l; asm volatile("v_mbcnt_lo_u32_b32 %0, -1, 0\n\tv_mbcnt_hi_u32_b32 %0, -1, %0" : "=v"(l)); return l; }
__device__ __forceinline__ float wave_sum(float v, int lane) {
#pragma unroll
    for (int o = 1; o < 64; o <<= 1) v += SHX(v, o);
    return v;
}
__device__ __forceinline__ float sigmoidf_(float x) { return __builtin_amdgcn_rcpf(1.0f + __builtin_amdgcn_exp2f(-1.44269504f * x)); }
__device__ __forceinline__ float siluf_(float x) { return x * sigmoidf_(x); }
__device__ __forceinline__ float gelu_tanh_(float x) { const float u = 0.7978845608f * (x + 0.044715f * x * x * x); return x * sigmoidf_(2.0f * u); }
#define LDS_WAIT() asm volatile("s_waitcnt lgkmcnt(0)" ::: "memory")

struct Args { const float* in[25]; float* out; unsigned char* ws; int ph_lo, ph_hi; };
enum { I_X = 0, I_C, I_CTX, I_CCTX, I_WMOD, I_BMOD, I_WIN, I_CONVW, I_CONVB, I_LAM, I_RGW, I_RGB, I_QG, I_KG, I_RPB, I_WRO, I_WNO, I_WOUT, I_F1, I_F3, I_F2, I_ROUTER, I_M1, I_M3, I_M2 };

__device__ __forceinline__ int map_row(int mode, int n) {
    if (mode == 1) { const int t = n >> 8, cl = n & 255, wc = cl >> 6, bj = (cl >> 5) & 1, j = cl & 31; return (t << 8) + 128 * bj + 32 * wc + j; }
    if (mode == 2) return ((n >> 7) << 8) + (n & 127);
    if (mode == 3) return ((n >> 7) << 8) + 128 + (n & 127);
    return n;
}
struct TItem { const float* src; bf16* dst; int K, N, mode, k0, n0; };
__device__ __forceinline__ TItem titem(const float* W, int K, int N, bf16* WT, int mode, int tile, int k, int w) { const int n8 = N / 256, kb = 4 * (tile / n8) + k, nb = 8 * (tile % n8) + w; return TItem{W, WT, K, N, mode, 64 * kb, 32 * nb}; }
__device__ __forceinline__ void titem_load(const TItem& d, f32x4 (&t)[8], int lane) {
#pragma unroll
    for (int i = 0; i < 8; ++i) t[i] = *(const f32x4*)(d.src + (size_t)(d.k0 + 8 * i + (lane >> 3)) * d.N + d.n0 + 4 * (lane & 7));
}
__device__ __forceinline__ void titem_finish(const TItem& d, const f32x4 (&t)[8], float* scr, int lane) {
#pragma unroll
    for (int i = 0; i < 8; ++i) { float* p = scr + (8 * i + (lane >> 3)) * 33 + 4 * (lane & 7); p[0] = t[i].x; p[1] = t[i].y; p[2] = t[i].z; p[3] = t[i].w; }
    LDS_WAIT(); asm volatile("" ::: "memory");
    const int c = lane & 7; const float sc = d.mode == 2 ? -1.44269504f : 1.0f;
#pragma unroll
    for (int j = 0; j < 4; ++j) { const int n = (lane >> 3) + 8 * j; const float* s = scr + (8 * c) * 33 + n;
        u32x4 o; o.x = pk2(s[0 * 33] * sc, s[1 * 33] * sc); o.y = pk2(s[2 * 33] * sc, s[3 * 33] * sc); o.z = pk2(s[4 * 33] * sc, s[5 * 33] * sc); o.w = pk2(s[6 * 33] * sc, s[7 * 33] * sc);
        *(u32x4*)(d.dst + (size_t)map_row(d.mode, d.n0 + n) * d.K + d.k0 + 8 * c) = o; }
    LDS_WAIT(); asm volatile("" ::: "memory");
}
constexpr int TL_IN = (DM / 256) * (NIN / 256), TL_SQ = (DM / 256) * (DM / 256), TL_F1 = (DM / 256) * (DFF / 256), TL_F2 = (DFF / 256) * (DM / 256), TL_M1 = (DM / 256) * (DFE / 256), TL_M2 = (DFE / 256) * (DM / 256);
constexpr int NT_IN = 2 * TL_IN, NT_SQ = 6 * TL_SQ, NT_F = 2 * TL_F1 + TL_F2, NT_M13 = 16 * TL_M1, NT_MOE = NT_M13 + 8 * TL_M2, NT_EAGER = NT_IN + NT_SQ + NT_F, NTILES = NT_EAGER + NT_MOE;
static_assert(NIN % 256 == 0 && DFF % 256 == 0 && DFE % 256 == 0 && DM % 256 == 0, "conversion tiles");
__device__ __forceinline__ TItem conv_item(const Args& a, int r, int k, int w) {
    unsigned char* ws = a.ws;
    if (r < NT_IN) { const int l = r / TL_IN; return titem(a.in[I_WIN] + (size_t)l * DM * NIN, DM, NIN, (bf16*)(ws + WS_WIN) + (size_t)l * NIN * DM, 1, r % TL_IN, k, w); } r -= NT_IN;
    if (r < NT_SQ) { const int m = r / TL_SQ, which = m >> 1, l = m & 1; const float* s0 = a.in[I_WRO]; const float* s1 = a.in[I_WNO]; const float* s2 = a.in[I_WOUT];
        const float* src = (which == 0 ? s0 : (which == 1 ? s1 : s2)) + (size_t)l * DM * DM;
        bf16* dst = (bf16*)(ws + (which == 0 ? WS_WRO : (which == 1 ? WS_WNO : WS_WOUT))) + (size_t)l * DM * DM; return titem(src, DM, DM, dst, 0, r % TL_SQ, k, w); } r -= NT_SQ;
    if (r < NT_F) { if (r < TL_F1) return titem(a.in[I_F1], DM, DFF, (bf16*)(ws + WS_WF13), 2, r, k, w);
        if (r < 2 * TL_F1) return titem(a.in[I_F3], DM, DFF, (bf16*)(ws + WS_WF13), 3, r - TL_F1, k, w);
        return titem(a.in[I_F2], DFF, DM, (bf16*)(ws + WS_WF2), 0, r - 2 * TL_F1, k, w); } r -= NT_F;
    if (r < NT_M13) { const int m = r / TL_M1, e = m >> 1, up = m & 1; const float* s1 = a.in[I_M1]; const float* s3 = a.in[I_M3];
        return titem((up ? s3 : s1) + (size_t)e * DM * DFE, DM, DFE, (bf16*)(ws + WS_WM13) + (size_t)e * 2 * DFE * DM, up ? 3 : 2, r % TL_M1, k, w); } r -= NT_M13;
    { const int e = r / TL_M2; return titem(a.in[I_M2] + (size_t)e * DFE * DM, DFE, DM, (bf16*)(ws + WS_WM2) + (size_t)e * DM * DFE, 0, r % TL_M2, k, w); }
}
constexpr int NT_DEFER = TL_IN + 3 * TL_SQ, NT_PRO = NT_EAGER - NT_DEFER;
static_assert(NT_DEFER == 160 && 144 * 22 - 12 * 256 == 256 - NT_DEFER, "deferred layer-1 weight tiles = workgroups idle in the FFN up GEMM's last round");
__device__ __forceinline__ int deferred_tile(int d) { if (d < TL_IN) return TL_IN + d; d -= TL_IN; return NT_IN + (2 * (d / TL_SQ) + 1) * TL_SQ + d % TL_SQ; }
__device__ __forceinline__ int eager_tile(int e) { if (e < TL_IN) return e; e -= TL_IN; if (e < 3 * TL_SQ) return NT_IN + 2 * (e / TL_SQ) * TL_SQ + e % TL_SQ; return NT_IN + NT_SQ + (e - 3 * TL_SQ); }
__device__ __forceinline__ void conv_tile(const Args& a, float* scr, int tile, int wave, int lane) {
    f32x4 t[4][8]; TItem d[4];
#pragma unroll
    for (int k = 0; k < 4; ++k) { d[k] = conv_item(a, tile, k, wave); titem_load(d[k], t[k], lane); }
#pragma unroll
    for (int k = 0; k < 4; ++k) titem_finish(d[k], t[k], scr, lane);
}
static_assert(NT_MOE == 6 * 224, "lazy MoE conversion slices");
__device__ __forceinline__ void moe_convert_slice(const Args& a, unsigned char* lds, int s, int blk, int wave, int lane) {
    if (blk < 32) return;
    conv_tile(a, (float*)(lds + wave * 16384), NT_EAGER + s * 224 + (blk - 32), wave, lane);
}
__device__ __forceinline__ void phase_prologue(const Args& a, unsigned char* lds, int blk, int G, int wave, int lane, int tid, bool lazy_moe) {
    unsigned char* ws = a.ws;
    float* scr = (float*)(lds + wave * 16384);
    if (lazy_moe) { for (int e = blk; e < NT_PRO; e += G) conv_tile(a, scr, eager_tile(e), wave, lane); }
    else { for (int t = blk; t < NTILES; t += G) conv_tile(a, scr, t, wave, lane); }
    __syncthreads();
    float* sc = (float*)lds;
    float* red = (float*)(lds + 17 * 1024 * 4);
    bool have = false;
    for (int u = lazy_moe ? blk - 64 : blk; u < 2 * (NMOD / 64); u += G) {
        if (u < 0) continue;
        if (!have) {
            const f32x4* c4 = (const f32x4*)a.in[I_C]; const f32x4* cc4 = (const f32x4*)a.in[I_CCTX]; f32x4 tv[9];
#pragma unroll
            for (int k = 0; k < 9; ++k) { const int idx = tid + NTHR * k; tv[k] = (f32x4){0.f, 0.f, 0.f, 0.f}; if (idx < 17 * 256) tv[k] = idx < 16 * 256 ? c4[idx] : cc4[idx - 16 * 256]; }
#pragma unroll
            for (int k = 0; k < 9; ++k) { const int idx = tid + NTHR * k; if (idx < 17 * 256) ((f32x4*)sc)[idx] = (f32x4){siluf_(tv[k].x), siluf_(tv[k].y), siluf_(tv[k].z), siluf_(tv[k].w)}; }
            have = true; }
        __syncthreads();
        const int l = u / (NMOD / 64), n0 = (u % (NMOD / 64)) * 64;
        const float* wm = a.in[I_WMOD] + (size_t)l * DM * NMOD + n0 + lane;
        float acc[17];
#pragma unroll
        for (int r = 0; r < 17; ++r) acc[r] = 0.f;
        for (int k0 = wave * 128; k0 < wave * 128 + 128; k0 += 16) { float w[16];
#pragma unroll
            for (int i = 0; i < 16; ++i) w[i] = wm[(size_t)(k0 + i) * NMOD];
#pragma unroll
            for (int i = 0; i < 16; ++i)
#pragma unroll
                for (int r = 0; r < 17; ++r) acc[r] += sc[r * 1024 + k0 + i] * w[i]; }
#pragma unroll
        for (int r = 0; r < 17; ++r) red[(wave * 17 + r) * 64 + lane] = acc[r];
        __syncthreads();
        for (int i = tid; i < 17 * 64; i += NTHR) { const int r = i >> 6, c = i & 63; float s = 0.f;
#pragma unroll
            for (int w = 0; w < 8; ++w) s += red[(w * 17 + r) * 64 + c];
            ((float*)(ws + WS_MOD))[((size_t)l * 17 + r) * NMOD + n0 + c] = s + a.in[I_BMOD][l * NMOD + n0 + c]; }
    }
    __syncthreads();
}

#define DPP_ADD_(v, ctrl, rmask) v += __builtin_bit_cast(float, __builtin_amdgcn_update_dpp(0, __builtin_bit_cast(int, v), ctrl, rmask, 0xf, false))
__device__ __forceinline__ float wave_sum_dpp(float v) {
    DPP_ADD_(v, 0x111, 0xf); DPP_ADD_(v, 0x112, 0xf); DPP_ADD_(v, 0x114, 0xf); DPP_ADD_(v, 0x118, 0xf);
    DPP_ADD_(v, 0x142, 0xa); DPP_ADD_(v, 0x143, 0xc);
    return __builtin_bit_cast(float, __builtin_amdgcn_readlane(__builtin_bit_cast(int, v), 63));
}
template <bool ROUTE, bool XBF, bool CP = false>
__device__ __forceinline__ void modulate_rows(const void* __restrict__ xl_, const void* __restrict__ xc_, int nlat, int mbase, const float* __restrict__ modl, int shoff, bf16* __restrict__ out,
                                              int r0, int n, int lane, const float* __restrict__ router, int* __restrict__ re, float* __restrict__ rw, int* cntl, const bf16* __restrict__ cpart = nullptr) {
    if (n <= 0) return;
    f32x4 rt[ROUTE ? 32 : 1];
    if (ROUTE) {
#pragma unroll
        for (int j = 0; j < 4; ++j)
#pragma unroll
            for (int i = 0; i < 4; ++i) { const int col = 4 * lane + 256 * j + i; rt[2 * (4 * j + i)] = *(const f32x4*)(router + col * 8); rt[2 * (4 * j + i) + 1] = *(const f32x4*)(router + col * 8 + 4); } }
    typedef typename std::conditional<XBF, u32x2, f32x4>::type rowv;
    constexpr size_t XLD = XBF ? (size_t)XS_LD * 2 : (size_t)DM * 4;
    const unsigned char* xl = (const unsigned char*)xl_; const unsigned char* xc = (const unsigned char*)xc_;
    rowv vn[4]; f32x4 s4[4], h4[4];
    { const rowv* p = (const rowv*)(r0 >= nlat ? xc + (size_t)(r0 - nlat) * XLD : xl + (size_t)r0 * XLD);
#pragma unroll
      for (int j = 0; j < 4; ++j) vn[j] = p[lane + 64 * j]; }
    u32x2 pv[CP ? 4 : 1][4];
    if constexpr (CP) { if (r0 >= nlat) {
#pragma unroll
        for (int p = 0; p < 4; ++p) { const u32x2* q = (const u32x2*)(cpart + (size_t)(4 * (r0 - nlat) + p) * XS_LD + DM);
#pragma unroll
            for (int j = 0; j < 4; ++j) pv[p][j] = q[lane + 64 * j]; } } }
    int mprev = -1;
    auto process = [&](f32x4 (&v)[4], const int r) __attribute__((always_inline)) {
        const int mrow = r >= nlat ? 16 : mbase + r / SEQ;
        if (mrow != mprev) { mprev = mrow; const f32x4* hp = (const f32x4*)(modl + (size_t)mrow * NMOD + (size_t)shoff * DM); const f32x4* sp = hp + DM / 4;
#pragma unroll
            for (int j = 0; j < 4; ++j) { s4[j] = sp[lane + 64 * j] + 1.0f; h4[j] = hp[lane + 64 * j]; } }
        float ss = 0.f;
#pragma unroll
        for (int j = 0; j < 4; ++j) ss += (v[j].x * v[j].x + v[j].y * v[j].y) + (v[j].z * v[j].z + v[j].w * v[j].w);
        ss = wave_sum_dpp(ss);
        const float rinv = __builtin_amdgcn_rsqf(ss * (1.0f / DM) + EPS);
#pragma unroll
        for (int j = 0; j < 4; ++j) v[j] = v[j] * rinv * s4[j] + h4[j];
        unsigned long long* o8 = (unsigned long long*)(out + (size_t)r * DM) + lane;
#pragma unroll
        for (int j = 0; j < 4; ++j) o8[64 * j] = (unsigned long long)pk2(v[j].x, v[j].y) | ((unsigned long long)pk2(v[j].z, v[j].w) << 32);
        if (ROUTE) {
            float lg[8];
#pragma unroll
            for (int e = 0; e < 8; ++e) lg[e] = 0.f;
#pragma unroll
            for (int j = 0; j < 4; ++j)
#pragma unroll
                for (int k = 0; k < 4; ++k) { const f32x4 q0 = rt[2 * (4 * j + k)], q1 = rt[2 * (4 * j + k) + 1]; const float x = v[j][k];
                    lg[0] += x * q0.x; lg[1] += x * q0.y; lg[2] += x * q0.z; lg[3] += x * q0.w; lg[4] += x * q1.x; lg[5] += x * q1.y; lg[6] += x * q1.z; lg[7] += x * q1.w; }
#pragma unroll
            for (int e = 0; e < 8; ++e) lg[e] = wave_sum_dpp(lg[e]);
            int e0 = 0; float v0 = lg[0];
#pragma unroll
            for (int e = 1; e < 8; ++e) if (lg[e] > v0) { v0 = lg[e]; e0 = e; }
            int e1 = -1; float v1 = -3.0e38f;
#pragma unroll
            for (int e = 0; e < 8; ++e) if (e != e0 && lg[e] > v1) { v1 = lg[e]; e1 = e; }
            const float w0 = 1.0f / (1.0f + __expf(v1 - v0));
            if (lane == 0) { re[r] = e0 | (e1 << 8); rw[2 * r] = w0; rw[2 * r + 1] = 1.0f - w0; atomicAdd(&cntl[e0], 1); atomicAdd(&cntl[e1], 1); }
        }
    };
    auto row_ptr = [&](const int r) __attribute__((always_inline)) { return (const rowv*)(r >= nlat ? xc + (size_t)(r - nlat) * XLD : xl + (size_t)r * XLD); };
    if constexpr (CP) {
        for (int i = 0; i < n; ++i) {
            const int r = r0 + i;
            f32x4 v[4];
#pragma unroll
            for (int j = 0; j < 4; ++j) { if constexpr (XBF) v[j] = (f32x4){bflo(vn[j].x), bfhi(vn[j].x), bflo(vn[j].y), bfhi(vn[j].y)}; else v[j] = vn[j]; }
            if (r >= nlat) {
#pragma unroll
                for (int p = 0; p < 4; ++p)
#pragma unroll
                    for (int j = 0; j < 4; ++j) { v[j].x += bflo(pv[p][j].x); v[j].y += bfhi(pv[p][j].x); v[j].z += bflo(pv[p][j].y); v[j].w += bfhi(pv[p][j].y); } }
            if (i + 1 < n) { const int rn = r + 1; const rowv* p = row_ptr(rn);
#pragma unroll
                for (int j = 0; j < 4; ++j) vn[j] = p[lane + 64 * j];
                if (rn >= nlat) {
#pragma unroll
                    for (int p2 = 0; p2 < 4; ++p2) { const u32x2* q = (const u32x2*)(cpart + (size_t)(4 * (rn - nlat) + p2) * XS_LD + DM);
#pragma unroll
                        for (int j = 0; j < 4; ++j) pv[p2][j] = q[lane + 64 * j]; } } }
            process(v, r);
        }
    } else {
        rowv vm[4];
        if (n > 1) { const rowv* p = row_ptr(r0 + 1);
#pragma unroll
            for (int j = 0; j < 4; ++j) vm[j] = p[lane + 64 * j]; }
        for (int i = 0; i < n; i += 2) {
            { f32x4 v[4];
#pragma unroll
              for (int j = 0; j < 4; ++j) { if constexpr (XBF) v[j] = (f32x4){bflo(vn[j].x), bfhi(vn[j].x), bflo(vn[j].y), bfhi(vn[j].y)}; else v[j] = vn[j]; }
              if (i + 2 < n) { const rowv* p = row_ptr(r0 + i + 2);
#pragma unroll
                  for (int j = 0; j < 4; ++j) vn[j] = p[lane + 64 * j]; }
              process(v, r0 + i); }
            if (i + 1 < n) { f32x4 v[4];
#pragma unroll
              for (int j = 0; j < 4; ++j) { if constexpr (XBF) v[j] = (f32x4){bflo(vm[j].x), bfhi(vm[j].x), bflo(vm[j].y), bfhi(vm[j].y)}; else v[j] = vm[j]; }
              if (i + 3 < n) { const rowv* p = row_ptr(r0 + i + 3);
#pragma unroll
                  for (int j = 0; j < 4; ++j) vm[j] = p[lane + 64 * j]; }
              process(v, r0 + i + 1); }
        }
    }
}
#ifndef RECT_GH
#define RECT_GH 8
#endif
__device__ __forceinline__ void rect_unit(int L, int nM, int nN, int& pm, int& pn) {
    const int per = RECT_GH * nN, gid = L / per, fm = gid * RECT_GH, gs = (nM - fm) < RECT_GH ? (nM - fm) : RECT_GH, rem = L - gid * per;
    pm = fm + rem % gs; pn = rem / gs;
}
__device__ __forceinline__ int xcd_remap(int L, int nU) { const int q = nU >> 3, r = nU & 7, xcd = L & 7, off = L >> 3; return (xcd < r ? xcd * (q + 1) : r * (q + 1) + (xcd - r) * q) + off; }
struct RectOrder {
    int nM0, nN0, nM1, nN1, G, c, ntk;
    __device__ __forceinline__ bool next(int i, pg8::Unit& u) const {
        const int n0 = nM0 * nN0, nU = n0 + nM1 * nN1; int L = i * G + c;
        if (L >= nU) return false;
        L = xcd_remap(L, nU); u.koff = 0; u.nt = ntk;
        if (L < n0) { rect_unit(L, nM0, nN0, u.pm, u.pn); return true; }
        rect_unit(L - n0, nM1, nN1, u.pm, u.pn); u.pm += nM0; return true;
    }
    __device__ __forceinline__ void a_ready(const pg8::Unit&) const {}
    __device__ __forceinline__ void done(const pg8::Unit&) const {}
};
struct MoeOrder {
    int nT, nN, G, c, t1, t2, t3, t4, t5, t6, t7, ntk;
    __device__ __forceinline__ bool next(int i, pg8::Unit& u) const {
        const int nU = nT * nN; int L = i * G + c; if (L >= nU) return false;
        L = xcd_remap(L, nU); u.koff = 0; u.nt = ntk;
        int pm, pn; rect_unit(L, nT, nN, pm, pn);
        const int e = (pm >= t1) + (pm >= t2) + (pm >= t3) + (pm >= t4) + (pm >= t5) + (pm >= t6) + (pm >= t7);
        u.pm = pm; u.pn = e * nN + pn; return true;
    }
    __device__ __forceinline__ void a_ready(const pg8::Unit&) const {}
    __device__ __forceinline__ void done(const pg8::Unit&) const {}
};

constexpr int MOE_MAIN_TILES = 128, MOE_KS = 7, MOE_KS_TILES = 8;
struct MoeDownOrder {
    int nT, G, c, t1, t2, t3, t4, t5, t6, t7;
    __device__ __forceinline__ int expert(int pm) const { return (pm >= t1) + (pm >= t2) + (pm >= t3) + (pm >= t4) + (pm >= t5) + (pm >= t6) + (pm >= t7); }
    __device__ __forceinline__ bool next(int i, pg8::Unit& u) const {
        const int Tm = nT < MOE_MAIN_TILES ? nT : MOE_MAIN_TILES, nmain = Tm * 4; int L = i * G + c;
        if (L < nmain) { L = xcd_remap(L, nmain); int pm, pn; rect_unit(L, Tm, 4, pm, pn); u.pm = pm; u.pn = expert(pm) * 4 + pn; u.koff = 0; u.nt = DFE / 64; return true; }
        const int j = L - nmain, novf = (nT - Tm) * 4 * MOE_KS; if (j >= novf) return false;
        const int ks = j % MOE_KS, pn = (j / MOE_KS) & 3, pm = MOE_MAIN_TILES + j / (4 * MOE_KS);
        u.pm = pm; u.pn = expert(pm) * 4 + pn; u.koff = ks * MOE_KS_TILES * 64 * 2; u.nt = MOE_KS_TILES; return true;
    }
    __device__ __forceinline__ void a_ready(const pg8::Unit&) const {}
    __device__ __forceinline__ void done(const pg8::Unit&) const {}
};
static_assert(MOE_KS * MOE_KS_TILES * 64 == DFE, "MoE down K split");
constexpr int FD_MAIN_TILES = 128, FD_KS = 4;
struct FfnDownOrder {
    int G, c;
    __device__ __forceinline__ bool next(int i, pg8::Unit& u) const {
        constexpr int nmain = FD_MAIN_TILES * 4; int L = i * G + c;
        if (L < nmain) { L = xcd_remap(L, nmain); rect_unit(L, FD_MAIN_TILES, 4, u.pm, u.pn); u.koff = 0; u.nt = DFF / 64; return true; }
        const int j = L - nmain; if (j >= 16 * 4 * FD_KS) return false;
        const int ks = j & 3; u.pn = (j >> 2) & 3; u.pm = FD_MAIN_TILES + (j >> 4);
        u.koff = (12 * ks - 2 * (ks >> 1) * (ks & 1)) * 64 * 2; u.nt = 12 - 2 * (ks >> 1); return true;
    }
    __device__ __forceinline__ void a_ready(const pg8::Unit&) const {}
    __device__ __forceinline__ void done(const pg8::Unit&) const {}
};
static_assert(DFF / 64 == 44 && NB * CTXL == 16 * 256 && NB * SEQ == FD_MAIN_TILES * 256, "FFN down K split");

typedef pg8::f32x4 accv;
__device__ __forceinline__ u32x4 pack8(const accv& a, const accv& b) { u32x4 w; w.x = pg8::cvt_pk_bf16(a[0], a[1]); w.y = pg8::cvt_pk_bf16(a[2], a[3]); w.z = pg8::cvt_pk_bf16(b[0], b[1]); w.w = pg8::cvt_pk_bf16(b[2], b[3]); return w; }

struct EpiIn {
    static constexpr bool PERM = true, AFTER_DRAIN = false, HAS_SWAP = true;
    unsigned char* ws; const float* qg; const float* kg;
    __device__ __forceinline__ bool swap_ab(const pg8::Unit& u) const { return (u.pn >> 2) == 2; }
    __device__ __forceinline__ void operator()(const accv (&acc)[2][2][4][2], const pg8::Unit& u, int wr, int wc, int fr_in, int fq) const {
        int fr = fr_in; asm volatile("" : "+v"(fr));
        const int part = u.pn >> 2, ht = (u.pn & 3) * 4 + wc;
        const int row0 = u.pm * 256 + wr * 64 + fr, colb = ht * 64 + 8 * fq;
        if (part == 2) {
            const bool isc = u.pm >= 64; const int bl = isc ? u.pm - 64 : (u.pm >> 3), T = isc ? CTXL : SEQ, t0 = (isc ? 0 : (u.pm & 7) * 256) + wc * 32 + 8 * fq;
            bf16* vt = (bf16*)(ws + A_VT) + (isc ? (size_t)LATG * DM : 0) + ((size_t)(bl * 16 + (u.pn & 3) * 4 + 2 * wr) * 64 + fr) * T + t0;
#pragma unroll
            for (int ai = 0; ai < 2; ++ai)
#pragma unroll
                for (int m = 0; m < 4; ++m)
#pragma unroll
                    for (int bj = 0; bj < 2; ++bj) *(u32x4*)(vt + (size_t)((m >> 1) * 64 + 32 * ai + 16 * (m & 1)) * T + 128 * bj) = pack8(acc[ai][bj][m][0], acc[ai][bj][m][1]);
            return;
        }
        bf16* dst = (bf16*)(ws + (part == 0 ? A_XR : part == 1 ? A_KB : part == 3 ? A_YG : part == 4 ? A_QB : part == 5 ? A_SR : A_SN));
        float gn[2][2][4];
        if (part == 1 || part == 4) { const float* gp = (part == 1 ? kg : qg) + 8 * fq; const float sc = (part == 4) ? 0.125f * 1.44269504f : 1.0f;
#pragma unroll
            for (int bj = 0; bj < 2; ++bj)
#pragma unroll
                for (int n = 0; n < 2; ++n)
#pragma unroll
                    for (int j = 0; j < 4; ++j) gn[bj][n][j] = gp[32 * bj + 4 * n + j] * sc; }
#pragma unroll
        for (int ai = 0; ai < 2; ++ai)
#pragma unroll
            for (int m = 0; m < 4; ++m) {
                accv v[2][2];
#pragma unroll
                for (int bj = 0; bj < 2; ++bj)
#pragma unroll
                    for (int n = 0; n < 2; ++n) v[bj][n] = acc[ai][bj][m][n];
                if (part == 1 || part == 4) {
                    float ss = 0.f;
#pragma unroll
                    for (int bj = 0; bj < 2; ++bj)
#pragma unroll
                        for (int n = 0; n < 2; ++n) ss += (v[bj][n][0] * v[bj][n][0] + v[bj][n][1] * v[bj][n][1]) + (v[bj][n][2] * v[bj][n][2] + v[bj][n][3] * v[bj][n][3]);
                    { const int lane = fq * 16 + fr; ss += SHX(ss, 16); ss += SHX(ss, 32); }
                    const float rinv = __builtin_amdgcn_rsqf(ss * (1.0f / 64.0f) + EPS);
#pragma unroll
                    for (int bj = 0; bj < 2; ++bj)
#pragma unroll
                        for (int n = 0; n < 2; ++n)
#pragma unroll
                            for (int j = 0; j < 4; ++j) v[bj][n][j] = v[bj][n][j] * rinv * gn[bj][n][j];
                } else if (part == 3) {
#pragma unroll
                    for (int bj = 0; bj < 2; ++bj)
#pragma unroll
                        for (int n = 0; n < 2; ++n)
#pragma unroll
                            for (int j = 0; j < 4; ++j) v[bj][n][j] = gelu_tanh_(v[bj][n][j]);
                } else if (part >= 5) {
#pragma unroll
                    for (int bj = 0; bj < 2; ++bj)
#pragma unroll
                        for (int n = 0; n < 2; ++n)
#pragma unroll
                            for (int j = 0; j < 4; ++j) v[bj][n][j] = sigmoidf_(v[bj][n][j]);
                }
                bf16* rowp = dst + (size_t)(row0 + ai * 128 + m * 16) * DM + colb;
#pragma unroll
                for (int bj = 0; bj < 2; ++bj) *(u32x4*)(rowp + 32 * bj) = pack8(v[bj][0], v[bj][1]);
            }
    }
};
template <int MODE> struct EpiGate {
    static constexpr bool PERM = true, AFTER_DRAIN = false, HAS_SWAP = false;
    const bf16* gate; const bf16* add; bf16* out;
    __device__ __forceinline__ void operator()(const accv (&acc)[2][2][4][2], const pg8::Unit& u, int wr, int wc, int fr_in, int fq) const {
        int fr = fr_in; asm volatile("" : "+v"(fr));
        const int row0 = u.pm * 256 + wr * 64 + fr, col0 = u.pn * 256 + wc * 32 + 8 * fq;
#pragma unroll
        for (int ai = 0; ai < 2; ++ai) {
            u32x4 gw[4][2], aw[4][2];
#pragma unroll
            for (int m = 0; m < 4; ++m)
#pragma unroll
                for (int bj = 0; bj < 2; ++bj) { const size_t ro = (size_t)(row0 + ai * 128 + m * 16) * DM + col0 + bj * 128;
                    gw[m][bj] = *(const u32x4*)(gate + ro); if (MODE == 1) aw[m][bj] = *(const u32x4*)(add + ro); }
#pragma unroll
            for (int m = 0; m < 4; ++m)
#pragma unroll
                for (int bj = 0; bj < 2; ++bj) { const size_t ro = (size_t)(row0 + ai * 128 + m * 16) * DM + col0 + bj * 128;
                    const u32x4 g = gw[m][bj];
                    accv v0 = acc[ai][bj][m][0], v1 = acc[ai][bj][m][1];
                    v0[0] *= bflo(g.x); v0[1] *= bfhi(g.x); v0[2] *= bflo(g.y); v0[3] *= bfhi(g.y); v1[0] *= bflo(g.z); v1[1] *= bfhi(g.z); v1[2] *= bflo(g.w); v1[3] *= bfhi(g.w);
                    if (MODE == 1) { const u32x4 a4 = aw[m][bj];
                        v0[0] += bflo(a4.x); v0[1] += bfhi(a4.x); v0[2] += bflo(a4.y); v0[3] += bfhi(a4.y); v1[0] += bflo(a4.z); v1[1] += bfhi(a4.z); v1[2] += bflo(a4.w); v1[3] += bfhi(a4.w); }
                    *(u32x4*)(out + ro) = pack8(v0, v1); }
            asm volatile("" ::: "memory");
        }
    }
};
template <bool INF32, bool SPLITCTX = false> struct EpiRes {
    static constexpr bool PERM = true, AFTER_DRAIN = false, HAS_SWAP = false;
    const void* xold_lat; const void* xold_ctx; bf16* xnew_lat; bf16* xnew_ctx;
    const float* modl; int gchunk; int sbase; int nlat;
    __device__ __forceinline__ void operator()(const accv (&acc)[2][2][4][2], const pg8::Unit& u, int wr, int wc, int fr_in, int fq) const {
        int fr = fr_in; asm volatile("" : "+v"(fr));
        const bool isc = u.pm >= nlat; const int mrow = isc ? 16 : (sbase + (u.pm >> 3));
        const int rbase = (isc ? (u.pm - nlat) * 256 : u.pm * 256) + wr * 64 + fr, col0 = u.pn * 256 + wc * 32 + 8 * fq;
        const bool iscp = SPLITCTX ? false : isc;
        const float* xof = (const float*)(iscp ? xold_ctx : xold_lat) + (size_t)rbase * DM + col0; const bf16* xob = (const bf16*)(iscp ? xold_ctx : xold_lat) + (size_t)rbase * XS_LD + col0;
        bf16* xn = (iscp ? xnew_ctx : xnew_lat) + (size_t)rbase * XS_LD + col0;
        const float* gp = modl + (size_t)mrow * NMOD + gchunk * DM + col0;
        accv gv[2][2];
#pragma unroll
        for (int bj = 0; bj < 2; ++bj)
#pragma unroll
            for (int n = 0; n < 2; ++n) gv[bj][n] = *(const accv*)(gp + bj * 128 + n * 4);
        if constexpr (SPLITCTX) {
            if (isc) { const int kt = u.koff >> 7, ks = (kt >= 12) + (kt >= 24) + (kt >= 34);
#pragma unroll
                for (int ai = 0; ai < 2; ++ai)
#pragma unroll
                    for (int m = 0; m < 4; ++m) { const int cr = rbase + ai * 128 + m * 16, gg = cr >> 11, cl = cr & 2047;
                        bf16* pp = xnew_lat + (size_t)(gg * LATG + 4 * cl + ks) * XS_LD + DM + col0;
#pragma unroll
                        for (int bj = 0; bj < 2; ++bj) *(u32x4*)(pp + bj * 128) = pack8(gv[bj][0] * acc[ai][bj][m][0], gv[bj][1] * acc[ai][bj][m][1]); }
                __builtin_amdgcn_s_waitcnt(0x0F70);
                return; }
        }
#pragma unroll
        for (int ai = 0; ai < 2; ++ai) {
            accv xv[4][2][2];
            if constexpr (INF32) {
#pragma unroll
                for (int m = 0; m < 4; ++m)
#pragma unroll
                    for (int bj = 0; bj < 2; ++bj)
#pragma unroll
                        for (int n = 0; n < 2; ++n) xv[m][bj][n] = *(const accv*)(xof + (size_t)(ai * 128 + m * 16) * DM + bj * 128 + n * 4);
            } else {
                u32x4 xw[4][2];
#pragma unroll
                for (int m = 0; m < 4; ++m)
#pragma unroll
                    for (int bj = 0; bj < 2; ++bj) xw[m][bj] = *(const u32x4*)(xob + (size_t)(ai * 128 + m * 16) * XS_LD + bj * 128);
#pragma unroll
                for (int m = 0; m < 4; ++m)
#pragma unroll
                    for (int bj = 0; bj < 2; ++bj) { xv[m][bj][0] = (accv){bflo(xw[m][bj].x), bfhi(xw[m][bj].x), bflo(xw[m][bj].y), bfhi(xw[m][bj].y)}; xv[m][bj][1] = (accv){bflo(xw[m][bj].z), bfhi(xw[m][bj].z), bflo(xw[m][bj].w), bfhi(xw[m][bj].w)}; }
            }
#pragma unroll
            for (int m = 0; m < 4; ++m)
#pragma unroll
                for (int bj = 0; bj < 2; ++bj) *(u32x4*)(xn + (size_t)(ai * 128 + m * 16) * XS_LD + bj * 128) = pack8(xv[m][bj][0] + gv[bj][0] * acc[ai][bj][m][0], xv[m][bj][1] + gv[bj][1] * acc[ai][bj][m][1]);
            asm volatile("" ::: "memory");
        }
        if constexpr (SPLITCTX) __builtin_amdgcn_s_waitcnt(0x0F70);
    }
};
template <bool MOE> struct EpiSwi {
    static constexpr bool PERM = true, AFTER_DRAIN = false, HAS_SWAP = false;
    bf16* out; int ldc; int nN; const float* roww;
    __device__ __forceinline__ void operator()(const accv (&acc)[2][2][4][2], const pg8::Unit& u, int wr, int wc, int fr_in, int fq) const {
        int fr = fr_in; asm volatile("" : "+v"(fr));
        const int pnl = MOE ? (u.pn % nN) : u.pn;
        const int row0 = u.pm * 256 + wr * 64 + fr, col0 = pnl * 128 + wc * 32 + 8 * fq;
        float rwv[2][4];
#pragma unroll
        for (int ai = 0; ai < 2; ++ai)
#pragma unroll
            for (int m = 0; m < 4; ++m) rwv[ai][m] = MOE ? roww[row0 + ai * 128 + m * 16] : 1.0f;
#pragma unroll
        for (int ai = 0; ai < 2; ++ai)
#pragma unroll
            for (int m = 0; m < 4; ++m) { const int row = row0 + ai * 128 + m * 16; const float rw = rwv[ai][m] * -0.69314718f;
                const pg8::f32x2 rw2 = {rw, rw}; accv v[2];
#pragma unroll
                for (int n = 0; n < 2; ++n)
#pragma unroll
                    for (int jp = 0; jp < 2; ++jp) { const pg8::f32x2 gq = {acc[ai][0][m][n][2 * jp], acc[ai][0][m][n][2 * jp + 1]}, uq = {acc[ai][1][m][n][2 * jp], acc[ai][1][m][n][2 * jp + 1]};
                        pg8::f32x2 dq = (pg8::f32x2){__builtin_amdgcn_exp2f(gq.x), __builtin_amdgcn_exp2f(gq.y)} + 1.0f;
                        const pg8::f32x2 rq = {__builtin_amdgcn_rcpf(dq.x), __builtin_amdgcn_rcpf(dq.y)}, oq = (gq * uq) * (rq * rw2);
                        v[n][2 * jp] = oq.x; v[n][2 * jp + 1] = oq.y; }
                *(u32x4*)(out + (size_t)row * ldc + col0) = pack8(v[0], v[1]); }
    }
};
struct EpiY {
    static constexpr bool PERM = true, AFTER_DRAIN = false, HAS_SWAP = false;
    bf16* out; int nN; bf16* part;
    __device__ __forceinline__ void operator()(const accv (&acc)[2][2][4][2], const pg8::Unit& u, int wr, int wc, int fr_in, int fq) const {
        int fr = fr_in; asm volatile("" : "+v"(fr));
        const int pnl = u.pn % nN, col0 = pnl * 256 + wc * 32 + 8 * fq;
        bf16* base = u.pm < MOE_MAIN_TILES ? out + (size_t)(u.pm * 256) * DM : part + ((size_t)((u.koff / (MOE_KS_TILES * 128)) * 8 + (u.pm - MOE_MAIN_TILES)) * 256) * DM;
        const int row0 = wr * 64 + fr;
#pragma unroll
        for (int ai = 0; ai < 2; ++ai)
#pragma unroll
            for (int m = 0; m < 4; ++m)
#pragma unroll
                for (int bj = 0; bj < 2; ++bj) *(u32x4*)(base + (size_t)(row0 + ai * 128 + m * 16) * DM + col0 + bj * 128) = pack8(acc[ai][bj][m][0], acc[ai][bj][m][1]);
    }
};
constexpr int RL_XRAW = 0, RL_XCB = 33792, RL_XCF = 70656, RL_WAGG = 104448, RL_HB = RL_WAGG + 2048, RL_HB_LD = 36, RL_END = RL_HB + 2 * 128 * RL_HB_LD * 4;
static_assert(RL_END <= MISC_OFF, "RG-LRU LDS map");
struct RlStep { int L, rowbase, tlo; bool store, comb; };
__device__ __forceinline__ RlStep rl_step(int st, int dirw, int bl, bool ctx_out) {
    RlStep s; const int seq = st >= 2, ch = seq ? st - 2 : st, nst = seq ? 16 : 2;
    s.L = seq ? SEQ : CTXL; s.rowbase = seq ? bl * SEQ : LATG + bl * CTXL;
    s.tlo = dirw ? s.L - 128 * (ch + 1) : 128 * ch;
    s.store = seq || ctx_out; s.comb = ch >= nst / 2; return s;
}
#define LDS_BARRIER() asm volatile("s_waitcnt lgkmcnt(0)\n\ts_barrier" ::: "memory")
__device__ __forceinline__ void rglru_unit(const Args& a, unsigned char* lds, int l, int unit, bool ctx_out, int wave, int lane_in, int tid_in) {
    int lane = lane_in, tid = tid_in; asm volatile("" : "+v"(lane), "+v"(tid));
    unsigned char* ws = a.ws;
    const int bl = unit >> 5, n = (unit >> 1) & 15, hf = unit & 1;
    const bf16* XR = (const bf16*)(ws + A_XR); bf16* YR = (bf16*)(ws + A_H); const bf16* YG = (const bf16*)(ws + A_YG);
    const int col = lane & 15, quad = lane >> 4, dirw = wave >> 2, wd = wave & 3, td = tid & 255;
    bf16* xraw = (bf16*)(lds + RL_XRAW) + dirw * 132 * 64;
    bf16* xcb = (bf16*)(lds + RL_XCB) + dirw * 128 * 72;
    float* wagg = (float*)(lds + RL_WAGG) + dirw * 256;
    float* hb = (float*)(lds + RL_HB) + dirw * 128 * RL_HB_LD;
    __syncthreads();
    const int cp = td & 31, tg = td >> 5;
    pg8::f32x2 cwv[4], cbv;
    { const float* cbp = a.in[I_CONVB] + (size_t)l * DM + 64 * n + 2 * cp; cbv = (pg8::f32x2){cbp[0], cbp[1]};
#pragma unroll
      for (int j = 0; j < 4; ++j) { const float* cwp = a.in[I_CONVW] + (size_t)l * 4 * DM + j * DM + 64 * n + 2 * cp; cwv[j] = (pg8::f32x2){cwp[0], cwp[1]}; } }
    bf16x8 Bf[2][2][2];
#pragma unroll
    for (int gt = 0; gt < 2; ++gt)
#pragma unroll
        for (int nb = 0; nb < 2; ++nb)
#pragma unroll
            for (int ks = 0; ks < 2; ++ks) { const float* wp = a.in[I_RGW] + ((size_t)((((l * 2 + dirw) * 2 + gt) * 16 + n) * 64 + 32 * ks + 8 * quad)) * 64 + 32 * hf + 16 * nb + col;
                const float sg = -1.44269504f;
                u32x4 w; w.x = pk2(wp[0] * sg, wp[64] * sg); w.y = pk2(wp[128] * sg, wp[192] * sg); w.z = pk2(wp[256] * sg, wp[320] * sg); w.w = pk2(wp[384] * sg, wp[448] * sg); Bf[gt][nb][ks] = __builtin_bit_cast(bf16x8, w); }
    float b0[2], b1[2], c8[2], hin[2];
#pragma unroll
    for (int nb = 0; nb < 2; ++nb) { const int c = 64 * n + 32 * hf + 16 * nb + col;
        b0[nb] = -1.44269504f * a.in[I_RGB][((l * 2 + dirw) * 2 + 0) * DM + c]; b1[nb] = -1.44269504f * a.in[I_RGB][((l * 2 + dirw) * 2 + 1) * DM + c];
        const float lam = a.in[I_LAM][(l * 2 + dirw) * DM + c]; c8[nb] = 8.0f * (fminf(lam, 0.f) - log1pf(__expf(-fabsf(lam)))); hin[nb] = 0.f; }
    const pg8::f32x2 c8v = {1.44269504f * c8[0], 1.44269504f * c8[1]};
    u32x4 xr[5];
#define RL_FETCH(S_) do { _Pragma("unroll") for (int i = 0; i < 5; ++i) { const int c = td + 256 * i, row = c >> 3, part = c & 7, t = (S_).tlo - 2 + row; \
        xr[i] = (u32x4){0u, 0u, 0u, 0u}; if (row < 131 && t >= 0 && t < (S_).L) xr[i] = *(const u32x4*)(XR + (unsigned)(((S_).rowbase + t) * DM + 64 * n + 8 * part)); } } while (0)
#define RL_PUT() do { _Pragma("unroll") for (int i = 0; i < 5; ++i) { const int c = td + 256 * i; if (c < 131 * 8) *(u32x4*)(xraw + c * 8) = xr[i]; } } while (0)
#define RL_CONV() do { const int rlo = dirw ? 112 - 16 * tg : 16 * tg; pg8::f32x2 xv[19]; \
        _Pragma("unroll") for (int i = 0; i < 19; ++i) { const unsigned w_ = *(const unsigned*)(xraw + (rlo + i) * 64 + 2 * cp); xv[i] = (pg8::f32x2){bflo(w_), bfhi(w_)}; } \
        unsigned pk_[16]; \
        _Pragma("unroll") for (int i = 0; i < 16; ++i) { pg8::f32x2 v_ = cbv; \
            _Pragma("unroll") for (int j = 0; j < 4; ++j) v_ += cwv[j] * xv[i + j]; \
            pk_[i] = pk2(v_.x, v_.y); } \
          \
        if (dirw) { bf16* pb_ = xcb + (16 * tg + 15) * 72 + 2 * cp; _Pragma("unroll") for (int i = 0; i < 16; ++i) *(unsigned*)(pb_ - i * 72) = pk_[i]; } \
        else { bf16* pf_ = xcb + (16 * tg) * 72 + 2 * cp; _Pragma("unroll") for (int i = 0; i < 16; ++i) *(unsigned*)(pf_ + i * 72) = pk_[i]; } } while (0)
    u32x4 oy[2], og[2];
#define RL_OUT_LOAD(SO_) do { if ((SO_).store && (SO_).comb) { const int sl_ = td >> 1, t_ = (SO_).tlo + (dirw ? 127 - sl_ : sl_); const unsigned go_ = (unsigned)(((SO_).rowbase + t_) * DM + 64 * n + 32 * hf + 16 * (td & 1)); \
        oy[0] = *(const u32x4*)(YR + go_); oy[1] = *(const u32x4*)(YR + go_ + 8); og[0] = *(const u32x4*)(YG + go_); og[1] = *(const u32x4*)(YG + go_ + 8); } } while (0)
#define RL_OUT_FINISH(SO_) do { if ((SO_).store) { const int sl_ = td >> 1, t_ = (SO_).tlo + (dirw ? 127 - sl_ : sl_); const unsigned go_ = (unsigned)(((SO_).rowbase + t_) * DM + 64 * n + 32 * hf + 16 * (td & 1)); \
        const f32x4* hp_ = (const f32x4*)(hb + sl_ * RL_HB_LD + 16 * (td & 1)); f32x4 hv_[4]; _Pragma("unroll") for (int i_ = 0; i_ < 4; ++i_) hv_[i_] = hp_[i_]; \
        if ((SO_).comb) { _Pragma("unroll") for (int k_ = 0; k_ < 2; ++k_) { const unsigned yw_[4] = {oy[k_].x, oy[k_].y, oy[k_].z, oy[k_].w}, gw_[4] = {og[k_].x, og[k_].y, og[k_].z, og[k_].w}; \
            _Pragma("unroll") for (int e_ = 0; e_ < 4; ++e_) { const int v_ = 2 * k_ + (e_ >> 1), c_ = 2 * (e_ & 1); \
                hv_[v_][c_] = (bflo(yw_[e_]) + hv_[v_][c_]) * bflo(gw_[e_]); hv_[v_][c_ + 1] = (bfhi(yw_[e_]) + hv_[v_][c_ + 1]) * bfhi(gw_[e_]); } } } \
        u32x4 o0_, o1_; o0_.x = pk2(hv_[0][0], hv_[0][1]); o0_.y = pk2(hv_[0][2], hv_[0][3]); o0_.z = pk2(hv_[1][0], hv_[1][1]); o0_.w = pk2(hv_[1][2], hv_[1][3]); \
        o1_.x = pk2(hv_[2][0], hv_[2][1]); o1_.y = pk2(hv_[2][2], hv_[2][3]); o1_.z = pk2(hv_[3][0], hv_[3][1]); o1_.w = pk2(hv_[3][2], hv_[3][3]); \
        *(u32x4*)(YR + go_) = o0_; *(u32x4*)(YR + go_ + 8) = o1_; } } while (0)
    { const RlStep s0 = rl_step(0, dirw, bl, ctx_out); RL_FETCH(s0); RL_PUT(); }
    __syncthreads();
    RL_CONV();
    { const RlStep s1 = rl_step(1, dirw, bl, ctx_out); RL_FETCH(s1); }
    __syncthreads();
    for (int st = 0; st < 18; ++st) {
        const RlStep S = rl_step(st, dirw, bl, ctx_out);
        if (st > 0) { const RlStep Sp = rl_step(st - 1, dirw, bl, ctx_out); RL_OUT_FINISH(Sp); }
        if (st + 1 < 18) RL_PUT();
        if (st + 2 < 18) { const RlStep Sn = rl_step(st + 2, dirw, bl, ctx_out); RL_FETCH(Sn); }
        float hl[2][2][4], PP[2][2][4], EA[2][2], EH[2][2];
#pragma unroll
        for (int mb = 0; mb < 2; ++mb) {
            const bf16* ap = xcb + (32 * wd + 16 * mb + col) * 72 + 8 * quad;
            const bf16x8 A0 = *(const bf16x8*)ap, A1 = *(const bf16x8*)(ap + 32);
            accv g0[2], g1[2];
#pragma unroll
            for (int nb = 0; nb < 2; ++nb) { g0[nb] = (accv){b0[nb], b0[nb], b0[nb], b0[nb]}; g1[nb] = (accv){b1[nb], b1[nb], b1[nb], b1[nb]};
                g0[nb] = __builtin_amdgcn_mfma_f32_16x16x32_bf16(A0, Bf[0][nb][0], g0[nb], 0, 0, 0); g0[nb] = __builtin_amdgcn_mfma_f32_16x16x32_bf16(A1, Bf[0][nb][1], g0[nb], 0, 0, 0);
                g1[nb] = __builtin_amdgcn_mfma_f32_16x16x32_bf16(A0, Bf[1][nb][0], g1[nb], 0, 0, 0); g1[nb] = __builtin_amdgcn_mfma_f32_16x16x32_bf16(A1, Bf[1][nb][1], g1[nb], 0, 0, 0); }
            pg8::f32x2 pa2 = {1.f, 1.f}, hh2 = {0.f, 0.f};
#pragma unroll
            for (int r = 0; r < 4; ++r) { const int sl = 32 * wd + 16 * mb + 4 * quad + r;
                const pg8::f32x2 d0 = (pg8::f32x2){__builtin_amdgcn_exp2f(g0[0][r]), __builtin_amdgcn_exp2f(g0[1][r])} + 1.0f, d1 = (pg8::f32x2){__builtin_amdgcn_exp2f(g1[0][r]), __builtin_amdgcn_exp2f(g1[1][r])} + 1.0f;
                const pg8::f32x2 rg = {__builtin_amdgcn_rcpf(d0.x), __builtin_amdgcn_rcpf(d0.y)}, ig = {__builtin_amdgcn_rcpf(d1.x), __builtin_amdgcn_rcpf(d1.y)}, la = c8v * rg;
                const pg8::f32x2 av = {__builtin_amdgcn_exp2f(la.x), __builtin_amdgcn_exp2f(la.y)}, o1 = 1.0f - av * av;
                const pg8::f32x2 sq = {__builtin_amdgcn_sqrtf(fmaxf(o1.x, 0.0f)), __builtin_amdgcn_sqrtf(fmaxf(o1.y, 0.0f))};
                const pg8::f32x2 xc2 = {bf2f(xcb[sl * 72 + 32 * hf + col]), bf2f(xcb[sl * 72 + 32 * hf + 16 + col])};
                hh2 = av * hh2 + (sq * ig) * xc2; pa2 = pa2 * av;
                hl[mb][0][r] = hh2.x; hl[mb][1][r] = hh2.y; PP[mb][0][r] = pa2.x; PP[mb][1][r] = pa2.y; }
#pragma unroll
            for (int nb = 0; nb < 2; ++nb) {
                const float pa = nb ? pa2.y : pa2.x, hh = nb ? hh2.y : hh2.x;
                float IA = pa, IH = hh;
                { const float pA = SHUP(IA, 16), pH = SHUP(IH, 16); if (quad >= 1) { IH = IA * pH + IH; IA = IA * pA; } }
                { const float pA = SHUP(IA, 32), pH = SHUP(IH, 32); if (quad >= 2) { IH = IA * pH + IH; IA = IA * pA; } }
                float eA = SHUP(IA, 16), eH = SHUP(IH, 16); if (quad == 0) { eA = 1.f; eH = 0.f; }
                const float gA = __builtin_bit_cast(float, __builtin_amdgcn_ds_bpermute((48 + col) << 2, __builtin_bit_cast(int, IA)));
                const float gH = __builtin_bit_cast(float, __builtin_amdgcn_ds_bpermute((48 + col) << 2, __builtin_bit_cast(int, IH)));
                if (mb == 0) { EA[0][nb] = eA; EH[0][nb] = eH; EA[1][nb] = gA; EH[1][nb] = gH; }
                else { const float a0 = EA[1][nb], h0 = EH[1][nb];
                    EA[1][nb] = eA * a0; EH[1][nb] = eA * h0 + eH;
                    if (quad == 3) { wagg[((wd * 2 + nb) * 16 + col) * 2] = gA * a0; wagg[((wd * 2 + nb) * 16 + col) * 2 + 1] = gA * h0 + gH; } }
            }
            __builtin_amdgcn_sched_barrier(0);
        }
        __syncthreads();
        RL_OUT_LOAD(S);
#pragma unroll
        for (int nb = 0; nb < 2; ++nb) {
            float h = hin[nb], hw = 0.f;
#pragma unroll
            for (int w = 0; w < 4; ++w) { if (w == wd) hw = h; const float wa = wagg[((w * 2 + nb) * 16 + col) * 2], wh = wagg[((w * 2 + nb) * 16 + col) * 2 + 1]; h = wa * h + wh; }
            hin[nb] = h;
            if (S.store) {
#pragma unroll
                for (int mb = 0; mb < 2; ++mb) { const float hs = EA[mb][nb] * hw + EH[mb][nb];
#pragma unroll
                    for (int r = 0; r < 4; ++r) { const int sl = 32 * wd + 16 * mb + 4 * quad + r; hb[sl * RL_HB_LD + 16 * nb + col] = hl[mb][nb][r] + PP[mb][nb][r] * hs; } }
            }
        }
        if (st + 1 < 18) RL_CONV();
        LDS_BARRIER();
    }
    { const RlStep Sl = rl_step(17, dirw, bl, ctx_out); RL_OUT_FINISH(Sl); }
    __syncthreads();
#undef RL_OUT_LOAD
#undef RL_OUT_FINISH
#undef RL_FETCH
#undef RL_PUT
#undef RL_CONV
}

constexpr int AT_KC = 0, AT_KC_LD = 72, AT_VC = 256 * 72 * 2, AT_VC_LD = 264, AT_RP = AT_VC + 64 * 264 * 2, AT_RP_N = 713, AT_WIN = AT_RP + 2816, AT_END = AT_WIN + 9 * 64 * 128;
static_assert(AT_END <= MISC_OFF, "attention LDS map");
#define SCHED_FENCE() __builtin_amdgcn_sched_barrier(0)
__device__ __forceinline__ float max3_(float a, float b, float c) { float r; asm("v_max3_f32 %0, %1, %2, %3" : "=v"(r) : "v"(a), "v"(b), "v"(c)); return r; }
__device__ __forceinline__ void attn_stage(const Args& a, unsigned char* lds, int l, int bl, int h, int tid) {
    unsigned char* ws = a.ws;
    const bf16* KB = (const bf16*)(ws + A_KB); const bf16* VT = (const bf16*)(ws + A_VT);
    bf16* KC = (bf16*)(lds + AT_KC); bf16* VC = (bf16*)(lds + AT_VC); float* RP = (float*)(lds + AT_RP);
    u32x4 tk[4], tv[4];
    const bf16* vsrc = VT + (size_t)LATG * DM + (size_t)(bl * 16 + h) * 64 * CTXL;
#pragma unroll
    for (int i = 0; i < 4; ++i) { const int c = tid + 512 * i; tk[i] = *(const u32x4*)(KB + (size_t)(LATG + bl * CTXL + (c >> 3)) * DM + 64 * h + 8 * (c & 7)); tv[i] = *(const u32x4*)(vsrc + (size_t)(c >> 5) * CTXL + 8 * (c & 31)); }
#pragma unroll
    for (int i = 0; i < 4; ++i) { const int c = tid + 512 * i; *(u32x4*)(KC + (c >> 3) * AT_KC_LD + 8 * (c & 7)) = tk[i]; *(u32x4*)(VC + (c >> 5) * AT_VC_LD + 8 * (c & 31)) = tv[i]; }
    const float* rp = a.in[I_RPB] + (size_t)(l * 16 + h) * 465;
    for (int i = tid; i < AT_RP_N; i += NTHR) RP[i] = i < 465 ? rp[i] * 1.44269504f : -__builtin_inff();
}
__device__ __forceinline__ int win_fk(int kcol) { return ((kcol >> 1) & 1) | (((kcol >> 3) & 3) << 1); }
__device__ __forceinline__ void win_fetch_k(u32x4 (&wr)[9], const bf16* KB, int bl, int h, int ws0, int tid) {
    const int kcol = tid >> 3, chunk = tid & 7; const unsigned lo = (unsigned)(kcol * DM + 64 * h + 8 * chunk);
#pragma unroll
    for (int i = 0; i < 9; ++i) { const int grow = min(ws0 + i, 31); wr[i] = *(const u32x4*)(KB + (size_t)(bl * SEQ + 64 * grow) * DM + lo); }
}
__device__ __forceinline__ void win_put_k(const u32x4 (&wr)[9], unsigned char* win, int tid) {
    const int kcol = tid >> 3, chunk = tid & 7; unsigned char* p = win + kcol * 128 + ((chunk ^ win_fk(kcol)) << 4);
#pragma unroll
    for (int i = 0; i < 9; ++i) *(u32x4*)(p + i * 8192) = wr[i];
}
__device__ __forceinline__ void win_fetch_v(u32x4 (&wr)[9], const bf16* VT, int bl, int h, int ws0, int tid) {
    const int dd = tid >> 3, chunk = tid & 7; const bf16* p = VT + (size_t)((bl * 16 + h) * 64 + dd) * SEQ + 8 * chunk;
#pragma unroll
    for (int i = 0; i < 9; ++i) { const int grow = min(ws0 + i, 31); wr[i] = *(const u32x4*)(p + 64 * grow); }
}
__device__ __forceinline__ void win_put_v(const u32x4 (&wr)[9], unsigned char* win, int tid) {
    const int dd = tid >> 3, chunk = tid & 7; unsigned char* p = win + dd * 128 + ((chunk ^ ((dd >> 1) & 7)) << 4);
#pragma unroll
    for (int i = 0; i < 9; ++i) *(u32x4*)(p + i * 8192) = wr[i];
}
__device__ __forceinline__ void attn_ctx_seg(const unsigned char* lds, const bf16x8 Bq0, const bf16x8 Bq1, int q, int quad, int kq, int one, accv (&O2)[4], float& m2, float& l2) {
    const bf16* KC = (const bf16*)(lds + AT_KC); const bf16* VC = (const bf16*)(lds + AT_VC);
    const float NEG = -__builtin_inff();
    accv S[16];
    const bf16* kc0 = KC + kq * AT_KC_LD + 8 * quad;
#pragma unroll
    for (int g4 = 0; g4 < 4; ++g4) {
        if (one) { asm volatile("");
            bf16x8 Kc[4][2];
#pragma unroll
            for (int i = 0; i < 4; ++i) { const int kb = 4 * g4 + i; const bf16* kp = kc0 + (32 * (kb >> 1) + 4 * (kb & 1)) * AT_KC_LD; Kc[i][0] = *(const bf16x8*)kp; Kc[i][1] = *(const bf16x8*)(kp + 32); }
            SCHED_FENCE();
#pragma unroll
            for (int i = 0; i < 4; ++i) { accv s = {0.f, 0.f, 0.f, 0.f};
                s = __builtin_amdgcn_mfma_f32_16x16x32_bf16(Kc[i][0], Bq0, s, 0, 0, 0); s = __builtin_amdgcn_mfma_f32_16x16x32_bf16(Kc[i][1], Bq1, s, 0, 0, 0); S[4 * g4 + i] = s; } }
    }
    float mx = NEG;
#pragma unroll
    for (int kb = 0; kb < 16; ++kb) { mx = max3_(S[kb][0], S[kb][1], mx); mx = max3_(S[kb][2], S[kb][3], mx); }
    { const int lane = quad * 16 + q; mx = fmaxf(mx, SHX(mx, 16)); mx = fmaxf(mx, SHX(mx, 32)); }
    float sum; u32x2 Pc[16];
    { const pg8::f32x2 mx2 = {mx, mx}; pg8::f32x2 sum2 = {0.f, 0.f};
#pragma unroll
      for (int kb = 0; kb < 16; ++kb) { const pg8::f32x2 t0 = S[kb].xy - mx2, t1 = S[kb].zw - mx2;
          const pg8::f32x2 p0 = {__builtin_amdgcn_exp2f(t0.x), __builtin_amdgcn_exp2f(t0.y)}, p1 = {__builtin_amdgcn_exp2f(t1.x), __builtin_amdgcn_exp2f(t1.y)};
          sum2 += p0; sum2 += p1; Pc[kb].x = pg8::cvt_pk_bf16(p0.x, p0.y); Pc[kb].y = pg8::cvt_pk_bf16(p1.x, p1.y); }
      sum = sum2.x + sum2.y; }
    { const int lane = quad * 16 + q; sum += SHX(sum, 16); sum += SHX(sum, 32); }
    m2 = mx; l2 = sum;
#pragma unroll
    for (int db = 0; db < 4; ++db) O2[db] = (accv){0.f, 0.f, 0.f, 0.f};
    const bf16* vb = VC + q * AT_VC_LD + 8 * quad;
#pragma unroll
    for (int g2 = 0; g2 < 4; ++g2) {
        if (one) { asm volatile("");
            u32x4 Vc[2][4];
#pragma unroll
            for (int p2 = 0; p2 < 2; ++p2)
#pragma unroll
                for (int db = 0; db < 4; ++db) Vc[p2][db] = *(const u32x4*)(vb + 16 * db * AT_VC_LD + 32 * (2 * g2 + p2));
            SCHED_FENCE();
#pragma unroll
            for (int p2 = 0; p2 < 2; ++p2) { const int pi = 2 * g2 + p2;
                u32x4 pw; pw.x = Pc[2 * pi].x; pw.y = Pc[2 * pi].y; pw.z = Pc[2 * pi + 1].x; pw.w = Pc[2 * pi + 1].y;
                const bf16x8 Bp = __builtin_bit_cast(bf16x8, pw);
#pragma unroll
                for (int db = 0; db < 4; ++db) O2[db] = __builtin_amdgcn_mfma_f32_16x16x32_bf16(__builtin_bit_cast(bf16x8, Vc[p2][db]), Bp, O2[db], 0, 0, 0); } }
    }
}
__device__ __forceinline__ void attn_store(bf16* op, const accv (&O1)[4], const accv (&O2)[4], float m1, float l1, float m2, float l2) {
    const float m = fmaxf(m1, m2), f1 = __builtin_amdgcn_exp2f(m1 - m), f2 = __builtin_amdgcn_exp2f(m2 - m);
    const float inv = 1.0f / (l1 * f1 + l2 * f2), g1 = f1 * inv, g2 = f2 * inv;
#pragma unroll
    for (int db = 0; db < 4; ++db) { u32x2 w; w.x = pk2(O1[db][0] * g1 + O2[db][0] * g2, O1[db][1] * g1 + O2[db][1] * g2); w.y = pk2(O1[db][2] * g1 + O2[db][2] * g2, O1[db][3] * g1 + O2[db][3] * g2); *(u32x2*)(op + 16 * db) = w; }
}
__device__ __forceinline__ void attn_iter(const Args& a, unsigned char* lds, int bl, int h, int r0, int wave, bf16x8 (&qf)[2], int nq) {
    unsigned char* ws = a.ws;
    const bf16* QB = (const bf16*)(ws + A_QB); const bf16* KB = (const bf16*)(ws + A_KB); const bf16* VT = (const bf16*)(ws + A_VT); bf16* YN = (bf16*)(ws + A_YN);
    const float* RP = (const float*)(lds + AT_RP); unsigned char* win = lds + AT_WIN;
    const int r = r0 + (wave >> 2), j = wave & 3;
    const int ws0 = min(max(r0 - 4, 0), 24), start = min(max(r - 4, 0), 24), kstart = min(max(16 * j - 8, 0), 32), wl0 = start - ws0;
    int one = 1; asm volatile("" : "+s"(one));
    const float NEG = -__builtin_inff();
    u32x4 wr[9];
    { const int tid = wave * 64 + lane_id_fresh(); win_fetch_k(wr, KB, bl, h, ws0, tid); }
    SCHED_FENCE();
    accv O2[4]; float m2, l2;
    { const int lane = lane_id_fresh(), q = lane & 15, quad = lane >> 4; attn_ctx_seg(lds, qf[0], qf[1], q, quad, 8 * (q >> 2) + (q & 3), one, O2, m2, l2); }
    __syncthreads();
    { const int tid = wave * 64 + lane_id_fresh(); win_put_k(wr, win, tid); }
    __syncthreads();
    const int lane = lane_id_fresh(), q = lane & 15, quad = lane >> 4, kq = 8 * (q >> 2) + (q & 3);
    const bf16x8 Bq0 = qf[0], Bq1 = qf[1];
    accv S[16];
    {
        const int kcol0 = kstart + kq, kcol1 = kcol0 + 4;
        const unsigned char* k0 = win + (wl0 * 64 + kcol0) * 128, *k1 = win + (wl0 * 64 + kcol1) * 128;
        const int f0 = win_fk(kcol0), f1 = win_fk(kcol1);
        const int o00 = (quad ^ f0) << 4, o01 = ((quad + 4) ^ f0) << 4, o10 = (quad ^ f1) << 4, o11 = ((quad + 4) ^ f1) << 4;
#pragma unroll
        for (int g4 = 0; g4 < 4; ++g4) {
            if (one) { asm volatile("");
                bf16x8 Kw[4][2];
#pragma unroll
                for (int i = 0; i < 4; ++i) { const int kb = 4 * g4 + i; const unsigned char* kp = ((kb & 1) ? k1 : k0) + (kb >> 1) * 64 * 128;
                    Kw[i][0] = *(const bf16x8*)(kp + ((kb & 1) ? o10 : o00)); Kw[i][1] = *(const bf16x8*)(kp + ((kb & 1) ? o11 : o01)); }
                SCHED_FENCE();
#pragma unroll
                for (int i = 0; i < 4; ++i) { accv s = {0.f, 0.f, 0.f, 0.f};
                    s = __builtin_amdgcn_mfma_f32_16x16x32_bf16(Kw[i][0], Bq0, s, 0, 0, 0); s = __builtin_amdgcn_mfma_f32_16x16x32_bf16(Kw[i][1], Bq1, s, 0, 0, 0); S[4 * g4 + i] = s; } }
        }
    }
    SCHED_FENCE();
    { const int tid = wave * 64 + lane; win_fetch_v(wr, VT, bl, h, ws0, tid); }
    SCHED_FENCE();
    float m1, l1; u32x2 Pl[16];
    {
        const int qc = 16 * j + q, wst = min(max(qc - 8, 0), 48);
        const float* bp[2][4];
#pragma unroll
        for (int hb = 0; hb < 2; ++hb)
#pragma unroll
            for (int rr = 0; rr < 4; ++rr) { const int kc = kstart + 8 * quad + 4 * hb + rr; const bool ok = (kc >= wst) && (kc < wst + 16); bp[hb][rr] = RP + (ok ? (start - r + 7) * 31 + min(max(kc - qc + 15, 0), 30) : 465); }
#pragma unroll
        for (int g4 = 0; g4 < 4; ++g4) {
            if (one) { asm volatile("");
                float bw[4][4];
#pragma unroll
                for (int i = 0; i < 4; ++i) { const int kb = 4 * g4 + i;
#pragma unroll
                    for (int rr = 0; rr < 4; ++rr) bw[i][rr] = bp[kb & 1][rr][(kb >> 1) * 31]; }
#pragma unroll
                for (int i = 0; i < 4; ++i) { const int kb = 4 * g4 + i; S[kb].xy += (pg8::f32x2){bw[i][0], bw[i][1]}; S[kb].zw += (pg8::f32x2){bw[i][2], bw[i][3]}; } }
        }
        float mx = NEG;
#pragma unroll
        for (int kb = 0; kb < 16; ++kb) { mx = max3_(S[kb][0], S[kb][1], mx); mx = max3_(S[kb][2], S[kb][3], mx); }
        mx = fmaxf(mx, SHX(mx, 16)); mx = fmaxf(mx, SHX(mx, 32));
        float sum;
        { const pg8::f32x2 mx2 = {mx, mx}; pg8::f32x2 sum2 = {0.f, 0.f};
#pragma unroll
          for (int kb = 0; kb < 16; ++kb) { const pg8::f32x2 t0 = S[kb].xy - mx2, t1 = S[kb].zw - mx2;
              const pg8::f32x2 p0 = {__builtin_amdgcn_exp2f(t0.x), __builtin_amdgcn_exp2f(t0.y)}, p1 = {__builtin_amdgcn_exp2f(t1.x), __builtin_amdgcn_exp2f(t1.y)};
              sum2 += p0; sum2 += p1; Pl[kb].x = pg8::cvt_pk_bf16(p0.x, p0.y); Pl[kb].y = pg8::cvt_pk_bf16(p1.x, p1.y); }
          sum = sum2.x + sum2.y; }
        sum += SHX(sum, 16); sum += SHX(sum, 32);
        m1 = mx; l1 = sum;
    }
    __syncthreads();
    { const int tid = wave * 64 + lane; win_put_v(wr, win, tid); }
    __syncthreads();
    if (nq >= 0) { const bf16* qn = QB + (size_t)(nq + q) * DM + 64 * h + 8 * quad; qf[0] = *(const bf16x8*)qn; qf[1] = *(const bf16x8*)(qn + 32); }
    accv O1[4];
#pragma unroll
    for (int db = 0; db < 4; ++db) O1[db] = (accv){0.f, 0.f, 0.f, 0.f};
    {
        const int chunk = (kstart >> 3) + quad;
#pragma unroll
        for (int g2 = 0; g2 < 4; ++g2) {
            if (one) { asm volatile("");
                u32x4 Vw[2][4];
#pragma unroll
                for (int p2 = 0; p2 < 2; ++p2)
#pragma unroll
                    for (int db = 0; db < 4; ++db) { const int dd = 16 * db + q; Vw[p2][db] = *(const u32x4*)(win + ((wl0 + 2 * g2 + p2) * 64 + dd) * 128 + ((chunk ^ ((dd >> 1) & 7)) << 4)); }
                SCHED_FENCE();
#pragma unroll
                for (int p2 = 0; p2 < 2; ++p2) { const int pi = 2 * g2 + p2;
                    u32x4 pw; pw.x = Pl[2 * pi].x; pw.y = Pl[2 * pi].y; pw.z = Pl[2 * pi + 1].x; pw.w = Pl[2 * pi + 1].y;
                    const bf16x8 Bp = __builtin_bit_cast(bf16x8, pw);
#pragma unroll
                    for (int db = 0; db < 4; ++db) O1[db] = __builtin_amdgcn_mfma_f32_16x16x32_bf16(__builtin_bit_cast(bf16x8, Vw[p2][db]), Bp, O1[db], 0, 0, 0); } }
        }
    }
    attn_store(YN + (size_t)(bl * SEQ + 64 * r + 16 * j + q) * DM + 64 * h + 4 * quad, O1, O2, m1, l1, m2, l2);
}
__device__ __forceinline__ void attn_ctx_unit(const Args& a, const unsigned char* lds, int bl, int h, int qb, bf16x8 (&qf)[2]) {
    bf16* YN = (bf16*)(a.ws + A_YN);
    int one = 1; asm volatile("" : "+s"(one));
    const int lane = lane_id_fresh(), q = lane & 15, quad = lane >> 4;
    accv O2[4], O1[4]; float m2, l2;
    attn_ctx_seg(lds, qf[0], qf[1], q, quad, 8 * (q >> 2) + (q & 3), one, O2, m2, l2);
#pragma unroll
    for (int db = 0; db < 4; ++db) O1[db] = (accv){0.f, 0.f, 0.f, 0.f};
    attn_store(YN + (size_t)(LATG + bl * CTXL + 16 * qb + q) * DM + 64 * h + 4 * quad, O1, O2, -__builtin_inff(), 0.f, m2, l2);
}
__device__ __forceinline__ void attn_block(const Args& a, unsigned char* lds, int l, int bu, bool ctx_out, int wave) {
    const int bl = bu >> 5, h = (bu >> 1) & 15, half = bu & 1;
    __syncthreads();
    attn_stage(a, lds, l, bl, h, wave * 64 + lane_id_fresh());
    __syncthreads();
    const int j = wave & 3, rw = 16 * half + (wave >> 2);
    bf16x8 qf[2];
    { const int lane = lane_id_fresh(); const bf16* qp = (const bf16*)(a.ws + A_QB) + (size_t)(bl * SEQ + 64 * rw + 16 * j + (lane & 15)) * DM + 64 * h + 8 * (lane >> 4); qf[0] = *(const bf16x8*)qp; qf[1] = *(const bf16x8*)(qp + 32); }
    for (int it = 0; it < 8; ++it) {
        const int nq = it < 7 ? bl * SEQ + 64 * (rw + 2 * it + 2) + 16 * j : (ctx_out ? LATG + bl * CTXL + 16 * (8 * half + wave) : -1);
        attn_iter(a, lds, bl, h, 16 * half + 2 * it, wave, qf, nq); }
    if (ctx_out) attn_ctx_unit(a, lds, bl, h, 8 * half + wave, qf);
    __syncthreads();
}
constexpr int NPH = 1 + 2 * 30;
__host__ __device__ constexpr bool phase_used(int ph) { if (ph == 0) return true; const int q = ph - 1, l = q / 30, r = q % 30; if (l == 0) return r < 24 ? (r % 12) <= 5 : r <= 26; return r < 24 && (r % 12) <= 10; }

#define RFL(x) __builtin_amdgcn_readfirstlane(x)
#if defined(__HIP_DEVICE_COMPILE__)
__device__ __forceinline__ Args load_kargs() { const __attribute__((address_space(4))) unsigned long long* p = (const __attribute__((address_space(4))) unsigned long long*)__builtin_amdgcn_kernarg_segment_ptr();
    asm volatile("" : "+s"(p)); Args r;
    typedef __attribute__((address_space(1))) float gf32; typedef __attribute__((address_space(1))) unsigned char gu8;
#pragma unroll
    for (int i = 0; i < 25; ++i) r.in[i] = (const float*)(const gf32*)p[i];
    r.out = (float*)(gf32*)p[25]; r.ws = (unsigned char*)(gu8*)p[26];
    const unsigned long long w = p[27]; r.ph_lo = (int)(unsigned)w; r.ph_hi = (int)(unsigned)(w >> 32);
    return r; }
#define LOAD_KARGS() load_kargs()
#else
#define LOAD_KARGS() a_in
#endif
#define PHASE_IDS() const Args a = LOAD_KARGS(); unsigned char* const ws = a.ws; (void)ws; int lane_l; asm volatile("v_mbcnt_lo_u32_b32 %0, -1, 0\n\tv_mbcnt_hi_u32_b32 %0, -1, %0" : "=v"(lane_l)); int wave_l = wave_s; asm volatile("" : "+s"(wave_l)); const int lane = lane_l, wave = wave_l, tid = wave_l * 64 + lane, gw = blk * NWAVES + wave, NGW = G * NWAVES; const float* modl = (const float*)(ws + WS_MOD) + (size_t)l * 17 * NMOD; const float* xin_lat = (l == 0 ? a.in[I_X] : a.out) + (size_t)g * LATG * DM; const float* xin_ctx = (l == 0 ? a.in[I_CTX] : (const float*)(ws + WS_XC)) + (size_t)g * CTXG * DM; float* xs_lat = a.out + (size_t)g * LATG * DM; float* xs_ctx = (float*)(ws + WS_XC) + (size_t)g * CTXG * DM; bf16* xsb_lat = (bf16*)a.out + (size_t)g * LATG * XS_LD; bf16* xsb_ctx = (bf16*)(ws + WS_XC) + (size_t)g * CTXG * XS_LD; (void)xsb_lat; (void)xsb_ctx; (void)modl; (void)xin_lat; (void)xin_ctx; (void)xs_lat; (void)xs_ctx; (void)lane; (void)wave; (void)gw; (void)NGW; (void)tid
__global__ void __launch_bounds__(NTHR, 2) fwd(Args a_in) {
    extern __shared__ __attribute__((aligned(16))) unsigned char lds[];
    const int tid = threadIdx.x, lane = tid & 63, wave = __builtin_amdgcn_readfirstlane(tid >> 6), G = gridDim.x, blk = blockIdx.x;
    const int wave_s = wave;
    if (tid < 16) ((unsigned*)(lds + MISC_OFF))[tid] = 0u;
    __syncthreads();
    XcdBarrier bar = xcd_barrier_post((unsigned*)(a_in.ws + WS_CTL) + CW_BAR, (volatile LAS unsigned*)(lds + MISC_OFF));
    const int lo = a_in.ph_lo, hi = a_in.ph_hi;
#ifndef PHMASK
#define PHMASK 0xFFFF
#endif
#define IN(k) (lo <= (k) && (k) < hi)
#define EN(k) ((PHMASK >> (k)) & 1)
#define SEAM(k) do { if ((k) + 1 < hi) xcd_barrier(bar); } while (0)
    PG8_LAS unsigned char* ring = (PG8_LAS unsigned char*)lds;

    if (EN(0) && IN(0)) { phase_prologue(a_in, lds, blk, G, wave, lane, tid, G == 256); SEAM(0); }

    for (int l = 0; l < NLAYER; ++l) {
        for (int g = 0; g < NGRP; ++g) {
            const int pb = 1 + 30 * l + 12 * g;
            if (hi <= pb || lo >= pb + 12) continue;
            int blk_l = blockIdx.x, G_l = gridDim.x; asm volatile("" : "+s"(blk_l), "+s"(G_l));
            const int blk = blk_l, G = G_l;
            const bool ctx_out = (l == 0);

            if (EN(1) && IN(pb + 0)) {
                PHASE_IDS();
                bf16* H = (bf16*)(ws + A_H);
                bool early = false;
                if (l == 0 && g == 1 && G == 256) early = true;
                if (l == 1 && g == 1 && G == 256) { const int nfull = (RFL(((const int*)(ws + WS_MISC + MS_TOFF))[8]) * 28) & 255; early = nfull > 0 && 256 - nfull >= 64; }
                if (!early)
                { const int rpw = (RG + NGW - 1) / NGW, r0 = gw * rpw, nr = RG - r0 < rpw ? RG - r0 : rpw;
                  if (l == 0) modulate_rows<false, false>(xin_lat, xin_ctx, LATG, g * BG, modl, 0, H, r0, nr, lane, nullptr, nullptr, nullptr, nullptr);
                  else {
                      const int rl = (LATG + NGW - 1) / NGW, l0r = gw * rl, nl = LATG - l0r < rl ? LATG - l0r : rl, rc = (CTXG + NGW - 1) / NGW, c0r = gw * rc, nc = CTXG - c0r < rc ? CTXG - c0r : rc;
                      modulate_rows<false, true, false>(xsb_lat, xsb_ctx, LATG, g * BG, modl, 0, H, l0r, nl, lane, nullptr, nullptr, nullptr, nullptr);
                      modulate_rows<false, true, true>(xsb_lat, xsb_ctx, LATG, g * BG, modl, 0, H, LATG + c0r, nc, lane, nullptr, nullptr, nullptr, nullptr, xsb_lat); } }
                SEAM(pb + 0);
            }
            if (EN(2) && IN(pb + 1)) {
                PHASE_IDS();
                pg8::Gemm gm{(const pg8::bf16_t*)(ws + A_H), (const pg8::bf16_t*)(ws + WS_WIN) + (size_t)l * NIN * DM, RG, NIN, DM, DM};
                int nn1 = ctx_out ? 28 : 12; asm volatile("" : "+s"(nn1));
                RectOrder S{64, 28, 8, nn1, G, blk, DM / 64};
                EpiIn E{ws, a.in[I_QG] + l * HD, a.in[I_KG] + l * HD};
                pg8::gemm_phase<EpiIn, RectOrder, false>(ring, gm, S, E, nullptr, tid);
                SEAM(pb + 1);
            }
            if (EN(3) && IN(pb + 2)) {
                PHASE_IDS();
                for (int u = blk; u < 256; u += G) rglru_unit(a, lds, l, u, ctx_out, wave, lane, tid);
                for (int bu = blk; bu < 256; bu += G) attn_block(a, lds, l, bu, ctx_out, wave);
                SEAM(pb + 2);
            }
            int nMmix = ctx_out ? 72 : 64; asm volatile("" : "+s"(nMmix));
            if (EN(4) && IN(pb + 3)) {
                PHASE_IDS();
                pg8::Gemm gm{(const pg8::bf16_t*)(ws + A_H), (const pg8::bf16_t*)(ws + WS_WRO) + (size_t)l * DM * DM, RG, DM, DM, DM};
                RectOrder S{nMmix, 4, 0, 0, G, blk, DM / 64};
                EpiGate<0> E{(const bf16*)(ws + A_SR), nullptr, (bf16*)(ws + A_T1)};
                pg8::gemm_phase<EpiGate<0>, RectOrder, false>(ring, gm, S, E, nullptr, tid);
                if (l == 0 && G == 256) moe_convert_slice(a, lds, 3 * g + 0, blk, wave, lane);
                __syncthreads();
            }
            if (EN(5) && IN(pb + 4)) {
                PHASE_IDS();
                pg8::Gemm gm{(const pg8::bf16_t*)(ws + A_YN), (const pg8::bf16_t*)(ws + WS_WNO) + (size_t)l * DM * DM, RG, DM, DM, DM};
                RectOrder S{nMmix, 4, 0, 0, G, blk, DM / 64};
                EpiGate<1> E{(const bf16*)(ws + A_SN), (const bf16*)(ws + A_T1), (bf16*)(ws + A_XR)};
                pg8::gemm_phase<EpiGate<1>, RectOrder, false>(ring, gm, S, E, nullptr, tid);
                if (l == 0 && G == 256) moe_convert_slice(a, lds, 3 * g + 1, blk, wave, lane);
                SEAM(pb + 4);
            }
            if (EN(6) && IN(pb + 5)) {
                PHASE_IDS();
                pg8::Gemm gm{(const pg8::bf16_t*)(ws + A_XR), (const pg8::bf16_t*)(ws + WS_WOUT) + (size_t)l * DM * DM, RG, DM, DM, DM};
                RectOrder S{nMmix, 4, 0, 0, G, blk, DM / 64};
                if (l == 0) { EpiRes<true> E{xin_lat, xin_ctx, xsb_lat, xsb_ctx, modl, 2, g * BG, 64}; pg8::gemm_phase<EpiRes<true>, RectOrder, false>(ring, gm, S, E, nullptr, tid); }
                else { EpiRes<false> E{xsb_lat, xsb_ctx, xsb_lat, xsb_ctx, modl, 2, g * BG, 64}; pg8::gemm_phase<EpiRes<false>, RectOrder, false>(ring, gm, S, E, nullptr, tid); }
                if (l == 0 && G == 256) moe_convert_slice(a, lds, 3 * g + 2, blk, wave, lane);
                if (l == 0 && g == 0 && G == 256 && blk >= 32) {
                    const int vw = (blk - 32) * NWAVES + wave, NVW = 224 * NWAVES, rpw = (RG + NVW - 1) / NVW, r0 = vw * rpw, nr = RG - r0 < rpw ? RG - r0 : rpw;
                    modulate_rows<false, false>(a.in[I_X] + (size_t)LATG * DM, a.in[I_CTX] + (size_t)CTXG * DM, LATG, BG, modl, 0, (bf16*)(ws + A_H), r0, nr, lane, nullptr, nullptr, nullptr, nullptr); }
                if (l == 0 && g == 1 && G == 256 && blk >= 32) {
                    const int vw = (blk - 32) * NWAVES + wave, NVW = 224 * NWAVES, rpw = (LATG + NVW - 1) / NVW, r0 = vw * rpw, nr = LATG - r0 < rpw ? LATG - r0 : rpw;
                    modulate_rows<false, true>(a.out, ws + WS_XC, NB * SEQ, 0, modl, 3, (bf16*)(ws + A_H2), r0, nr, lane, nullptr, nullptr, nullptr, nullptr); }
                if (l == 0 && g == 0 && MK_ONE_LAUNCH) __syncthreads(); else SEAM(pb + 5);
            }
            if (l == 0) continue;
            if (EN(7) && IN(pb + 6)) {
                PHASE_IDS();
                bf16* H2 = (bf16*)(ws + A_H2M); int* cntl = (int*)(lds + 1024);
                int* re = (int*)(ws + WS_MISC + MS_ROUTE_E); float* rw = (float*)(ws + WS_MISC + MS_ROUTE_W); int* cntg = (int*)(ws + WS_MISC + MS_CNT);
                for (int c = blk; c < LATG / 64; c += G) {
                    if (tid < 8) cntl[tid] = 0;
                    __syncthreads();
                    modulate_rows<true, true>(xsb_lat, xsb_lat, LATG, g * BG, modl, 3, H2, c * 64 + wave * 8, 8, lane, a.in[I_ROUTER], re, rw, cntl);
                    __syncthreads();
                    if (tid < 8) cntg[c * 8 + tid] = cntl[tid];
                    __syncthreads();
                }
                SEAM(pb + 6);
            }
            if (EN(8) && IN(pb + 7)) {
                PHASE_IDS();
                int* pre = (int*)lds;
                int* toff = (int*)(lds + 8192);
                const int* cntg = (const int*)(ws + WS_MISC + MS_CNT); const int* re = (const int*)(ws + WS_MISC + MS_ROUTE_E); const float* rw = (const float*)(ws + WS_MISC + MS_ROUTE_W);
                int* tokslot = (int*)(ws + WS_MISC + MS_TOKSLOT); float* slotw = (float*)(ws + WS_MISC + MS_SLOTW); int* rowmap = (int*)(ws + WS_MISC + MS_ROWMAP);
                { int t4[2048 / NTHR];
#pragma unroll
                  for (int k = 0; k < 2048 / NTHR; ++k) t4[k] = cntg[tid + NTHR * k];
#pragma unroll
                  for (int k = 0; k < 2048 / NTHR; ++k) pre[tid + NTHR * k] = t4[k]; }
                __syncthreads();
                { const int e = wave, c0 = 4 * lane;
                  const int v0 = pre[c0 * 8 + e], v1 = pre[(c0 + 1) * 8 + e], v2 = pre[(c0 + 2) * 8 + e], v3 = pre[(c0 + 3) * 8 + e], s = v0 + v1 + v2 + v3; int inc = s;
#define DPP_IADD_(v, ctrl, rmask) v += __builtin_amdgcn_update_dpp(0, v, ctrl, rmask, 0xf, false)
                  DPP_IADD_(inc, 0x111, 0xf); DPP_IADD_(inc, 0x112, 0xf); DPP_IADD_(inc, 0x114, 0xf); DPP_IADD_(inc, 0x118, 0xf); DPP_IADD_(inc, 0x142, 0xa); DPP_IADD_(inc, 0x143, 0xc);
#undef DPP_IADD_
                  const int exc = inc - s;
                  pre[c0 * 8 + e] = exc; pre[(c0 + 1) * 8 + e] = exc + v0; pre[(c0 + 2) * 8 + e] = exc + v0 + v1; pre[(c0 + 3) * 8 + e] = exc + v0 + v1 + v2;
                  if (lane == 63) toff[10 + e] = inc; }
                __syncthreads();
                if (tid == 0) { int t = 0; for (int e = 0; e < 8; ++e) { toff[e] = t; t += (toff[10 + e] + 255) >> 8; } toff[8] = t; toff[9] = t;
                    if (blk == 0) { int* tg = (int*)(ws + WS_MISC + MS_TOFF); for (int e = 0; e < 10; ++e) tg[e] = toff[e]; } }
                __syncthreads();
                for (int e = blk; e < 8; e += G) {
                    for (int s = toff[e] * 256 + toff[10 + e] + tid; s < toff[e + 1] * 256; s += NTHR) rowmap[s] = 0; }
                for (int c = blk; c < LATG / 64; c += G) {
                    if (wave == 0) { const int r = c * 64 + lane, ee = re[r], e0 = ee & 255, e1 = ee >> 8; int s0 = 0, s1 = 0;
                        const unsigned long long lt = (1ull << lane) - 1ull;
#pragma unroll
                        for (int e = 0; e < 8; ++e) { const unsigned long long m0 = __ballot(e0 == e), m1 = __ballot(e1 == e);
                            const int base = toff[e] * 256 + pre[c * 8 + e];
                            if (e0 == e) s0 = base + __popcll(m0 & lt);
                            if (e1 == e) s1 = base + __popcll(m0) + __popcll(m1 & lt); }
                        tokslot[2 * r] = s0; tokslot[2 * r + 1] = s1; slotw[s0] = rw[2 * r]; slotw[s1] = rw[2 * r + 1]; rowmap[s0] = r; rowmap[s1] = r; }
                }
                SEAM(pb + 7);
            }
            if (EN(9) && IN(pb + 8)) {
                PHASE_IDS();
                const int* tg = (const int*)(ws + WS_MISC + MS_TOFF);
                pg8::Gemm gm{(const pg8::bf16_t*)(ws + A_H2M), (const pg8::bf16_t*)(ws + WS_WM13), MOE_ROWS_MAX, 2 * DFE, DM, DM};
                MoeOrder S{RFL(tg[8]), 28, G, blk, RFL(tg[1]), RFL(tg[2]), RFL(tg[3]), RFL(tg[4]), RFL(tg[5]), RFL(tg[6]), RFL(tg[7]), DM / 64};
                EpiSwi<true> E{(bf16*)(ws + A_ACTM), DFE, 28, (const float*)(ws + WS_MISC + MS_SLOTW)};
                PG8_LAS int* umap = (PG8_LAS int*)(ring + RING_BYTES);
                { const int* rowmap = (const int*)(ws + WS_MISC + MS_ROWMAP); int rv[MOE_GATHER_UNITS];
#pragma unroll
                  for (int i = 0; i < MOE_GATHER_UNITS; ++i) { pg8::Unit uu; const bool ok = S.next(i, uu); rv[i] = (ok && tid < 256) ? rowmap[uu.pm * 256 + tid] : 0; }
#pragma unroll
                  for (int i = 0; i < MOE_GATHER_UNITS; ++i) if (tid < 256) umap[i * 256 + tid] = rv[i]; }
                __syncthreads();
                pg8::gemm_phase<EpiSwi<true>, MoeOrder, false, true>(ring, gm, S, E, nullptr, tid, umap);
                if (g == 0 && G == 256) {
                    const int nfull = (RFL(tg[8]) * 28) & 255, nshort = 256 - nfull;
                    if (nfull > 0 && nshort >= 64 && blk >= nfull) {
                        const int vw = (blk - nfull) * NWAVES + wave, NVW = nshort * NWAVES;
                        bf16* H = (bf16*)(ws + A_H); const bf16* x1l = (const bf16*)a.out + (size_t)LATG * XS_LD; const bf16* x1c = (const bf16*)(ws + WS_XC) + (size_t)CTXG * XS_LD;
                        const int rl = (LATG + NVW - 1) / NVW, l0r = vw * rl, nl = LATG - l0r < rl ? LATG - l0r : rl, rc = (CTXG + NVW - 1) / NVW, c0r = vw * rc, nc = CTXG - c0r < rc ? CTXG - c0r : rc;
                        modulate_rows<false, true, false>(x1l, x1c, LATG, BG, modl, 0, H, l0r, nl, lane, nullptr, nullptr, nullptr, nullptr);
                        modulate_rows<false, true, true>(x1l, x1c, LATG, BG, modl, 0, H, LATG + c0r, nc, lane, nullptr, nullptr, nullptr, nullptr, x1l); } }
                SEAM(pb + 8);
            }
            if (EN(10) && IN(pb + 9)) {
                PHASE_IDS();
                const int* tg = (const int*)(ws + WS_MISC + MS_TOFF);
                pg8::Gemm gm{(const pg8::bf16_t*)(ws + A_ACTM), (const pg8::bf16_t*)(ws + WS_WM2), MOE_ROWS_MAX, DM, DFE, DFE};
                MoeDownOrder S{RFL(tg[8]), G, blk, RFL(tg[1]), RFL(tg[2]), RFL(tg[3]), RFL(tg[4]), RFL(tg[5]), RFL(tg[6]), RFL(tg[7])};
                EpiY E{(bf16*)(ws + A_Y), 4, (bf16*)(ws + A_YPART)};
                pg8::gemm_phase<EpiY, MoeDownOrder, false>(ring, gm, S, E, nullptr, tid);
                SEAM(pb + 9);
            }
            if (EN(11) && IN(pb + 10)) {
                PHASE_IDS();
                const int* tokslot = (const int*)(ws + WS_MISC + MS_TOKSLOT); const bf16* Y = (const bf16*)(ws + A_Y); const bf16* YP = (const bf16*)(ws + A_YPART);
                for (int r = gw; r < LATG; r += NGW) { const int s0 = tokslot[2 * r], s1 = tokslot[2 * r + 1], mrow = g * BG + r / SEQ;
                    const float* gp = modl + (size_t)mrow * NMOD + 5 * DM; float* xr = xs_lat + (size_t)r * DM; const bf16* xb = xsb_lat + (size_t)r * XS_LD;
                    u32x2 y0[4], y1[4], xw[4]; f32x4 gv[4], xv[4];
                    const bool o0 = (s0 >> 8) >= MOE_MAIN_TILES, o1 = (s1 >> 8) >= MOE_MAIN_TILES;
                    const bf16* p0 = o0 ? YP + (size_t)(s0 - MOE_MAIN_TILES * 256) * DM : Y + (size_t)s0 * DM; const bf16* p1 = o1 ? YP + (size_t)(s1 - MOE_MAIN_TILES * 256) * DM : Y + (size_t)s1 * DM;
#pragma unroll
                    for (int j = 0; j < 4; ++j) { const int col = 4 * lane + 256 * j;
                        y0[j] = *(const u32x2*)(p0 + col); y1[j] = *(const u32x2*)(p1 + col); gv[j] = *(const f32x4*)(gp + col); xw[j] = *(const u32x2*)(xb + col); }
#pragma unroll
                    for (int j = 0; j < 4; ++j) xv[j] = (f32x4){bflo(xw[j].x), bfhi(xw[j].x), bflo(xw[j].y), bfhi(xw[j].y)};
                    f32x4 ys[4];
#pragma unroll
                    for (int j = 0; j < 4; ++j) ys[j] = (f32x4){bflo(y0[j].x) + bflo(y1[j].x), bfhi(y0[j].x) + bfhi(y1[j].x), bflo(y0[j].y) + bflo(y1[j].y), bfhi(y0[j].y) + bfhi(y1[j].y)};
                    if (o0 || o1) {
#pragma unroll
                        for (int w = 0; w < 2; ++w) { if (w ? o1 : o0) { const bf16* pw = w ? p1 : p0; u32x2 t[MOE_KS - 1][4];
#pragma unroll
                            for (int ks = 1; ks < MOE_KS; ++ks)
#pragma unroll
                                for (int j = 0; j < 4; ++j) t[ks - 1][j] = *(const u32x2*)(pw + (size_t)ks * 8 * 256 * DM + 4 * lane + 256 * j);
#pragma unroll
                            for (int ks = 1; ks < MOE_KS; ++ks)
#pragma unroll
                                for (int j = 0; j < 4; ++j) { ys[j].x += bflo(t[ks - 1][j].x); ys[j].y += bfhi(t[ks - 1][j].x); ys[j].z += bflo(t[ks - 1][j].y); ys[j].w += bfhi(t[ks - 1][j].y); } } } }
#pragma unroll
                    for (int j = 0; j < 4; ++j) ys[j] = xv[j] + gv[j] * ys[j];
                    asm volatile("s_waitcnt vmcnt(0)" ::: "memory");
#pragma unroll
                    for (int j = 0; j < 4; ++j) { const int col = 4 * lane + 256 * j; *(f32x4*)(xr + col) = ys[j]; } }
                if (!MK_ONE_LAUNCH) SEAM(pb + 10);
            }
        }
        if (l == 0 && !(hi <= 25 || lo >= 28)) {
            int blk_l = blockIdx.x, G_l = gridDim.x; asm volatile("" : "+s"(blk_l), "+s"(G_l));
            const int blk = blk_l, G = G_l, g = 0; (void)g;
            constexpr int NLAT = NB * SEQ, NALL = NLAT + NB * CTXL;
            if (EN(7) && IN(25)) {
                PHASE_IDS();
                bf16* H2 = (bf16*)(ws + A_H2);
                { const int rb = G == 256 ? LATG : 0;
                  const int rpw = (NALL - rb + NGW - 1) / NGW, r0 = rb + gw * rpw, nr = NALL - r0 < rpw ? NALL - r0 : rpw;
                  modulate_rows<false, true>(a.out, ws + WS_XC, NLAT, 0, modl, 3, H2, r0, nr, lane, nullptr, nullptr, nullptr, nullptr); }
                SEAM(25);
            }
            if (EN(8) && IN(26)) {
                PHASE_IDS();
                pg8::Gemm gm{(const pg8::bf16_t*)(ws + A_H2), (const pg8::bf16_t*)(ws + WS_WF13), NALL, 2 * DFF, DM, DM};
                RectOrder S{144, 22, 0, 0, G, blk, DM / 64};
                EpiSwi<false> E{(bf16*)(ws + A_ACT), DFF, 22, nullptr};
                pg8::gemm_phase<EpiSwi<false>, RectOrder, false>(ring, gm, S, E, nullptr, tid);
                if (G == 256 && blk >= 256 - NT_DEFER) conv_tile(a, (float*)(lds + wave * 16384), deferred_tile(blk - (256 - NT_DEFER)), wave, lane);
                SEAM(26);
            }
            if (EN(9) && IN(27)) {
                PHASE_IDS();
                pg8::Gemm gm{(const pg8::bf16_t*)(ws + A_ACT), (const pg8::bf16_t*)(ws + WS_WF2), NALL, DM, DFF, DFF};
                FfnDownOrder S{G, blk};
                EpiRes<false, true> E{a.out, ws + WS_XC, (bf16*)a.out, (bf16*)(ws + WS_XC), modl, 5, 0, 128};
                pg8::gemm_phase<EpiRes<false, true>, FfnDownOrder, false>(ring, gm, S, E, nullptr, tid);
                SEAM(27);
            }
        }
    }
#undef IN
#undef SEAM
}

extern "C" void kernel_launch(void* const* d_in, const int* in_sizes, int n_in, void* d_out, int out_size, void* d_ws, size_t ws_size, hipStream_t stream) {
    static int grid = 0;
    if (grid == 0) {
        if (n_in != 25 || out_size != NB * SEQ * DM || ws_size < WS_END) { fprintf(stderr, "kernel_launch: unexpected shapes (n_in %d, out %d, ws %zu < %zu)\n", n_in, out_size, ws_size, (size_t)WS_END); grid = -1; return; }
        int dev = 0, cus = 0, per_cu = 0;
        if (hipGetDevice(&dev) != hipSuccess || hipDeviceGetAttribute(&cus, hipDeviceAttributeMultiprocessorCount, dev) != hipSuccess) { grid = -1; return; }
        if (hipFuncSetAttribute((const void*)fwd, hipFuncAttributeMaxDynamicSharedMemorySize, LDS_BYTES) != hipSuccess) { fprintf(stderr, "kernel_launch: hipFuncSetAttribute failed\n"); grid = -1; return; }
        if (hipOccupancyMaxActiveBlocksPerMultiprocessor(&per_cu, (const void*)fwd, NTHR, LDS_BYTES) != hipSuccess || per_cu < 1) fprintf(stderr, "kernel_launch: occupancy query reports %d\n", per_cu);
        (void)hipGetLastError();
        grid = cus;
    }
    if (grid < 0) return;
    if (hipMemsetAsync((char*)d_ws + WS_CTL, 0, CTL_ZERO_BYTES, stream) != hipSuccess) return;
    Args a{};
    for (int i = 0; i < 25; ++i) a.in[i] = (const float*)d_in[i];
    a.out = (float*)d_out; a.ws = (unsigned char*)d_ws;
#if MK_ONE_LAUNCH
    a.ph_lo = 0; a.ph_hi = NPH;
    hipLaunchKernelGGL(fwd, dim3(grid), dim3(NTHR), LDS_BYTES, stream, a);
#else
    for (int ph = 0; ph < NPH; ++ph) { if (!phase_used(ph)) continue; a.ph_lo = ph; a.ph_hi = ph + 1; hipLaunchKernelGGL(fwd, dim3(grid), dim3(NTHR), LDS_BYTES, stream, a); }
#endif
}
```
